# Optimizing an MI355X kernel written in HIP

```python
import jax, jax.numpy as jnp
from jax import lax
import numpy as np

D_MODEL = 1024
BATCH = 8
SEQ = 4096
DEPTH = 2

CTX_LEN = 256
GRID_W = 64
EPS = 1e-6
M_HEADS = 4
M_HEAD_DIM = D_MODEL // M_HEADS
M_WIDTH = M_HEADS * M_HEAD_DIM
M_CHUNK = 64
QK_CONV = 3
POOL_WINDOWS = (2, 4, 8, 16)
POOL_GROUPS = len(POOL_WINDOWS)
POOL_WIDTH = D_MODEL // 2
POOL_GROUP_DIM = POOL_WIDTH // POOL_GROUPS
D_FF = 2816
N_EXPERTS = 8
TOP_K = 2
D_FF_EXPERT = 3584
N_DENSE = (DEPTH + 1) // 2
N_MOE = DEPTH // 2
Q_OFF = 0
K_OFF = M_WIDTH
V_OFF = 2 * M_WIDTH
O_OFF = 3 * M_WIDTH
IF_OFF = 4 * M_WIDTH
N_GATE_COLS = 2 * 2 * M_HEADS
POOL_OFF = IF_OFF + N_GATE_COLS
GA_OFF = POOL_OFF + POOL_WIDTH
GB_OFF = GA_OFF + D_MODEL
IN_COLS = GB_OFF + D_MODEL

kernel_name = 'hybrid_mlstm_pool_moe_dit'


def _rmsnorm(x, g):
    xf = x.astype(jnp.float32)
    r = lax.rsqrt(jnp.mean(xf * xf, axis=-1, keepdims=True) + EPS)
    return (xf * r).astype(x.dtype) * g


def _dwconv_centred(x, w):
    k = w.shape[0]
    pad = k // 2
    s = x.shape[1]
    xp = jnp.pad(x, ((0, 0), (pad, pad), (0, 0)))
    out = xp[:, 0:s] * w[0]
    for j in range(1, k):
        out = out + xp[:, j:j + s] * w[j]
    return out


def _split_heads(t):
    b, s, _ = t.shape
    return t.reshape(b, s, M_HEADS, M_HEAD_DIM).transpose(0, 2, 1, 3)


def _mlstm_chunkwise(q, k, v, ig, lf, state, with_outputs):
    b_, h_, s_, dh = q.shape
    nc = s_ // M_CHUNK

    def chunks(t):
        t = t.reshape(b_, h_, nc, M_CHUNK, *t.shape[3:])
        return jnp.moveaxis(t, 2, 0)

    lower = jnp.tril(jnp.ones((M_CHUNK, M_CHUNK), dtype=bool))

    def step(carry, xs):
        c_st, n_st, m_st = carry
        qc, kc, vc, ic, fc = xs
        bcum = jnp.cumsum(fc, axis=-1)
        b_last = bcum[..., -1]
        g_end = b_last[..., None] - bcum + ic
        m_new = jnp.maximum(b_last + m_st, jnp.max(g_end, axis=-1))
        wk = jnp.exp(g_end - m_new[..., None])
        wc = jnp.exp(b_last + m_st - m_new)
        c_new = wc[..., None, None] * c_st + jnp.einsum('bhs,bhsd,bhse->bhde', wk, kc, vc)
        n_new = wc[..., None] * n_st + jnp.einsum('bhs,bhsd->bhd', wk, kc)
        if not with_outputs:
            return (c_new, n_new, m_new), None
        a_inter = bcum + m_st[..., None]
        dmat = jnp.where(lower, bcum[..., :, None] - bcum[..., None, :] + ic[..., None, :], -jnp.inf)
        m_row = jnp.maximum(a_inter, jnp.max(dmat, axis=-1))
        w_inter = jnp.exp(a_inter - m_row)
        scores = jnp.einsum('bhjd,bhsd->bhjs', qc, kc) * jnp.exp(dmat - m_row[..., None])
        num = (w_inter[..., None] * jnp.einsum('bhjd,bhde->bhje', qc, c_st)
               + jnp.einsum('bhjs,bhse->bhje', scores, vc))
        den = w_inter * jnp.einsum('bhjd,bhd->bhj', qc, n_st) + jnp.sum(scores, axis=-1)
        hc = num / jnp.maximum(jnp.abs(den), jnp.exp(-m_row))[..., None]
        return (c_new, n_new, m_new), hc

    state, hs = lax.scan(step, state, (chunks(q), chunks(k), chunks(v), chunks(ig), chunks(lf)))
    if hs is not None:
        hs = jnp.moveaxis(hs, 0, 2).reshape(b_, h_, s_, dh)
    return state, hs


def _box_mean(x, axis, w):
    n = x.shape[axis]
    cs = jnp.cumsum(x, axis=axis)
    zero = jnp.zeros_like(lax.slice_in_dim(cs, 0, 1, axis=axis))
    cs = jnp.concatenate([zero, cs], axis=axis)
    t = jnp.arange(n)
    lo = jnp.clip(t - w // 2, 0, n)
    hi = jnp.clip(t + w // 2, 0, n)
    total = jnp.take(cs, hi, axis=axis) - jnp.take(cs, lo, axis=axis)
    shape = [1] * x.ndim
    shape[axis] = n
    return total / (hi - lo).astype(x.dtype).reshape(shape)


def _multiscale_pool(p, rows):
    b, s, _ = p.shape
    pf = p.astype(jnp.float32)
    outs = []
    for g, w in enumerate(POOL_WINDOWS):
        xg = pf[..., g * POOL_GROUP_DIM:(g + 1) * POOL_GROUP_DIM]
        if rows is None:
            pooled = _box_mean(xg, 1, w)
        else:
            grid = xg.reshape(b, rows, GRID_W, POOL_GROUP_DIM)
            pooled = _box_mean(_box_mean(grid, 2, w), 1, w).reshape(b, s, POOL_GROUP_DIM)
        outs.append(pooled - xg)
    return jnp.concatenate(outs, axis=-1).astype(p.dtype)


def _mixer(u, w_in, conv_qk, b_if, head_gain, w_pool, pool_scale, w_pa, w_pb, w_out,
           init_f, init_b, rows, with_outputs):
    b, s, _ = u.shape
    f32 = jnp.float32
    z = u @ w_in
    qk = jax.nn.silu(_dwconv_centred(z[..., Q_OFF:V_OFF], conv_qk))
    q = _split_heads(qk[..., :M_WIDTH]).astype(f32)
    k = _split_heads(qk[..., M_WIDTH:]).astype(f32) * (M_HEAD_DIM ** -0.5)
    v = _split_heads(z[..., V_OFF:O_OFF]).astype(f32)
    gates = z[..., IF_OFF:POOL_OFF].astype(f32).reshape(b, s, 2, 2, M_HEADS) + b_if.astype(f32)
    gates = gates.transpose(2, 3, 0, 4, 1)
    flip = lambda t: jnp.flip(t, axis=2)
    st_f, h_f = _mlstm_chunkwise(q, k, v, gates[0, 0], jax.nn.log_sigmoid(gates[0, 1]),
                                 init_f, with_outputs)
    st_b, h_b = _mlstm_chunkwise(flip(q), flip(k), flip(v), flip(gates[1, 0]),
                                 flip(jax.nn.log_sigmoid(gates[1, 1])), init_b, with_outputs)
    if not with_outputs:
        return None, st_f, st_b
    hm = h_f + flip(h_b)
    mu = jnp.mean(hm, axis=-1, keepdims=True)
    var = jnp.mean(jnp.square(hm - mu), axis=-1, keepdims=True)
    hm = ((hm - mu) * lax.rsqrt(var + EPS)).transpose(0, 2, 1, 3).reshape(b, s, M_WIDTH).astype(u.dtype)
    hm = jax.nn.sigmoid(z[..., O_OFF:IF_OFF]) * (hm * head_gain)
    pm = _multiscale_pool(z[..., POOL_OFF:GA_OFF], rows)
    pm = jnp.einsum('bsgc,gce->bsge', pm.reshape(b, s, POOL_GROUPS, POOL_GROUP_DIM), w_pool)
    pm = pm.reshape(b, s, POOL_WIDTH) * pool_scale
    merged = (jax.nn.sigmoid(z[..., GA_OFF:GB_OFF]) * (hm @ w_pa)
              + jax.nn.sigmoid(z[..., GB_OFF:IN_COLS]) * (pm @ w_pb))
    return merged @ w_out, st_f, st_b


def _swiglu(t, wg, wu, wd):
    return (jax.nn.silu(t @ wg) * (t @ wu)) @ wd


def _moe(u, w_router, w_g, w_u, w_d):
    b, s, d = u.shape
    t = u.reshape(b * s, d)
    logits = (t @ w_router).astype(jnp.float32)
    top_val, top_idx = lax.top_k(logits, TOP_K)
    probs = jax.nn.softmax(top_val, axis=-1)
    gate = jnp.sum(jax.nn.one_hot(top_idx, N_EXPERTS, dtype=jnp.float32) * probs[..., None], axis=1)
    gate = gate.astype(t.dtype)
    y = jnp.zeros_like(t)
    for e in range(N_EXPERTS):
        y = y + gate[:, e:e + 1] * _swiglu(t, w_g[e], w_u[e], w_d[e])
    return y.reshape(b, s, d)


def _channel_mixer(l, u, w_ff_gate, w_ff_up, w_ff_down, w_router, w_exp_gate, w_exp_up, w_exp_down):
    j = l // 2
    if l % 2 == 0:
        return _swiglu(u, w_ff_gate[j], w_ff_up[j], w_ff_down[j])
    return _moe(u, w_router[j], w_exp_gate[j], w_exp_up[j], w_exp_down[j])


def setup_inputs(seed: int = 0) -> dict:
    key = jax.random.key(seed)
    ks = jax.random.split(key, 26)
    nrm = jax.random.normal
    f32 = jnp.float32
    d = D_MODEL
    return {
        'x': nrm(ks[0], (BATCH, SEQ, d), f32),
        'c': nrm(ks[1], (BATCH, d), f32),
        'ctx': nrm(ks[2], (BATCH, CTX_LEN, d), f32),
        'c_ctx': nrm(ks[3], (d,), f32),
        'w_ada': nrm(ks[4], (DEPTH, d, 6 * d), f32) * (0.5 * d ** -0.5),
        'b_ada': 0.02 * nrm(ks[5], (DEPTH, 6 * d), f32),
        'g_mix': 1.0 + 0.1 * nrm(ks[6], (DEPTH, d), f32),
        'w_in': nrm(ks[7], (DEPTH, d, IN_COLS), f32) * d ** -0.5,
        'conv_qk': nrm(ks[8], (DEPTH, QK_CONV, 2 * M_WIDTH), f32) * QK_CONV ** -0.5,
        'b_if': jnp.array([-1.0, 3.0], f32)[None, None, :, None] + 0.3 * nrm(ks[9], (DEPTH, 2, 2, M_HEADS), f32),
        'head_gain': 1.0 + 0.1 * nrm(ks[10], (DEPTH, M_WIDTH), f32),
        'w_pool': nrm(ks[11], (DEPTH, POOL_GROUPS, POOL_GROUP_DIM, POOL_GROUP_DIM), f32) * POOL_GROUP_DIM ** -0.5,
        'pool_scale': 1.0 + 0.1 * nrm(ks[12], (DEPTH, POOL_WIDTH), f32),
        'w_pa': nrm(ks[13], (DEPTH, M_WIDTH, d), f32) * M_WIDTH ** -0.5,
        'w_pb': nrm(ks[14], (DEPTH, POOL_WIDTH, d), f32) * POOL_WIDTH ** -0.5,
        'w_out': nrm(ks[15], (DEPTH, d, d), f32) * d ** -0.5,
        'g_ffn': 1.0 + 0.1 * nrm(ks[16], (DEPTH, d), f32),
        'w_ff_gate': nrm(ks[17], (N_DENSE, d, D_FF), f32) * d ** -0.5,
        'w_ff_up': nrm(ks[18], (N_DENSE, d, D_FF), f32) * d ** -0.5,
        'w_ff_down': nrm(ks[19], (N_DENSE, D_FF, d), f32) * D_FF ** -0.5,
        'w_router': nrm(ks[20], (N_MOE, d, N_EXPERTS), f32) * d ** -0.5,
        'w_exp_gate': nrm(ks[21], (N_MOE, N_EXPERTS, d, D_FF_EXPERT), f32) * d ** -0.5,
        'w_exp_up': nrm(ks[22], (N_MOE, N_EXPERTS, d, D_FF_EXPERT), f32) * d ** -0.5,
        'w_exp_down': nrm(ks[23], (N_MOE, N_EXPERTS, D_FF_EXPERT, d), f32) * D_FF_EXPERT ** -0.5,
        'g_final': 1.0 + 0.1 * nrm(ks[24], (d,), f32),
    }


def reference(x, c, ctx, c_ctx, w_ada, b_ada, g_mix, w_in, conv_qk, b_if, head_gain, w_pool, pool_scale,
              w_pa, w_pb, w_out, g_ffn, w_ff_gate, w_ff_up, w_ff_down, w_router, w_exp_gate, w_exp_up,
              w_exp_down, g_final):
    rows = x.shape[1] // GRID_W
    bsz = ctx.shape[0]
    f32 = jnp.float32
    zero_state = (jnp.zeros((bsz, M_HEADS, M_HEAD_DIM, M_HEAD_DIM), f32),
                  jnp.zeros((bsz, M_HEADS, M_HEAD_DIM), f32),
                  jnp.zeros((bsz, M_HEADS), f32))
    h = x
    h_ctx = ctx
    ffn_w = (w_ff_gate, w_ff_up, w_ff_down, w_router, w_exp_gate, w_exp_up, w_exp_down)
    for l in range(DEPTH):
        last = l == DEPTH - 1
        mod = jax.nn.silu(c) @ w_ada[l] + b_ada[l]
        mod_c = jax.nn.silu(c_ctx) @ w_ada[l] + b_ada[l]
        sh1, sc1, gt1, sh2, sc2, gt2 = jnp.split(mod[:, None, :], 6, axis=-1)
        sh1c, sc1c, gt1c, sh2c, sc2c, gt2c = jnp.split(mod_c, 6, axis=-1)
        mix_w = (w_in[l], conv_qk[l], b_if[l], head_gain[l], w_pool[l], pool_scale[l],
                 w_pa[l], w_pb[l], w_out[l])
        u_c = _rmsnorm(h_ctx, g_mix[l]) * (1.0 + sc1c) + sh1c
        y_c, st_f, st_b = _mixer(u_c, *mix_w, zero_state, zero_state, None, not last)
        u_x = _rmsnorm(h, g_mix[l]) * (1.0 + sc1) + sh1
        y_x, _, _ = _mixer(u_x, *mix_w, st_f, st_b, rows, True)
        h = h + gt1 * y_x
        u_x = _rmsnorm(h, g_ffn[l]) * (1.0 + sc2) + sh2
        h = h + gt2 * _channel_mixer(l, u_x, *ffn_w)
        if not last:
            h_ctx = h_ctx + gt1c * y_c
            u_c = _rmsnorm(h_ctx, g_ffn[l]) * (1.0 + sc2c) + sh2c
            h_ctx = h_ctx + gt2c * _channel_mixer(l, u_c, *ffn_w)
    return _rmsnorm(h, g_final)
```

```cpp
#include <hip/hip_runtime.h>
#include <stdint.h>
#include <stdio.h>

#ifndef MK_MULTI
#define MK_MULTI 1
#endif

#define LAS __attribute__((address_space(3)))
typedef unsigned short bf16_t;
typedef short bf16x8 __attribute__((ext_vector_type(8)));
typedef float f32x4 __attribute__((ext_vector_type(4)));
typedef float f32x2 __attribute__((ext_vector_type(2)));
typedef unsigned u32x4 __attribute__((ext_vector_type(4)));
typedef unsigned u32x2 __attribute__((ext_vector_type(2)));

constexpr int BATCH = 8, SEQ = 4096, DM = 1024, CTXL = 256;
constexpr int NL = BATCH * SEQ;
constexpr int NCX = BATCH * CTXL;
constexpr int MT = NL + NCX;
constexpr int HEADS = 4, DH = 256, CHUNK = 64;
constexpr int IN_COLS = 6672, O_OFF = 3072, IF_OFF = 4096, POOL_OFF = 4112, GA_OFF = 4624, GB_OFF = 5648;
constexpr int DFF = 2816, NEXP = 8, DFE = 3584;
constexpr int NQKV = 3072, NZB = 3584;
constexpr int NCHUNK_L = NL / CHUNK;
constexpr int NCHUNK = MT / CHUNK;
constexpr float EPS = 1e-6f;
constexpr int NTHREADS = 512;
constexpr int LDS_BYTES = 159744;
constexpr int MOE_RT = 64;
constexpr int MOE_ROUNDS = 5;

constexpr size_t al256(size_t x) { return (x + 255) & ~(size_t)255; }
constexpr size_t WS_CTL = 0;
constexpr size_t CTL_BYTES = 65536;
constexpr size_t WS_MOD = WS_CTL + CTL_BYTES;
constexpr size_t WS_GATES = al256(WS_MOD + (size_t)2 * 9 * 6144 * 4);
constexpr size_t WS_HALO = al256(WS_GATES + (size_t)MT * 16 * 4);
constexpr size_t WS_HCTX = al256(WS_HALO + (size_t)NCHUNK * 2 * 2048 * 2);
constexpr size_t WS_RPROB = al256(WS_HCTX + (size_t)NCX * DM * 4);
constexpr size_t WS_RLIST = al256(WS_RPROB + (size_t)NL * 2 * 4);
constexpr size_t WS_WQKV = al256(WS_RLIST + (size_t)NEXP * NL * 4);
constexpr size_t WS_WB = al256(WS_WQKV + (size_t)2 * NQKV * DM * 2);
constexpr size_t WS_WPA = al256(WS_WB + (size_t)2 * NZB * DM * 2);
constexpr size_t WS_WPBC = al256(WS_WPA + (size_t)2 * DM * DM * 2);
constexpr size_t WS_WOUT = al256(WS_WPBC + (size_t)2 * DM * 512 * 2);
constexpr size_t WS_WFGU = al256(WS_WOUT + (size_t)2 * DM * DM * 2);
constexpr size_t WS_WFD = al256(WS_WFGU + (size_t)2 * DFF * DM * 2);
constexpr size_t WS_ARENA = al256(WS_WFD + (size_t)DM * DFF * 2);
constexpr size_t R0_BYTES = (size_t)MT * DM * 2;
constexpr size_t WS_R0 = WS_ARENA;
constexpr size_t WS_R1 = WS_R0 + R0_BYTES;
constexpr size_t WS_R2 = WS_R1 + (size_t)MT * NQKV * 2;
constexpr size_t WS_R3 = WS_R2 + 2 * R0_BYTES;
constexpr size_t WS_END = WS_R3 + 2 * R0_BYTES;
constexpr size_t WS_KT = WS_R2, WS_VT = WS_R2 + R0_BYTES;
constexpr size_t WS_HF = WS_R3, WS_HB = WS_R3 + R0_BYTES;
constexpr size_t WS_ZB = WS_R1;
constexpr size_t WS_POOLED = al256(WS_ZB + (size_t)MT * NZB * 2);
constexpr size_t WS_ACT = WS_R1;
constexpr size_t WS_WEGU = WS_R1;
constexpr size_t WS_WED = WS_WEGU + (size_t)NEXP * 2 * DFE * DM * 2;
constexpr size_t WS_MACT = WS_WED + (size_t)NEXP * DM * DFE * 2;
constexpr size_t WS_Y = WS_R3;
static_assert(WS_POOLED + (size_t)MT * 512 * 2 <= WS_R3, "Zb + pooled overlay");
static_assert(WS_MACT + (size_t)MOE_RT * 256 * DFE * 2 <= WS_R3, "MoE overlay");
static_assert((size_t)2 * NL * DM * 2 <= 2 * R0_BYTES, "Y overlay");

constexpr int CW_BAR = 0;
constexpr int CW_ECNT = 4096;
constexpr int CW_ERR = 8192;

__device__ __forceinline__ unsigned cvt_pk_bf16(float lo, float hi) { unsigned r; asm("v_cvt_pk_bf16_f32 %0, %1, %2" : "=v"(r) : "v"(lo), "v"(hi)); return r; }
__device__ __forceinline__ float bf_lo(unsigned w) { return __uint_as_float(w << 16); }
__device__ __forceinline__ float bf_hi(unsigned w) { return __uint_as_float(w & 0xffff0000u); }
__device__ __forceinline__ float bf2f(bf16_t b) { return __uint_as_float(((unsigned)b) << 16); }
__device__ __forceinline__ bf16_t f2bf(float f) { return (bf16_t)(cvt_pk_bf16(f, 0.f) & 0xffffu); }
__device__ __forceinline__ float sigm(float x) { return 1.0f / (1.0f + __expf(-x)); }
__device__ __forceinline__ float silu(float x) { return x / (1.0f + __expf(-x)); }
__device__ __forceinline__ float wave_sum(float v) {
#pragma unroll
    for (int o = 32; o >= 1; o >>= 1) v += __shfl_xor(v, o);
    return v;
}
__device__ __forceinline__ float wave_max(float v) {
#pragma unroll
    for (int o = 32; o >= 1; o >>= 1) v = fmaxf(v, __shfl_xor(v, o));
    return v;
}

#define XB_TMO      128
#define XB_XCNT(j)  (256  + 64 * (j))
#define XB_XSUB(j)  (1280 + 64 * (j))
#define XB_XGEN(j)  (2304 + 64 * (j))
#define XB_TOP      3328
#define XB_TOPGEN   3392
#define XCD_BAR_WORDS 3456
#define XB_SPIN_CAP (1u << 18)

__device__ __forceinline__ unsigned xb_ld(unsigned* p)              { return __hip_atomic_load(p, __ATOMIC_RELAXED, __HIP_MEMORY_SCOPE_AGENT); }
__device__ __forceinline__ unsigned xb_add(unsigned* p, unsigned v) { return __hip_atomic_fetch_add(p, v, __ATOMIC_RELAXED, __HIP_MEMORY_SCOPE_AGENT); }
__device__ __forceinline__ unsigned xb_xcc_id() { return (unsigned)__builtin_amdgcn_s_getreg((3 << 11) | 20) & 0xFu; }
#define XB_SPIN(cond, bar) do { unsigned _sp = 0; while (cond) { __builtin_amdgcn_s_sleep(1); \
    if ((++_sp & 255u) == 0u) { if (xb_ld(&(bar)[XB_TMO])) break; if (_sp > XB_SPIN_CAP) { atomicAdd(&(bar)[XB_TMO], 1u); break; } } } } while (0)

struct XcdBarrier { unsigned* bar; unsigned x; volatile LAS unsigned* st; };

__device__ __forceinline__ XcdBarrier xcd_barrier_post(unsigned* bar, volatile LAS unsigned* st) {
    XcdBarrier b; b.bar = bar; b.x = xb_xcc_id(); b.st = st;
    if (threadIdx.x == 0) (void)xb_add(&bar[XB_XCNT(b.x)], 1u);
    return b;
}
__device__ __forceinline__ void xcd_barrier_complete(unsigned* bar, unsigned x, unsigned& nloc, unsigned& nx) {
    const unsigned G = gridDim.x * gridDim.y * gridDim.z;
    unsigned sum, cnt, mine, sp = 0u;
    for (;;) {
        sum = 0u; cnt = 0u; mine = 0u;
#pragma unroll
        for (unsigned j = 0; j < 16; ++j) { const unsigned c = xb_ld(&bar[XB_XCNT(j)]); sum += c; cnt += (c > 0u) ? 1u : 0u; mine = (j == x) ? c : mine; }
        if (sum == G) break;
        __builtin_amdgcn_s_sleep(1);
        if ((++sp & 255u) == 0u) { if (xb_ld(&bar[XB_TMO])) break; if (sp > XB_SPIN_CAP) { atomicAdd(&bar[XB_TMO], 1u); break; } }
    }
    nloc = mine > 0u ? mine : 1u; nx = cnt > 0u ? cnt : 1u;
}
__device__ __forceinline__ void xcd_barrier(const XcdBarrier& b) {
    asm volatile("s_waitcnt vmcnt(0)" ::: "memory");
    __syncthreads();
    if (threadIdx.x == 0) {
        unsigned* bar = b.bar;
        __builtin_amdgcn_s_waitcnt(0);
        unsigned nloc = b.st[0], nx = b.st[1];
        if (nloc == 0u) { xcd_barrier_complete(bar, b.x, nloc, nx); b.st[0] = nloc; b.st[1] = nx; }
        const unsigned old = xb_add(&bar[XB_XSUB(b.x)], 1u);
        const unsigned gen = old / nloc;
        if (old + 1u == (gen + 1u) * nloc) {
            __builtin_amdgcn_fence(__ATOMIC_RELEASE, "agent");
            asm volatile("s_waitcnt vmcnt(0)" ::: "memory");
            const unsigned og = xb_add(&bar[XB_TOP], 1u);
            const unsigned tg = og / nx;
            if (og + 1u == (tg + 1u) * nx) xb_add(&bar[XB_TOPGEN], 1u);
            else XB_SPIN(xb_ld(&bar[XB_TOPGEN]) == tg, bar);
            __builtin_amdgcn_fence(__ATOMIC_ACQUIRE, "agent");
            xb_add(&bar[XB_XGEN(b.x)], 1u);
            asm volatile("s_waitcnt vmcnt(0)" ::: "memory");
        } else {
            XB_SPIN(xb_ld(&bar[XB_XGEN(b.x)]) == gen, bar);
            __builtin_amdgcn_fence(__ATOMIC_ACQUIRE, "agent");
            asm volatile("s_waitcnt vmcnt(0)" ::: "memory");
        }
    }
    __syncthreads();
}

namespace gp {
constexpr int BM = 256, BK = 64, HALF = 128, HTB = HALF * BK * 2, STAGE_BYTES = 8 * HTB, NXCD = 8, WGM = 8;
__device__ __forceinline__ int lds_byte(int r, int c) { const int st = (r >> 4) * 2 + (c >> 5), rr = r & 15, cc = c & 31, ob = rr * 64 + cc * 2; return st * 1024 + (ob ^ (((ob >> 9) & 1) << 5)); }
__device__ __forceinline__ void stage_rc(int b, int& R, int& C) { const int st = b / 1024, sb = b % 1024, swz = sb ^ (((sb >> 9) & 1) << 5); R = (st >> 1) * 16 + swz / 64; C = (st & 1) * 32 + (swz % 64) / 2; }
__device__ __forceinline__ int perm32(int rho) { const int n = rho >> 4, i = rho & 15; return 8 * (i >> 2) + 4 * n + (i & 3); }

struct Unit { int pm, pn, ex, cnt; };

__device__ __forceinline__ bool static_next(int i, int G, int c, int nM, int nN, int& pm, int& pn) {
    const int nwg = nM * nN;
    const long L = (long)i * G + c; if (L >= nwg) return false;
    int wgid = (int)L; { const int q = nwg / NXCD, r = nwg % NXCD, xcd = wgid % NXCD, off = wgid / NXCD; wgid = (xcd < r ? xcd * (q + 1) : r * (q + 1) + (xcd - r) * q) + off; }
    const int nig = WGM * nN, gid = wgid / nig, fm = gid * WGM, gsz = (nM - fm) < WGM ? (nM - fm) : WGM;
    pm = fm + ((wgid % nig) % gsz); pn = (wgid % nig) / gsz; return true;
}

template <class Epi, class Sched>
__device__ __forceinline__ void gemm_phase(LAS unsigned char* lds, const int K, const Sched& S, const Epi& E) {
    const int tid = threadIdx.x, wid = __builtin_amdgcn_readfirstlane(tid >> 6), lane = tid & 63, wr = wid >> 2, wc = wid & 3, fr = lane & 15, fq = lane >> 4;
    const int nt = K / BK;
    const int lda = S.lda, ldb = S.ldb;
    unsigned voffA[2], voffB[2]; int RA[2], CA[2];
#pragma unroll
    for (int i = 0; i < 2; ++i) { int R, C; stage_rc(tid * 16 + i * 8192, R, C); const int Rb = Epi::PERM ? ((R & ~31) + perm32(R & 31)) : R;
        RA[i] = R; CA[i] = C; voffA[i] = (unsigned)(R * lda + C) * 2u; voffB[i] = (unsigned)(Rb * ldb + C) * 2u; }
    const size_t kstep = (size_t)(BK * 2);
    const size_t hstepA = (size_t)HALF * lda * 2, hstepB = (size_t)HALF * ldb * 2;
    const unsigned ldsw = (unsigned)wid * 1024u;
    const int aoff = lds_byte(wr * 64 + fr, fq * 8), boff = lds_byte(wc * 32 + fr, fq * 8);
    unsigned gvc[2][2], gvn[2][2];
#define GP_SA(b, h) (((b) * 2 + (h)) * HTB)
#define GP_SB(b, h) ((4 + (b) * 2 + (h)) * HTB)
#define GP_STAGE_B(bufoff, gbase) do { _Pragma("unroll") for (int _i = 0; _i < 2; ++_i) \
        __builtin_amdgcn_global_load_lds((const unsigned*)((const char*)(gbase) + voffB[_i]), (LAS unsigned*)(lds + (bufoff) + ldsw + _i * 8192), 16, 0, 0); } while (0)
#define GP_STAGE_A(bufoff, p, nx, h) do { _Pragma("unroll") for (int _i = 0; _i < 2; ++_i) { \
        const unsigned _vo = Sched::GATHER ? ((nx) ? gvn[h][_i] : gvc[h][_i]) : voffA[_i]; \
        __builtin_amdgcn_global_load_lds((const unsigned*)((const char*)(p) + (Sched::GATHER ? (size_t)0 : (size_t)(h) * hstepA) + _vo), (LAS unsigned*)(lds + (bufoff) + ldsw + _i * 8192), 16, 0, 0); } } while (0)
#define GP_LDA(dst, b, h) do { _Pragma("unroll") for (int m = 0; m < 4; ++m) _Pragma("unroll") for (int k = 0; k < 2; ++k) dst[m][k] = *(const LAS bf16x8*)(lds + GP_SA(b, h) + aoff + m * 2048 + k * 1024); } while (0)
#define GP_LDB(dst, b, h) do { _Pragma("unroll") for (int n = 0; n < 2; ++n) _Pragma("unroll") for (int k = 0; k < 2; ++k) dst[n][k] = *(const LAS bf16x8*)(lds + GP_SB(b, h) + boff + n * 2048 + k * 1024); } while (0)
#define GP_MMA(ai, bj, At, Bt) do { __builtin_amdgcn_s_setprio(1); _Pragma("unroll") for (int m = 0; m < 4; ++m) _Pragma("unroll") for (int n = 0; n < 2; ++n) _Pragma("unroll") for (int k = 0; k < 2; ++k) \
        acc[ai][bj][m][n] = __builtin_amdgcn_mfma_f32_16x16x32_bf16(Bt[n][k], At[m][k], acc[ai][bj][m][n], 0, 0, 0); __builtin_amdgcn_s_setprio(0); } while (0)
#define GP_WAIT_V(n) asm volatile("s_waitcnt vmcnt(" #n ")" ::: "memory")
#define GP_WAIT_L(n) asm volatile("s_waitcnt lgkmcnt(" #n ")" ::: "memory")
#define GP_BAR __builtin_amdgcn_s_barrier()
#define GP_SCHED __builtin_amdgcn_sched_barrier(0)
    Unit cur, nxt; int ui = 0;
    if (!S.next(0, cur)) return;
    f32x4 acc[2][2][4][2];
#pragma unroll
    for (int a = 0; a < 2; ++a)
#pragma unroll
        for (int b = 0; b < 2; ++b)
#pragma unroll
            for (int m = 0; m < 4; ++m)
#pragma unroll
                for (int n = 0; n < 2; ++n) acc[a][b][m][n] = (f32x4){0.f, 0.f, 0.f, 0.f};
    bf16x8 At[4][2], B0[2][2], B1[2][2];
    const char* cA = S.aptr(cur); const char* cB = S.bptr(cur);
    if (Sched::GATHER) {
#pragma unroll
        for (int h = 0; h < 2; ++h)
#pragma unroll
            for (int i = 0; i < 2; ++i) { gvc[h][i] = (unsigned)(S.arow(cur, h * HALF + RA[i]) * lda + CA[i]) * 2u; gvn[h][i] = gvc[h][i]; }
    }
    GP_STAGE_B(GP_SB(0, 0), cB); GP_STAGE_A(GP_SA(0, 0), cA, false, 0); GP_STAGE_B(GP_SB(0, 1), cB + hstepB); GP_STAGE_A(GP_SA(0, 1), cA, false, 1);
    if (wr == 1) GP_BAR;
    GP_WAIT_V(4); GP_BAR;
    GP_STAGE_B(GP_SB(1, 0), cB + kstep); GP_STAGE_A(GP_SA(1, 0), cA + kstep, false, 0); GP_STAGE_B(GP_SB(1, 1), cB + hstepB + kstep);
    GP_WAIT_V(6); GP_BAR;
    for (;;) {
        const bool has_next = S.next(ui + 1, nxt);
        const char* nA = has_next ? S.aptr(nxt) : cA; const char* nB = has_next ? S.bptr(nxt) : cB;
        if (Sched::GATHER && has_next) {
#pragma unroll
            for (int h = 0; h < 2; ++h)
#pragma unroll
                for (int i = 0; i < 2; ++i) gvn[h][i] = (unsigned)(S.arow(nxt, h * HALF + RA[i]) * lda + CA[i]) * 2u;
        }
        for (int t = 0; t < nt; t += 2) {
            const bool last = (t == nt - 2);
            const char* a1 = cA + (size_t)(t + 1) * kstep;
            const char* a2 = last ? nA : cA + (size_t)(t + 2) * kstep; const char* b2 = last ? nB : cB + (size_t)(t + 2) * kstep;
            const char* a3 = a2 + kstep; const char* b3 = b2 + kstep;
            GP_LDB(B0, 0, 0); GP_SCHED; GP_LDA(At, 0, 0); GP_STAGE_A(GP_SA(1, 1), a1, false, 1);
            GP_WAIT_L(8); GP_BAR; GP_WAIT_L(0); GP_MMA(0, 0, At, B0); GP_BAR; GP_SCHED;
            GP_LDB(B1, 0, 1); GP_STAGE_B(GP_SB(0, 0), b2);
            GP_BAR; GP_WAIT_L(0); GP_MMA(0, 1, At, B1); GP_BAR;
            GP_LDA(At, 0, 1); GP_STAGE_A(GP_SA(0, 0), a2, last, 0);
            GP_BAR; GP_WAIT_L(0); GP_MMA(1, 0, At, B0); GP_BAR; GP_SCHED;
            GP_STAGE_B(GP_SB(0, 1), b2 + hstepB);
            GP_WAIT_V(6); GP_BAR; GP_MMA(1, 1, At, B1); GP_BAR;
            GP_LDB(B0, 1, 0); GP_SCHED; GP_LDA(At, 1, 0); GP_STAGE_A(GP_SA(0, 1), a2, last, 1);
            GP_WAIT_L(8); GP_BAR; GP_WAIT_L(0); GP_MMA(0, 0, At, B0); GP_BAR; GP_SCHED;
            GP_LDB(B1, 1, 1); GP_STAGE_B(GP_SB(1, 0), b3);
            GP_BAR; GP_WAIT_L(0); GP_MMA(0, 1, At, B1); GP_BAR;
            GP_LDA(At, 1, 1); GP_STAGE_A(GP_SA(1, 0), a3, last, 0);
            GP_BAR; GP_WAIT_L(0); GP_MMA(1, 0, At, B0); GP_BAR; GP_SCHED;
            GP_STAGE_B(GP_SB(1, 1), b3 + hstepB);
            GP_WAIT_V(6); GP_BAR; GP_MMA(1, 1, At, B1); GP_BAR;
        }
        E(acc, cur, wr, wc, fr, fq);
        if (!has_next) break;
#pragma unroll
        for (int a = 0; a < 2; ++a)
#pragma unroll
            for (int b = 0; b < 2; ++b)
#pragma unroll
                for (int m = 0; m < 4; ++m)
#pragma unroll
                    for (int n = 0; n < 2; ++n) acc[a][b][m][n] = (f32x4){0.f, 0.f, 0.f, 0.f};
        cur = nxt; cA = nA; cB = nB; ++ui;
        if (Sched::GATHER) {
#pragma unroll
            for (int h = 0; h < 2; ++h)
#pragma unroll
                for (int i = 0; i < 2; ++i) gvc[h][i] = gvn[h][i];
        }
    }
    GP_WAIT_V(0);
    if (wr == 0) GP_BAR;
    GP_BAR;
#undef GP_SA
#undef GP_SB
#undef GP_STAGE_A
#undef GP_STAGE_B
#undef GP_LDA
#undef GP_LDB
#undef GP_MMA
#undef GP_WAIT_V
#undef GP_WAIT_L
#undef GP_BAR
#undef GP_SCHED
}
}

typedef const char __attribute__((address_space(4)))* karg_t;
__device__ __forceinline__ const float* karg_in(int i) {
    karg_t ka = (karg_t)__builtin_amdgcn_kernarg_segment_ptr();
    unsigned long long v;
    asm volatile("s_load_dwordx2 %0, %1, %2\n\ts_waitcnt lgkmcnt(0)" : "=s"(v) : "s"(ka), "s"(i * 8) : "memory");
    return (const float*)v;
}
struct Frame {
    float* out; unsigned char* ws; unsigned* ctl; LAS unsigned char* lds;
    int G, bid, tid, lane, wave;
    __device__ __forceinline__ const float* in(int i) const { return karg_in(i); }
};
enum { I_X = 0, I_C, I_CTX, I_CCTX, I_WADA, I_BADA, I_GMIX, I_WIN, I_CONV, I_BIF, I_HGAIN, I_WPOOL, I_PSCALE, I_WPA, I_WPB, I_WOUT, I_GFFN,
       I_WFG, I_WFU, I_WFD, I_WROUTER, I_WEG, I_WEU, I_WED, I_GFINAL };
constexpr int MOD_SH1 = 0, MOD_SC1 = 1024, MOD_GT1 = 2048, MOD_SH2 = 3072, MOD_SC2 = 4096, MOD_GT2 = 5120;

struct SchedDense {
    static constexpr bool GATHER = false;
    const char* A; const char* B; int lda, ldb, nM, nN, G, c;
    __device__ __forceinline__ bool next(int i, gp::Unit& u) const { u.ex = 0; u.cnt = 256; return gp::static_next(i, G, c, nM, nN, u.pm, u.pn); }
    __device__ __forceinline__ const char* aptr(const gp::Unit& u) const { return A + (size_t)u.pm * 256 * lda * 2; }
    __device__ __forceinline__ const char* bptr(const gp::Unit& u) const { return B + (size_t)u.pn * 256 * ldb * 2; }
    __device__ __forceinline__ int arow(const gp::Unit&, int) const { return 0; }
};
constexpr int LDS_MOE_TAB = 131072;
__device__ __forceinline__ int moe_build_table(const Frame& F) {
    LAS int* tab = (LAS int*)(F.lds + LDS_MOE_TAB);
    int acc = 0, myex = -1, myr0 = 0, mycnt = 0;
#pragma unroll
    for (int e = 0; e < 8; ++e) { const int c = (int)__hip_atomic_load(F.ctl + CW_ECNT + 64 * e, __ATOMIC_RELAXED, __HIP_MEMORY_SCOPE_AGENT); const int nt = (c + 255) >> 8;
        if (F.tid >= acc && F.tid < acc + nt) { myex = e; myr0 = (F.tid - acc) * 256; mycnt = c - myr0; mycnt = mycnt > 256 ? 256 : mycnt; }
        acc += nt; }
    if (myex >= 0) { tab[2 * F.tid] = myex; tab[2 * F.tid + 1] = (myr0 << 9) | mycnt; }
    __syncthreads();
    return acc;
}
struct SchedMoe1 {
    static constexpr bool GATHER = true;
    const char* A; const char* B; const int* list; LAS const int* tab; int lda, ldb, G, c, g0, ntile;
    __device__ __forceinline__ bool next(int i, gp::Unit& u) const {
        if (ntile <= 0) return false;
        if (!gp::static_next(i, G, c, ntile, DFE / 128, u.pm, u.pn)) return false;
        u.ex = __builtin_amdgcn_readfirstlane(tab[2 * (g0 + u.pm)]); u.cnt = __builtin_amdgcn_readfirstlane(tab[2 * (g0 + u.pm) + 1]);
        return true;
    }
    __device__ __forceinline__ const char* aptr(const gp::Unit&) const { return A; }
    __device__ __forceinline__ const char* bptr(const gp::Unit& u) const { return B + ((size_t)u.ex * (2 * DFE) + (size_t)u.pn * 256) * ldb * 2; }
    __device__ __forceinline__ int arow(const gp::Unit& u, int r) const {
        const int cnt = u.cnt & 511, r0 = u.cnt >> 9;
        return r < cnt ? (list[(size_t)u.ex * NL + r0 + r] >> 1) : 0;
    }
};
struct SchedMoe2 {
    static constexpr bool GATHER = false;
    const char* A; const char* B; LAS const int* tab; int lda, ldb, G, c, g0, ntile;
    __device__ __forceinline__ bool next(int i, gp::Unit& u) const {
        if (ntile <= 0) return false;
        if (!gp::static_next(i, G, c, ntile, DM / 256, u.pm, u.pn)) return false;
        u.ex = __builtin_amdgcn_readfirstlane(tab[2 * (g0 + u.pm)]); u.cnt = __builtin_amdgcn_readfirstlane(tab[2 * (g0 + u.pm) + 1]);
        return true;
    }
    __device__ __forceinline__ const char* aptr(const gp::Unit& u) const { return A + (size_t)u.pm * 256 * lda * 2; }
    __device__ __forceinline__ const char* bptr(const gp::Unit& u) const { return B + ((size_t)u.ex * DM + (size_t)u.pn * 256) * ldb * 2; }
    __device__ __forceinline__ int arow(const gp::Unit&, int) const { return 0; }
};

#define EPI_ARGS const f32x4 (&acc)[2][2][4][2], const gp::Unit& u, int wr, int wc, int fr, int fq
#define EPI_ROWS(ai, m) ((ai) * 128 + wr * 64 + (m) * 16 + fr)
__device__ __forceinline__ u32x4 pack8(const f32x4& a, const f32x4& b) { u32x4 w; w.x = cvt_pk_bf16(a[0], a[1]); w.y = cvt_pk_bf16(a[2], a[3]); w.z = cvt_pk_bf16(b[0], b[1]); w.w = cvt_pk_bf16(b[2], b[3]); return w; }
__device__ __forceinline__ void unpack8(const u32x4& w, f32x4& a, f32x4& b) { a = (f32x4){bf_lo(w.x), bf_hi(w.x), bf_lo(w.y), bf_hi(w.y)}; b = (f32x4){bf_lo(w.z), bf_hi(w.z), bf_lo(w.w), bf_hi(w.w)}; }

struct EpiQKV {
    static constexpr bool PERM = true;
    bf16_t* O; bf16_t* halo;
    __device__ __forceinline__ void operator()(EPI_ARGS) const {
        const int c8 = u.pn * 256 + wc * 32 + 8 * fq;
#pragma unroll
        for (int ai = 0; ai < 2; ++ai)
#pragma unroll
            for (int m = 0; m < 4; ++m) { const int row = u.pm * 256 + EPI_ROWS(ai, m);
#pragma unroll
                for (int bj = 0; bj < 2; ++bj) { const u32x4 w = pack8(acc[ai][bj][m][0], acc[ai][bj][m][1]);
                    *(u32x4*)(O + (size_t)row * NQKV + c8 + bj * 128) = w;
                    const int rr = row & 63;
                    if (u.pn < 8 && (rr == 0 || rr == 63)) *(u32x4*)(halo + ((size_t)(row >> 6) * 2 + (rr ? 1 : 0)) * 2048 + c8 + bj * 128) = w; } }
    }
};
struct EpiZB {
    static constexpr bool PERM = true;
    bf16_t* O;
    __device__ __forceinline__ void operator()(EPI_ARGS) const {
        const int c8 = u.pn * 256 + wc * 32 + 8 * fq; const bool sg = u.pn < 12;
#pragma unroll
        for (int ai = 0; ai < 2; ++ai)
#pragma unroll
            for (int m = 0; m < 4; ++m) { const int row = u.pm * 256 + EPI_ROWS(ai, m);
#pragma unroll
                for (int bj = 0; bj < 2; ++bj) { f32x4 a = acc[ai][bj][m][0], b = acc[ai][bj][m][1];
                    if (sg) {
#pragma unroll
                        for (int j = 0; j < 4; ++j) { a[j] = sigm(a[j]); b[j] = sigm(b[j]); } }
                    *(u32x4*)(O + (size_t)row * NZB + c8 + bj * 128) = pack8(a, b); } }
    }
};
template <int ADD> struct EpiGate {
    static constexpr bool PERM = true;
    bf16_t* O; const bf16_t* Z; int gcol0;
    __device__ __forceinline__ void operator()(EPI_ARGS) const {
        const int c8 = u.pn * 256 + wc * 32 + 8 * fq;
#pragma unroll
        for (int ai = 0; ai < 2; ++ai)
#pragma unroll
            for (int m = 0; m < 4; ++m) { const int row = u.pm * 256 + EPI_ROWS(ai, m);
#pragma unroll
                for (int bj = 0; bj < 2; ++bj) {
                    const u32x4 gw = *(const u32x4*)(Z + (size_t)row * NZB + gcol0 + c8 + bj * 128); f32x4 g0, g1; unpack8(gw, g0, g1);
                    f32x4 a = acc[ai][bj][m][0] * g0, b = acc[ai][bj][m][1] * g1;
                    bf16_t* op = O + (size_t)row * DM + c8 + bj * 128;
                    if (ADD) { const u32x4 pw = *(const u32x4*)op; f32x4 p0, p1; unpack8(pw, p0, p1); a += p0; b += p1; }
                    *(u32x4*)op = pack8(a, b); } }
    }
};
struct EpiResid {
    static constexpr bool PERM = false;
    const float* srcL; float* dstL; const float* srcC; float* dstC; const float* modl; int gtoff;
    __device__ __forceinline__ void operator()(EPI_ARGS) const {
        const bool isc = u.pm >= NL / 256; const int mrow = isc ? 8 : (u.pm >> 4);
        const float* src = isc ? srcC : srcL; float* dst = isc ? dstC : dstL; const int rbase = isc ? u.pm * 256 - NL : u.pm * 256;
        const float* gt = modl + (size_t)mrow * 6144 + gtoff;
        const int c4 = u.pn * 256 + wc * 32 + 4 * fq;
        f32x4 gv[2][2];
#pragma unroll
        for (int bj = 0; bj < 2; ++bj)
#pragma unroll
            for (int n = 0; n < 2; ++n) gv[bj][n] = *(const f32x4*)(gt + c4 + bj * 128 + n * 16);
#pragma unroll
        for (int ai = 0; ai < 2; ++ai)
#pragma unroll
            for (int m = 0; m < 4; ++m) { const size_t off = (size_t)(rbase + EPI_ROWS(ai, m)) * DM + c4;
#pragma unroll
                for (int bj = 0; bj < 2; ++bj)
#pragma unroll
                    for (int n = 0; n < 2; ++n) { const f32x4 s = *(const f32x4*)(src + off + bj * 128 + n * 16);
                        *(f32x4*)(dst + off + bj * 128 + n * 16) = s + gv[bj][n] * acc[ai][bj][m][n]; }
                asm volatile("" ::: "memory"); }
    }
};
struct EpiSwiglu {
    static constexpr bool PERM = true;
    bf16_t* O; int ldo;
    __device__ __forceinline__ void operator()(EPI_ARGS) const {
        const int c8 = u.pn * 128 + wc * 32 + 8 * fq;
#pragma unroll
        for (int ai = 0; ai < 2; ++ai)
#pragma unroll
            for (int m = 0; m < 4; ++m) { const int row = u.pm * 256 + EPI_ROWS(ai, m);
                f32x4 a, b;
#pragma unroll
                for (int j = 0; j < 4; ++j) { a[j] = silu(acc[ai][0][m][0][j]) * acc[ai][1][m][0][j]; b[j] = silu(acc[ai][0][m][1][j]) * acc[ai][1][m][1][j]; }
                *(u32x4*)(O + (size_t)row * ldo + c8) = pack8(a, b); }
    }
};
struct EpiMoe2 {
    static constexpr bool PERM = true;
    bf16_t* Y; const int* list; const float* prob;
    __device__ __forceinline__ void operator()(EPI_ARGS) const {
        const int cnt = u.cnt & 511, r0 = u.cnt >> 9;
        const int c8 = u.pn * 256 + wc * 32 + 8 * fq;
#pragma unroll
        for (int ai = 0; ai < 2; ++ai)
#pragma unroll
            for (int m = 0; m < 4; ++m) { const int r = EPI_ROWS(ai, m);
                if (r < cnt) { const int en = list[(size_t)u.ex * NL + r0 + r]; const float p = prob[en];
                    bf16_t* op = Y + ((size_t)(en & 1) * NL + (size_t)(en >> 1)) * DM + c8;
#pragma unroll
                    for (int bj = 0; bj < 2; ++bj) *(u32x4*)(op + bj * 128) = pack8(acc[ai][bj][m][0] * p, acc[ai][bj][m][1] * p); } }
    }
};

__device__ __forceinline__ void conv_tile(const float* src, int ld, int k0, int c0, bf16_t* dst, int dld, int dr0, LAS float* tl) {
    const int t = threadIdx.x;
    { const int r = t >> 4, c4 = (t & 15) * 4;
#pragma unroll
      for (int p = 0; p < 2; ++p) { const int rr = r + p * 32; const f32x4 v = *(const f32x4*)(src + (size_t)(k0 + rr) * ld + c0 + c4);
          tl[rr * 65 + c4 + 0] = v[0]; tl[rr * 65 + c4 + 1] = v[1]; tl[rr * 65 + c4 + 2] = v[2]; tl[rr * 65 + c4 + 3] = v[3]; } }
    __syncthreads();
    { const int n = t >> 3, kc = (t & 7) * 8; float v[8];
#pragma unroll
      for (int j = 0; j < 8; ++j) v[j] = tl[(kc + j) * 65 + n];
      u32x4 w; w.x = cvt_pk_bf16(v[0], v[1]); w.y = cvt_pk_bf16(v[2], v[3]); w.z = cvt_pk_bf16(v[4], v[5]); w.w = cvt_pk_bf16(v[6], v[7]);
      *(u32x4*)(dst + (size_t)(dr0 + n) * dld + k0 + kc) = w; }
    __syncthreads();
}
__device__ __forceinline__ void conv_mat(const Frame& F, const float* src, int ld, int Krows, int c0, int ncols, bf16_t* dst, int dld, int dr0, int mode, int rot, LAS float* tl) {
    const int ntn = ncols / 64, ntk = Krows / 64, tot = ntn * ntk;
    for (int j = (F.bid + rot) % F.G; j < tot; j += F.G) { const int tn = j % ntn, tk = j / ntn; const int cc = tn * 64;
        const int dr = mode ? ((cc >> 7) * 256 + (cc & 127) + dr0) : (dr0 + cc);
        conv_tile(src, ld, tk * 64, c0 + cc, dst, dld, dr, tl); }
}

__device__ __forceinline__ void prologue_phase(const Frame& F) {
    LAS float* tl = (LAS float*)F.lds;
    for (int l = 0; l < 2; ++l) {
        const float* win = F.in(I_WIN) + (size_t)l * DM * IN_COLS;
        bf16_t* wqkv = (bf16_t*)(F.ws + WS_WQKV) + (size_t)l * NQKV * DM;
        bf16_t* wb = (bf16_t*)(F.ws + WS_WB) + (size_t)l * NZB * DM;
        conv_mat(F, win, IN_COLS, DM, 0, NQKV, wqkv, DM, 0, 0, 0, tl);
        conv_mat(F, win, IN_COLS, DM, O_OFF, 1024, wb, DM, 0, 0, 64, tl);
        conv_mat(F, win, IN_COLS, DM, GA_OFF, 1024, wb, DM, 1024, 0, 128, tl);
        conv_mat(F, win, IN_COLS, DM, GB_OFF, 1024, wb, DM, 2048, 0, 192, tl);
        conv_mat(F, win, IN_COLS, DM, POOL_OFF, 512, wb, DM, 3072, 0, 0, tl);
        conv_mat(F, F.in(I_WPA) + (size_t)l * DM * DM, DM, DM, 0, DM, (bf16_t*)(F.ws + WS_WPA) + (size_t)l * DM * DM, DM, 0, 0, 128, tl);
        conv_mat(F, F.in(I_WOUT) + (size_t)l * DM * DM, DM, DM, 0, DM, (bf16_t*)(F.ws + WS_WOUT) + (size_t)l * DM * DM, DM, 0, 0, 0, tl);
    }
    conv_mat(F, F.in(I_WFG), DFF, DM, 0, DFF, (bf16_t*)(F.ws + WS_WFGU), DM, 0, 1, 0, tl);
    conv_mat(F, F.in(I_WFU), DFF, DM, 0, DFF, (bf16_t*)(F.ws + WS_WFGU), DM, 128, 1, 64, tl);
    conv_mat(F, F.in(I_WFD), DM, DFF, 0, DM, (bf16_t*)(F.ws + WS_WFD), DFF, 0, 0, 128, tl);
    const float* wpool = F.in(I_WPOOL); const float* pscale = F.in(I_PSCALE); const float* wpb = F.in(I_WPB);
    for (int idx = F.bid * NTHREADS + F.tid; idx < 2 * 512 * 1024; idx += F.G * NTHREADS) {
        const int l = idx >> 19, rem = idx & ((1 << 19) - 1), gc = rem >> 10, n = rem & 1023, g = gc >> 7;
        const float* wp = wpool + ((size_t)l * 512 + gc) * 128; const float* ps = pscale + l * 512 + g * 128;
        const float* pb = wpb + ((size_t)l * 512 + g * 128) * DM + n;
        float s = 0.f;
        for (int e = 0; e < 128; ++e) s += wp[e] * ps[e] * pb[(size_t)e * DM];
        ((bf16_t*)(F.ws + WS_WPBC))[((size_t)l * DM + n) * 512 + gc] = f2bf(s);
    }
    {
        LAS float* sl = (LAS float*)(F.lds + 32768);
        LAS float* red = (LAS float*)(F.lds + 32768 + 36864);
        const float* cvec = F.in(I_C); const float* ccv = F.in(I_CCTX); const float* bada = F.in(I_BADA);
        for (int idx = F.tid; idx < 9 * 1024; idx += NTHREADS) { const int r = idx >> 10, k = idx & 1023; const float v = r < 8 ? cvec[r * 1024 + k] : ccv[k]; sl[idx] = silu(v); }
        __syncthreads();
        float* mod = (float*)(F.ws + WS_MOD);
        for (int job = F.bid; job < 2 * 96; job += F.G) {
            const int l = job / 96, n0 = (job % 96) * 64, cidx = F.tid & 63, kg = F.tid >> 6;
            const float* w = F.in(I_WADA) + (size_t)l * DM * 6144 + n0 + cidx;
            float a[9];
#pragma unroll
            for (int r = 0; r < 9; ++r) a[r] = 0.f;
            for (int k = kg * 128; k < kg * 128 + 128; ++k) { const float wv = w[(size_t)k * 6144];
#pragma unroll
                for (int r = 0; r < 9; ++r) a[r] += sl[r * 1024 + k] * wv; }
#pragma unroll
            for (int r = 0; r < 9; ++r) red[(kg * 64 + cidx) * 9 + r] = a[r];
            __syncthreads();
            for (int idx = F.tid; idx < 576; idx += NTHREADS) { const int ci = idx & 63, r = idx >> 6; float s = 0.f;
#pragma unroll
                for (int g = 0; g < 8; ++g) s += red[(g * 64 + ci) * 9 + r];
                mod[((size_t)l * 9 + r) * 6144 + n0 + ci] = s + bada[l * 6144 + n0 + ci]; }
            __syncthreads();
        }
    }
}

__device__ __forceinline__ void expert_convert(const Frame& F, LAS float* tl) {
    for (int e = 0; e < NEXP; ++e) {
        bf16_t* gu = (bf16_t*)(F.ws + WS_WEGU) + (size_t)e * 2 * DFE * DM;
        conv_mat(F, F.in(I_WEG) + (size_t)e * DM * DFE, DFE, DM, 0, DFE, gu, DM, 0, 1, e * 32, tl);
        conv_mat(F, F.in(I_WEU) + (size_t)e * DM * DFE, DFE, DM, 0, DFE, gu, DM, 128, 1, e * 32 + 96, tl);
        conv_mat(F, F.in(I_WED) + (size_t)e * DFE * DM, DM, DFE, 0, DM, (bf16_t*)(F.ws + WS_WED) + (size_t)e * DM * DFE, DFE, 0, 0, e * 32 + 192, tl);
    }
}

__device__ __forceinline__ void norm_phase(const Frame& F, int l, int which) {
    const bool n1 = which == 0;
    const int M = (which == 2) ? NL : (n1 ? MT : (l == 0 ? MT : NL));
    const bool first = n1 && l == 0;
    const float* srcL = first ? F.in(I_X) : F.out; const float* srcC = first ? F.in(I_CTX) : (const float*)(F.ws + WS_HCTX);
    const float* g = (n1 ? F.in(I_GMIX) : F.in(I_GFFN)) + l * DM;
    const float* modl = (const float*)(F.ws + WS_MOD) + (size_t)l * 9 * 6144;
    const int shoff = n1 ? MOD_SH1 : MOD_SH2, scoff = n1 ? MOD_SC1 : MOD_SC2;
    bf16_t* U = (bf16_t*)(F.ws + WS_R0);
    LAS float* W = (LAS float*)F.lds;
    LAS float* rlog = (LAS float*)(F.lds + 65536);
    LAS int* lcnt = (LAS int*)(F.lds + 65536 + 8192);
    const int ncol = n1 ? 16 : 8;
    const float* bif = F.in(I_BIF) + l * 16;
    if (which != 1) {
        const float* wsrc = n1 ? (F.in(I_WIN) + (size_t)l * DM * IN_COLS + IF_OFF) : (F.in(I_WROUTER));
        const int ld = n1 ? IN_COLS : NEXP;
        for (int idx = F.tid; idx < ncol * 1024; idx += NTHREADS) { const int k = idx / ncol, c = idx % ncol; W[c * 1024 + k] = wsrc[(size_t)k * ld + c]; }
        if (F.tid < 16) lcnt[F.tid] = 0;
        __syncthreads();
    }
    const int rpb = (M + F.G - 1) / F.G, rb0 = F.bid * rpb, rb1 = (rb0 + rpb) < M ? (rb0 + rpb) : M;
    for (int row = rb0 + F.wave; row < rb1; row += 8) {
        const bool isc = row >= NL; const float* xr = isc ? srcC + (size_t)(row - NL) * DM : srcL + (size_t)row * DM;
        const float* mr = modl + (size_t)(isc ? 8 : (row >> 12)) * 6144;
        f32x4 v[4]; float ss = 0.f;
#pragma unroll
        for (int i = 0; i < 4; ++i) { v[i] = *(const f32x4*)(xr + i * 256 + F.lane * 4); ss += v[i][0] * v[i][0] + v[i][1] * v[i][1] + v[i][2] * v[i][2] + v[i][3] * v[i][3]; }
        ss = wave_sum(ss);
        const float r = rsqrtf(ss * (1.0f / DM) + EPS);
#pragma unroll
        for (int i = 0; i < 4; ++i) { const int k = i * 256 + F.lane * 4;
            const f32x4 g4 = *(const f32x4*)(g + k), sc = *(const f32x4*)(mr + scoff + k), sh = *(const f32x4*)(mr + shoff + k);
            v[i] = (v[i] * r) * g4 * (sc + 1.0f) + sh;
            u32x2 w; w.x = cvt_pk_bf16(v[i][0], v[i][1]); w.y = cvt_pk_bf16(v[i][2], v[i][3]);
            *(u32x2*)(U + (size_t)row * DM + k) = w; }
        if (which == 0) {
            float p[16];
#pragma unroll
            for (int c = 0; c < 16; ++c) { float s = 0.f;
#pragma unroll
                for (int i = 0; i < 4; ++i) { const f32x4 w4 = *(const LAS f32x4*)(W + c * 1024 + i * 256 + F.lane * 4); s += v[i][0] * w4[0] + v[i][1] * w4[1] + v[i][2] * w4[2] + v[i][3] * w4[3]; }
                p[c] = s; }
            { const bool hi = F.lane & 32;
#pragma unroll
              for (int i = 0; i < 8; ++i) { const float keep = hi ? p[i + 8] : p[i], send = hi ? p[i] : p[i + 8]; p[i] = keep + __shfl_xor(send, 32); } }
            { const bool hi = F.lane & 16;
#pragma unroll
              for (int i = 0; i < 4; ++i) { const float keep = hi ? p[i + 4] : p[i], send = hi ? p[i] : p[i + 4]; p[i] = keep + __shfl_xor(send, 16); } }
            { const bool hi = F.lane & 8;
#pragma unroll
              for (int i = 0; i < 2; ++i) { const float keep = hi ? p[i + 2] : p[i], send = hi ? p[i] : p[i + 2]; p[i] = keep + __shfl_xor(send, 8); } }
            { const bool hi = F.lane & 4; const float keep = hi ? p[1] : p[0], send = hi ? p[0] : p[1]; p[0] = keep + __shfl_xor(send, 4); }
            p[0] += __shfl_xor(p[0], 2); p[0] += __shfl_xor(p[0], 1);
            if ((F.lane & 3) == 0) { const int c = ((F.lane >> 5) & 1) * 8 + ((F.lane >> 4) & 1) * 4 + ((F.lane >> 3) & 1) * 2 + ((F.lane >> 2) & 1);
                ((float*)(F.ws + WS_GATES))[(size_t)row * 16 + c] = p[0] + bif[c]; }
        } else if (which == 2) {
            float p[8];
#pragma unroll
            for (int c = 0; c < 8; ++c) { float s = 0.f;
#pragma unroll
                for (int i = 0; i < 4; ++i) { const f32x4 w4 = *(const LAS f32x4*)(W + c * 1024 + i * 256 + F.lane * 4); s += v[i][0] * w4[0] + v[i][1] * w4[1] + v[i][2] * w4[2] + v[i][3] * w4[3]; }
                p[c] = s; }
            { const bool hi = F.lane & 32;
#pragma unroll
              for (int i = 0; i < 4; ++i) { const float keep = hi ? p[i + 4] : p[i], send = hi ? p[i] : p[i + 4]; p[i] = keep + __shfl_xor(send, 32); } }
            { const bool hi = F.lane & 16;
#pragma unroll
              for (int i = 0; i < 2; ++i) { const float keep = hi ? p[i + 2] : p[i], send = hi ? p[i] : p[i + 2]; p[i] = keep + __shfl_xor(send, 16); } }
            { const bool hi = F.lane & 8; const float keep = hi ? p[1] : p[0], send = hi ? p[0] : p[1]; p[0] = keep + __shfl_xor(send, 8); }
            p[0] += __shfl_xor(p[0], 4); p[0] += __shfl_xor(p[0], 2); p[0] += __shfl_xor(p[0], 1);
            if ((F.lane & 7) == 0) { const int c = ((F.lane >> 5) & 1) * 4 + ((F.lane >> 4) & 1) * 2 + ((F.lane >> 3) & 1); rlog[(row - rb0) * 8 + c] = p[0]; }
        }
    }
    if (which == 2) {
        __syncthreads();
        const int nr = rb1 - rb0; int e0 = 0, e1 = 0, k0 = 0, k1 = 0; float p0 = 0.f, p1 = 0.f;
        const bool act = F.tid < nr;
        if (act) {
            float lg[8];
#pragma unroll
            for (int e = 0; e < 8; ++e) lg[e] = rlog[F.tid * 8 + e];
            float v0 = lg[0]; e0 = 0;
#pragma unroll
            for (int e = 1; e < 8; ++e) if (lg[e] > v0) { v0 = lg[e]; e0 = e; }
            float v1 = -3.0e38f; e1 = -1;
#pragma unroll
            for (int e = 0; e < 8; ++e) if (e != e0 && (e1 < 0 || lg[e] > v1)) { v1 = lg[e]; e1 = e; }
            p0 = 1.0f / (1.0f + __expf(v1 - v0)); p1 = 1.0f - p0;
            k0 = atomicAdd((int*)(lcnt + e0), 1); k1 = atomicAdd((int*)(lcnt + e1), 1);
        }
        __syncthreads();
        if (F.tid < 8) lcnt[8 + F.tid] = (int)__hip_atomic_fetch_add(F.ctl + CW_ECNT + 64 * F.tid, (unsigned)lcnt[F.tid], __ATOMIC_RELAXED, __HIP_MEMORY_SCOPE_AGENT);
        __syncthreads();
        if (act) { const int tok = rb0 + F.tid; int* list = (int*)(F.ws + WS_RLIST); float* prob = (float*)(F.ws + WS_RPROB);
            list[(size_t)e0 * NL + lcnt[8 + e0] + k0] = tok * 2; list[(size_t)e1 * NL + lcnt[8 + e1] + k1] = tok * 2 + 1;
            prob[tok * 2] = p0; prob[tok * 2 + 1] = p1; }
        __syncthreads();
    }
}

__device__ __forceinline__ void final_phase(const Frame& F) {
    const float* modl = (const float*)(F.ws + WS_MOD) + (size_t)1 * 9 * 6144;
    const bf16_t* Y0 = (const bf16_t*)(F.ws + WS_Y); const bf16_t* Y1 = Y0 + (size_t)NL * DM; const float* gfin = F.in(I_GFINAL);
    for (int row = F.bid * 8 + F.wave; row < NL; row += F.G * 8) {
        float* hr = F.out + (size_t)row * DM; const float* gt = modl + (size_t)(row >> 12) * 6144 + MOD_GT2;
        f32x4 v[4]; float ss = 0.f;
#pragma unroll
        for (int i = 0; i < 4; ++i) { const int k = i * 256 + F.lane * 4; v[i] = *(const f32x4*)(hr + k);
            const u32x2 a = *(const u32x2*)(Y0 + (size_t)row * DM + k), b = *(const u32x2*)(Y1 + (size_t)row * DM + k);
            const f32x4 y = (f32x4){bf_lo(a.x) + bf_lo(b.x), bf_hi(a.x) + bf_hi(b.x), bf_lo(a.y) + bf_lo(b.y), bf_hi(a.y) + bf_hi(b.y)};
            v[i] += *(const f32x4*)(gt + k) * y;
            ss += v[i][0] * v[i][0] + v[i][1] * v[i][1] + v[i][2] * v[i][2] + v[i][3] * v[i][3]; }
        ss = wave_sum(ss);
        const float r = rsqrtf(ss * (1.0f / DM) + EPS);
#pragma unroll
        for (int i = 0; i < 4; ++i) { const int k = i * 256 + F.lane * 4; *(f32x4*)(hr + k) = (v[i] * r) * *(const f32x4*)(gfin + k); }
    }
}

__device__ __forceinline__ void prep_phase(const Frame& F, int l) {
    bf16_t* QKV = (bf16_t*)(F.ws + WS_R1); const bf16_t* halo = (const bf16_t*)(F.ws + WS_HALO);
    bf16_t* KT = (bf16_t*)(F.ws + WS_KT); bf16_t* VT = (bf16_t*)(F.ws + WS_VT);
    const float* cw = F.in(I_CONV) + (size_t)l * 3 * 2048;
    LAS bf16_t* T = (LAS bf16_t*)F.lds;
    constexpr int TP = 258;
    const int cg = F.tid & 31, rg = F.tid >> 5;
    for (int un = F.bid; un < NCHUNK * 12; un += F.G) {
        const int ci = un / 12, hc = un % 12, row0 = ci * 64, col0 = hc * 256 + cg * 8;
        bool first, lastc;
        if (ci < NCHUNK_L) { first = (ci & 63) == 0; lastc = (ci & 63) == 63; } else { const int cc = ci - NCHUNK_L; first = (cc & 3) == 0; lastc = (cc & 3) == 3; }
        u32x4 ow[4];
        if (hc < 8) {
            u32x4 raw[6];
#pragma unroll
            for (int i = 0; i < 6; ++i) { const int r = rg * 4 - 1 + i;
                if (r < 0) raw[i] = first ? (u32x4){0u, 0u, 0u, 0u} : *(const u32x4*)(halo + ((size_t)(ci - 1) * 2 + 1) * 2048 + col0);
                else if (r > 63) raw[i] = lastc ? (u32x4){0u, 0u, 0u, 0u} : *(const u32x4*)(halo + ((size_t)(ci + 1) * 2 + 0) * 2048 + col0);
                else raw[i] = *(const u32x4*)(QKV + (size_t)(row0 + r) * NQKV + col0); }
            f32x4 w[3][2];
#pragma unroll
            for (int j = 0; j < 3; ++j) { w[j][0] = *(const f32x4*)(cw + j * 2048 + col0); w[j][1] = *(const f32x4*)(cw + j * 2048 + col0 + 4); }
            const float scl = hc >= 4 ? 0.0625f : 1.0f;
            f32x4 x[6][2];
#pragma unroll
            for (int i = 0; i < 6; ++i) unpack8(raw[i], x[i][0], x[i][1]);
#pragma unroll
            for (int i = 0; i < 4; ++i) { f32x4 o[2];
#pragma unroll
                for (int hh = 0; hh < 2; ++hh) { o[hh] = x[i][hh] * w[0][hh] + x[i + 1][hh] * w[1][hh] + x[i + 2][hh] * w[2][hh];
#pragma unroll
                    for (int j = 0; j < 4; ++j) o[hh][j] = silu(o[hh][j]) * scl; }
                ow[i] = pack8(o[0], o[1]); }
            __syncthreads();
#pragma unroll
            for (int i = 0; i < 4; ++i) *(u32x4*)(QKV + (size_t)(row0 + rg * 4 + i) * NQKV + col0) = ow[i];
        } else {
#pragma unroll
            for (int i = 0; i < 4; ++i) ow[i] = *(const u32x4*)(QKV + (size_t)(row0 + rg * 4 + i) * NQKV + col0);
        }
        if (hc >= 4) {
#pragma unroll
            for (int i = 0; i < 4; ++i) { LAS unsigned* tp = (LAS unsigned*)(T + (rg * 4 + i) * TP + cg * 8);
                tp[0] = ow[i].x; tp[1] = ow[i].y; tp[2] = ow[i].z; tp[3] = ow[i].w; }
            __syncthreads();
            bf16_t* dst = (hc < 8 ? KT : VT) + ((size_t)ci * 4 + (hc & 3)) * (256 * 64);
#pragma unroll
            for (int o = 0; o < 4; ++o) { const int idx = F.tid + o * NTHREADS, d = idx >> 3, sc = idx & 7; unsigned short v[8];
#pragma unroll
                for (int j = 0; j < 8; ++j) v[j] = T[(sc * 8 + j) * TP + d];
                u32x4 w; w.x = v[0] | ((unsigned)v[1] << 16); w.y = v[2] | ((unsigned)v[3] << 16); w.z = v[4] | ((unsigned)v[5] << 16); w.w = v[6] | ((unsigned)v[7] << 16);
                *(u32x4*)(dst + (size_t)d * 64 + sc * 8) = w; }
            __syncthreads();
        }
    }
}

__device__ __forceinline__ float logsigmoid(float x) { return fminf(x, 0.f) - log1pf(__expf(-fabsf(x))); }
__device__ __forceinline__ float scan_add(float v, int lane) {
#pragma unroll
    for (int o = 1; o < 64; o <<= 1) { const float t = __shfl_up(v, o); if (lane >= o) v += t; }
    return v;
}
__device__ __forceinline__ float scan_max(float v, int lane) {
#pragma unroll
    for (int o = 1; o < 64; o <<= 1) { const float t = __shfl_up(v, o); if (lane >= o) v = fmaxf(v, t); }
    return v;
}
__device__ __forceinline__ void mlstm_phase_ref(const Frame& F, int l) {
    const bf16_t* QKV = (const bf16_t*)(F.ws + WS_R1); const float* gates = (const float*)(F.ws + WS_GATES);
    LAS bf16_t* Qs = (LAS bf16_t*)F.lds;
    LAS bf16_t* Ks = (LAS bf16_t*)(F.lds + 32768);
    LAS float* Cs = (LAS float*)(F.lds + 65536);
    LAS bf16_t* Vs = (LAS bf16_t*)(F.lds + 131072);
    LAS bf16_t* Ps = (LAS bf16_t*)(F.lds + 139264);
    LAS float* sc = (LAS float*)(F.lds + 147456);
    LAS float* s_a = sc, *s_mj = sc + 64, *s_wi = sc + 128, *s_en = sc + 192, *s_wk = sc + 256, *s_den = sc + 320, *s_n = sc + 384;
    const int tid = F.tid, lane = F.lane;
    for (int un = F.bid; un < 256; un += F.G) {
        const int xcd = un & 7, q = un >> 3, seq = xcd * 8 + (q >> 2), es = q & 3;
        const int b = seq >> 3, h = (seq >> 1) & 3, dir = seq & 1;
        bf16_t* HO = (bf16_t*)(F.ws + (dir ? WS_HB : WS_HF));
        for (int i = tid; i < 256 * 64; i += NTHREADS) Cs[i] = 0.f;
        if (tid < 256) s_n[tid] = 0.f;
        float m_st = 0.f;
        __syncthreads();
        for (int step = 0; step < 68; ++step) {
            const bool isctx = step < 4; const int cidx = isctx ? step : step - 4, nch = isctx ? 4 : 64;
            const int cact = dir ? (nch - 1 - cidx) : cidx;
            const int row0 = isctx ? (NL + b * CTXL + cact * 64) : (b * SEQ + cact * 64);
#pragma unroll
            for (int o = 0; o < 4; ++o) { const int idx = tid + o * NTHREADS, r = idx >> 5, c8 = (idx & 31) * 8;
                const u32x4 qv = *(const u32x4*)(QKV + (size_t)(row0 + r) * NQKV + h * 256 + c8);
                const u32x4 kv = *(const u32x4*)(QKV + (size_t)(row0 + r) * NQKV + 1024 + h * 256 + c8);
                *(LAS u32x4*)(Qs + r * 256 + c8) = qv; *(LAS u32x4*)(Ks + r * 256 + c8) = kv; }
            { const int r = tid >> 3, c8 = (tid & 7) * 8;
              *(LAS u32x4*)(Vs + r * 64 + c8) = *(const u32x4*)(QKV + (size_t)(row0 + r) * NQKV + 2048 + h * 256 + es * 64 + c8); }
            float wc;
            { const int r = dir ? 63 - lane : lane;
              const float ig = gates[(size_t)(row0 + r) * 16 + dir * 8 + h], fp = gates[(size_t)(row0 + r) * 16 + dir * 8 + 4 + h];
              const float fc = logsigmoid(fp);
              const float bcum = scan_add(fc, lane);
              const float blast = __shfl(bcum, 63);
              const float a = ig - bcum;
              const float pmax = scan_max(a, lane);
              const float mj = fmaxf(m_st, pmax);
              const float gend = blast + a;
              const float mnew = fmaxf(blast + m_st, wave_max(gend));
              const float wk = __expf(gend - mnew);
              wc = __expf(blast + m_st - mnew);
              if (F.wave == 0) { s_a[r] = a; s_mj[r] = mj; s_wi[r] = __expf(m_st - mj); s_en[r] = __expf(-(bcum + mj)); s_wk[r] = wk; }
              m_st = mnew; }
            __syncthreads();
            { const int j = tid >> 3, sg = tid & 7; float acc[8];
#pragma unroll
              for (int i = 0; i < 8; ++i) acc[i] = 0.f;
#pragma unroll 2
              for (int kk = 0; kk < 32; ++kk) { const u32x4 qv = *(const LAS u32x4*)(Qs + j * 256 + kk * 8);
                  const float q0 = bf_lo(qv.x), q1 = bf_hi(qv.x), q2 = bf_lo(qv.y), q3 = bf_hi(qv.y), q4 = bf_lo(qv.z), q5 = bf_hi(qv.z), q6 = bf_lo(qv.w), q7 = bf_hi(qv.w);
#pragma unroll
                  for (int i = 0; i < 8; ++i) { const u32x4 kv = *(const LAS u32x4*)(Ks + (sg * 8 + i) * 256 + kk * 8);
                      acc[i] += q0 * bf_lo(kv.x) + q1 * bf_hi(kv.x) + q2 * bf_lo(kv.y) + q3 * bf_hi(kv.y) + q4 * bf_lo(kv.z) + q5 * bf_hi(kv.z) + q6 * bf_lo(kv.w) + q7 * bf_hi(kv.w); } }
              const float mjj = s_mj[j]; float rs = 0.f; float pv[8];
#pragma unroll
              for (int i = 0; i < 8; ++i) { const int s = sg * 8 + i; const bool ok = dir ? (s >= j) : (s <= j);
                  pv[i] = ok ? acc[i] * __expf(s_a[s] - mjj) : 0.f; rs += pv[i]; }
              u32x4 pw; pw.x = cvt_pk_bf16(pv[0], pv[1]); pw.y = cvt_pk_bf16(pv[2], pv[3]); pw.z = cvt_pk_bf16(pv[4], pv[5]); pw.w = cvt_pk_bf16(pv[6], pv[7]);
              *(LAS u32x4*)(Ps + j * 64 + sg * 8) = pw;
              rs += __shfl_xor(rs, 1); rs += __shfl_xor(rs, 2); rs += __shfl_xor(rs, 4);
              if (sg == 0) s_den[j] = rs; }
            __syncthreads();
            { const int e = tid & 63, jg = tid >> 6; float acc[8], qn[8];
#pragma unroll
              for (int i = 0; i < 8; ++i) { acc[i] = 0.f;
                  const u32x2 qq = *(const LAS u32x2*)(Qs + (jg * 8 + i) * 256 + e * 4); const f32x4 nn = *(const LAS f32x4*)(s_n + e * 4);
                  qn[i] = wave_sum(bf_lo(qq.x) * nn[0] + bf_hi(qq.x) * nn[1] + bf_lo(qq.y) * nn[2] + bf_hi(qq.y) * nn[3]); }
#pragma unroll 4
              for (int d = 0; d < 256; d += 2) { const float c0 = Cs[d * 64 + e], c1 = Cs[(d + 1) * 64 + e];
#pragma unroll
                  for (int i = 0; i < 8; ++i) { const unsigned qq = *(const LAS unsigned*)(Qs + (jg * 8 + i) * 256 + d); acc[i] += bf_lo(qq) * c0 + bf_hi(qq) * c1; } }
#pragma unroll
              for (int i = 0; i < 8; ++i) acc[i] *= s_wi[jg * 8 + i];
#pragma unroll 4
              for (int s = 0; s < 64; s += 2) { const float v0 = bf2f(Vs[s * 64 + e]), v1 = bf2f(Vs[(s + 1) * 64 + e]);
#pragma unroll
                  for (int i = 0; i < 8; ++i) { const unsigned pp = *(const LAS unsigned*)(Ps + (jg * 8 + i) * 64 + s); acc[i] += bf_lo(pp) * v0 + bf_hi(pp) * v1; } }
              if (!isctx || l == 0) {
#pragma unroll
                  for (int i = 0; i < 8; ++i) { const int j = jg * 8 + i; const float den = s_wi[j] * qn[i] + s_den[j];
                      HO[(size_t)(row0 + j) * DM + h * 256 + es * 64 + e] = f2bf(acc[i] / fmaxf(fabsf(den), s_en[j])); } } }
            __syncthreads();
            { const int e = tid & 63, dg = tid >> 6;
#pragma unroll 1
              for (int sh = 0; sh < 64; sh += 32) { float vv[32]; const float cf = sh == 0 ? wc : 1.0f;
#pragma unroll
                  for (int s = 0; s < 32; ++s) vv[s] = s_wk[sh + s] * bf2f(Vs[(sh + s) * 64 + e]);
#pragma unroll 1
                  for (int i = 0; i < 32; i += 2) { const int d = dg * 32 + i; float a0 = cf * Cs[d * 64 + e], a1 = cf * Cs[(d + 1) * 64 + e];
#pragma unroll
                      for (int s = 0; s < 32; ++s) { const unsigned kk = *(const LAS unsigned*)(Ks + (sh + s) * 256 + d); a0 += bf_lo(kk) * vv[s]; a1 += bf_hi(kk) * vv[s]; }
                      Cs[d * 64 + e] = a0; Cs[(d + 1) * 64 + e] = a1; } }
              if (tid < 256) { float nn = wc * s_n[tid];
                  for (int s = 0; s < 64; ++s) nn += s_wk[s] * bf2f(Ks[s * 256 + tid]);
                  s_n[tid] = nn; } }
            __syncthreads();
        }
    }
}

__device__ __forceinline__ void post_phase(const Frame& F, int l) {
    const int M = l == 0 ? MT : NL;
    bf16_t* HF = (bf16_t*)(F.ws + WS_HF); const bf16_t* HB = (const bf16_t*)(F.ws + WS_HB); const bf16_t* ZB = (const bf16_t*)(F.ws + WS_ZB);
    const float* hg = F.in(I_HGAIN) + l * DM;
    for (int row = F.bid * 8 + F.wave; row < M; row += F.G * 8) {
#pragma unroll
        for (int hh = 0; hh < 4; ++hh) { const int k = hh * 256 + F.lane * 4;
            const u32x2 a = *(const u32x2*)(HF + (size_t)row * DM + k), b = *(const u32x2*)(HB + (size_t)row * DM + k), o = *(const u32x2*)(ZB + (size_t)row * NZB + k);
            f32x4 x = (f32x4){bf_lo(a.x) + bf_lo(b.x), bf_hi(a.x) + bf_hi(b.x), bf_lo(a.y) + bf_lo(b.y), bf_hi(a.y) + bf_hi(b.y)};
            const float mu = wave_sum(x[0] + x[1] + x[2] + x[3]) * (1.0f / 256.0f);
            x -= mu;
            const float var = wave_sum(x[0] * x[0] + x[1] * x[1] + x[2] * x[2] + x[3] * x[3]) * (1.0f / 256.0f);
            const float rs = rsqrtf(var + EPS);
            const f32x4 g4 = *(const f32x4*)(hg + k), so = (f32x4){bf_lo(o.x), bf_hi(o.x), bf_lo(o.y), bf_hi(o.y)};
            x = so * ((x * rs) * g4);
            u32x2 w; w.x = cvt_pk_bf16(x[0], x[1]); w.y = cvt_pk_bf16(x[2], x[3]);
            *(u32x2*)(HF + (size_t)row * DM + k) = w; }
    }
    bf16_t* PO = (bf16_t*)(F.ws + WS_POOLED);
    LAS float* Vs = (LAS float*)F.lds;
    constexpr int VP = 132;
    const int nun = 8 * 64 * 4 + (l == 0 ? 8 * 4 * 4 : 0);
    const int c = F.tid >> 3, q = F.tid & 7;
    for (int un = F.bid; un < nun; un += F.G) {
        float xc[16]; int lo, hi, nrow; size_t orow;
        if (un < 2048) {
            const int b = un >> 8, gr = (un >> 2) & 63, g = un & 3, hw = 1 << g;
            const int rlo = (gr - hw) > 0 ? (gr - hw) : 0, rhi = (gr + hw) < 64 ? (gr + hw) : 64;
            float vs[16];
#pragma unroll
            for (int i = 0; i < 16; ++i) vs[i] = 0.f;
            for (int r = rlo; r < rhi; ++r) { const bf16_t* p = ZB + (size_t)(b * SEQ + r * 64 + c) * NZB + 3072 + g * 128 + q * 16;
                const u32x4 w0 = *(const u32x4*)p, w1 = *(const u32x4*)(p + 8); f32x4 f0, f1, f2, f3; unpack8(w0, f0, f1); unpack8(w1, f2, f3);
#pragma unroll
                for (int i = 0; i < 4; ++i) { vs[i] += f0[i]; vs[4 + i] += f1[i]; vs[8 + i] += f2[i]; vs[12 + i] += f3[i]; }
                if (r == gr) {
#pragma unroll
                    for (int i = 0; i < 4; ++i) { xc[i] = f0[i]; xc[4 + i] = f1[i]; xc[8 + i] = f2[i]; xc[12 + i] = f3[i]; } } }
#pragma unroll
            for (int i = 0; i < 4; ++i) *(LAS f32x4*)(Vs + (c + 8) * VP + q * 16 + i * 4) = (f32x4){vs[i * 4], vs[i * 4 + 1], vs[i * 4 + 2], vs[i * 4 + 3]};
            nrow = rhi - rlo; lo = (c - hw) > 0 ? (c - hw) : 0; hi = (c + hw) < 64 ? (c + hw) : 64; lo += 8; hi += 8;
            orow = (size_t)(b * SEQ + gr * 64 + c);
        } else {
            const int u2 = un - 2048, b = u2 >> 4, tb = (u2 >> 2) & 3, g = u2 & 3, hw = 1 << g, t0 = tb * 64;
            for (int pp = c; pp < 80; pp += 64) { const int t = t0 - 8 + pp; f32x4 f0 = {0.f, 0.f, 0.f, 0.f}, f1 = f0, f2 = f0, f3 = f0;
                if (t >= 0 && t < CTXL) { const bf16_t* p = ZB + (size_t)(NL + b * CTXL + t) * NZB + 3072 + g * 128 + q * 16;
                    unpack8(*(const u32x4*)p, f0, f1); unpack8(*(const u32x4*)(p + 8), f2, f3); }
                *(LAS f32x4*)(Vs + pp * VP + q * 16) = f0; *(LAS f32x4*)(Vs + pp * VP + q * 16 + 4) = f1; *(LAS f32x4*)(Vs + pp * VP + q * 16 + 8) = f2; *(LAS f32x4*)(Vs + pp * VP + q * 16 + 12) = f3;
                }
            { const int t = t0 + c; const bf16_t* p = ZB + (size_t)(NL + b * CTXL + t) * NZB + 3072 + g * 128 + q * 16; f32x4 f0, f1, f2, f3;
              unpack8(*(const u32x4*)p, f0, f1); unpack8(*(const u32x4*)(p + 8), f2, f3);
#pragma unroll
              for (int i = 0; i < 4; ++i) { xc[i] = f0[i]; xc[4 + i] = f1[i]; xc[8 + i] = f2[i]; xc[12 + i] = f3[i]; }
              const int tlo = (t - hw) > 0 ? (t - hw) : 0, thi = (t + hw) < CTXL ? (t + hw) : CTXL;
              lo = tlo - t0 + 8; hi = thi - t0 + 8; nrow = 1; orow = (size_t)(NL + b * CTXL + t); }
        }
        __syncthreads();
        { float sm[16];
#pragma unroll
          for (int i = 0; i < 16; ++i) sm[i] = 0.f;
          for (int pp = lo; pp < hi; ++pp) {
#pragma unroll
              for (int i = 0; i < 4; ++i) { const f32x4 f = *(const LAS f32x4*)(Vs + pp * VP + q * 16 + i * 4); sm[i * 4] += f[0]; sm[i * 4 + 1] += f[1]; sm[i * 4 + 2] += f[2]; sm[i * 4 + 3] += f[3]; } }
          const float inv = 1.0f / (float)(nrow * (hi - lo));
          const int g = un < 2048 ? (un & 3) : ((un - 2048) & 3);
          u32x4 w0, w1;
          w0.x = cvt_pk_bf16(sm[0] * inv - xc[0], sm[1] * inv - xc[1]); w0.y = cvt_pk_bf16(sm[2] * inv - xc[2], sm[3] * inv - xc[3]);
          w0.z = cvt_pk_bf16(sm[4] * inv - xc[4], sm[5] * inv - xc[5]); w0.w = cvt_pk_bf16(sm[6] * inv - xc[6], sm[7] * inv - xc[7]);
          w1.x = cvt_pk_bf16(sm[8] * inv - xc[8], sm[9] * inv - xc[9]); w1.y = cvt_pk_bf16(sm[10] * inv - xc[10], sm[11] * inv - xc[11]);
          w1.z = cvt_pk_bf16(sm[12] * inv - xc[12], sm[13] * inv - xc[13]); w1.w = cvt_pk_bf16(sm[14] * inv - xc[14], sm[15] * inv - xc[15]);
          bf16_t* op = PO + orow * 512 + g * 128 + q * 16;
          *(u32x4*)op = w0; *(u32x4*)(op + 8) = w1; }
        __syncthreads();
    }
}

constexpr int PH_FINAL = 49, PH_END = 50;
struct Args { const float* in[25]; float* out; unsigned char* ws; int ph_lo, ph_hi; };

template <unsigned PMASK>
__global__ void __launch_bounds__(NTHREADS, 2) fwd_kernel(Args args) {
    extern __shared__ __attribute__((aligned(16))) unsigned char lds_raw[];
    Frame F;
    F.out = args.out; F.ws = args.ws; F.ctl = (unsigned*)(args.ws + WS_CTL); F.lds = (LAS unsigned char*)lds_raw;
    F.G = gridDim.x; F.bid = blockIdx.x; F.tid = threadIdx.x; F.lane = F.tid & 63; F.wave = __builtin_amdgcn_readfirstlane(F.tid >> 6);
    volatile LAS unsigned* bst = (volatile LAS unsigned*)(F.lds + LDS_BYTES - 16);
    if (F.tid < 4) bst[F.tid] = 0u;
    __syncthreads();
    const int lo = args.ph_lo, hi = args.ph_hi;
    const bool single = (hi - lo) > 1;
    XcdBarrier bar; bar.bar = F.ctl + CW_BAR; bar.x = 0; bar.st = bst;
    if (single) bar = xcd_barrier_post(F.ctl + CW_BAR, bst);
#define IN(k) (lo <= (k) && (k) < hi)
#define PK(b) ((PMASK >> (b)) & 1u)
#define SEAM(k) do { if (IN((k) + 1) && single) xcd_barrier(bar); } while (0)

    if (PK(0) && IN(0)) { prologue_phase(F); SEAM(0); }

    for (int l = 0; l < 2; ++l) {
        const int pb = 1 + 24 * l;
        if (hi <= pb || lo >= pb + 24) continue;
        const int M = l == 0 ? MT : NL;
        const float* modl = (const float*)(F.ws + WS_MOD) + (size_t)l * 9 * 6144;
        if (PK(1) && IN(pb + 0)) { norm_phase(F, l, 0); SEAM(pb + 0); }
        if (PK(2) && IN(pb + 1)) {
            SchedDense S{(const char*)(F.ws + WS_R0), (const char*)(F.ws + WS_WQKV) + (size_t)l * NQKV * DM * 2, DM, DM, MT / 256, NQKV / 256, F.G, F.bid};
            EpiQKV E{(bf16_t*)(F.ws + WS_R1), (bf16_t*)(F.ws + WS_HALO)};
            gp::gemm_phase(F.lds, DM, S, E); SEAM(pb + 1);
        }
        if (PK(3) && IN(pb + 2)) { prep_phase(F, l); SEAM(pb + 2); }
        if (PK(4) && IN(pb + 3)) { mlstm_phase_ref(F, l); SEAM(pb + 3); }
        if (PK(5) && IN(pb + 4)) {
            SchedDense S{(const char*)(F.ws + WS_R0), (const char*)(F.ws + WS_WB) + (size_t)l * NZB * DM * 2, DM, DM, M / 256, NZB / 256, F.G, F.bid};
            EpiZB E{(bf16_t*)(F.ws + WS_ZB)};
            gp::gemm_phase(F.lds, DM, S, E); SEAM(pb + 4);
        }
        if (PK(6) && IN(pb + 5)) { post_phase(F, l); SEAM(pb + 5); }
        if (PK(7) && IN(pb + 6)) {
            { SchedDense S{(const char*)(F.ws + WS_HF), (const char*)(F.ws + WS_WPA) + (size_t)l * DM * DM * 2, DM, DM, M / 256, DM / 256, F.G, F.bid};
              EpiGate<0> E{(bf16_t*)(F.ws + WS_R0), (const bf16_t*)(F.ws + WS_ZB), 1024};
              gp::gemm_phase(F.lds, DM, S, E); }
            { SchedDense S{(const char*)(F.ws + WS_POOLED), (const char*)(F.ws + WS_WPBC) + (size_t)l * DM * 512 * 2, 512, 512, M / 256, DM / 256, F.G, F.bid};
              EpiGate<1> E{(bf16_t*)(F.ws + WS_R0), (const bf16_t*)(F.ws + WS_ZB), 2048};
              gp::gemm_phase(F.lds, 512, S, E); }
            SEAM(pb + 6);
        }
        if (PK(8) && IN(pb + 7)) {
            SchedDense S{(const char*)(F.ws + WS_R0), (const char*)(F.ws + WS_WOUT) + (size_t)l * DM * DM * 2, DM, DM, M / 256, DM / 256, F.G, F.bid};
            EpiResid E{l == 0 ? F.in(I_X) : F.out, F.out, l == 0 ? F.in(I_CTX) : (const float*)(F.ws + WS_HCTX), (float*)(F.ws + WS_HCTX), modl, MOD_GT1};
            gp::gemm_phase(F.lds, DM, S, E); SEAM(pb + 7);
        }
        if (PK(9) && IN(pb + 8)) {
            norm_phase(F, l, l == 0 ? 1 : 2);
            if (l == 1) expert_convert(F, (LAS float*)(F.lds + 81920));
            SEAM(pb + 8);
        }
        if (l == 0) {
            if (PK(10) && IN(pb + 9)) {
                SchedDense S{(const char*)(F.ws + WS_R0), (const char*)(F.ws + WS_WFGU), DM, DM, MT / 256, 2 * DFF / 256, F.G, F.bid};
                EpiSwiglu E{(bf16_t*)(F.ws + WS_ACT), DFF};
                gp::gemm_phase(F.lds, DM, S, E); SEAM(pb + 9);
            }
            if (PK(11) && IN(pb + 10)) {
                SchedDense S{(const char*)(F.ws + WS_ACT), (const char*)(F.ws + WS_WFD), DFF, DFF, MT / 256, DM / 256, F.G, F.bid};
                EpiResid E{F.out, F.out, (const float*)(F.ws + WS_HCTX), (float*)(F.ws + WS_HCTX), modl, MOD_GT2};
                gp::gemm_phase(F.lds, DFF, S, E); SEAM(pb + 10);
            }
        } else {
            for (int r = 0; r < MOE_ROUNDS; ++r) {
                if (!IN(pb + 11 + 2 * r) && !IN(pb + 12 + 2 * r)) continue;
                const int ttot = moe_build_table(F);
                int ntile = ttot - r * MOE_RT; ntile = ntile > MOE_RT ? MOE_RT : ntile;
                if (PK(12) && IN(pb + 11 + 2 * r)) {
                    SchedMoe1 S{(const char*)(F.ws + WS_R0), (const char*)(F.ws + WS_WEGU), (const int*)(F.ws + WS_RLIST), (LAS const int*)(F.lds + LDS_MOE_TAB), DM, DM, F.G, F.bid, r * MOE_RT, ntile};
                    EpiSwiglu E{(bf16_t*)(F.ws + WS_MACT), DFE};
                    gp::gemm_phase(F.lds, DM, S, E); SEAM(pb + 11 + 2 * r);
                }
                if (PK(13) && IN(pb + 12 + 2 * r)) {
                    SchedMoe2 S{(const char*)(F.ws + WS_MACT), (const char*)(F.ws + WS_WED), (LAS const int*)(F.lds + LDS_MOE_TAB), DFE, DFE, F.G, F.bid, r * MOE_RT, ntile};
                    EpiMoe2 E{(bf16_t*)(F.ws + WS_Y), (const int*)(F.ws + WS_RLIST), (const float*)(F.ws + WS_RPROB)};
                    gp::gemm_phase(F.lds, DFE, S, E);
                    if (r + 1 < MOE_ROUNDS) SEAM(pb + 12 + 2 * r); else { if (single) xcd_barrier(bar); }
                }
            }
        }
    }
    if (PK(14) && IN(PH_FINAL)) final_phase(F);
#undef IN
#undef SEAM
}

extern "C" void kernel_launch(void* const* d_in, const int* in_sizes, int n_in, void* d_out, int out_size, void* d_ws, size_t ws_size, hipStream_t stream) {
    static int grid = 0;
    if (grid == 0) {
        if (n_in != 25 || out_size != NL * DM || ws_size < WS_END) { fprintf(stderr, "kernel_launch: unexpected shapes (n_in %d out %d ws %zu need %zu)\n", n_in, out_size, ws_size, (size_t)WS_END); grid = -1; return; }
        int dev = 0, cus = 0, per_cu = 0;
        if (hipGetDevice(&dev) != hipSuccess || hipDeviceGetAttribute(&cus, hipDeviceAttributeMultiprocessorCount, dev) != hipSuccess) { grid = -1; return; }
        const void* ks[16] = { (const void*)fwd_kernel<1u << 0>, (const void*)fwd_kernel<1u << 1>, (const void*)fwd_kernel<1u << 2>, (const void*)fwd_kernel<1u << 3>, (const void*)fwd_kernel<1u << 4>,
            (const void*)fwd_kernel<1u << 5>, (const void*)fwd_kernel<1u << 6>, (const void*)fwd_kernel<1u << 7>, (const void*)fwd_kernel<1u << 8>, (const void*)fwd_kernel<1u << 9>, (const void*)fwd_kernel<1u << 10>,
            (const void*)fwd_kernel<1u << 11>, (const void*)fwd_kernel<1u << 12>, (const void*)fwd_kernel<1u << 13>, (const void*)fwd_kernel<1u << 14>,
#if MK_MULTI
            nullptr };
#else
            (const void*)fwd_kernel<0xFFFFFFFFu> };
#endif
        for (int i = 0; i < (MK_MULTI ? 15 : 16); ++i) { if (!MK_MULTI && i < 15) continue;
            if (hipFuncSetAttribute(ks[i], hipFuncAttributeMaxDynamicSharedMemorySize, LDS_BYTES) != hipSuccess) { fprintf(stderr, "kernel_launch: hipFuncSetAttribute failed\n"); grid = -1; return; }
            if (hipOccupancyMaxActiveBlocksPerMultiprocessor(&per_cu, ks[i], NTHREADS, LDS_BYTES) != hipSuccess || per_cu < 1) { fprintf(stderr, "kernel_launch: occupancy query says %d\n", per_cu); (void)hipGetLastError(); grid = -1; return; } }
        grid = cus;
    }
    if (grid < 0) return;
    (void)in_sizes;
    (void)hipMemsetAsync((char*)d_ws + WS_CTL, 0, CTL_BYTES, stream);
    Args a{};
    for (int i = 0; i < 25; ++i) a.in[i] = (const float*)d_in[i];
    a.out = (float*)d_out; a.ws = (unsigned char*)d_ws;
#if MK_MULTI
    for (int p = 0; p < PH_END; ++p) {
        const int rel = p == 0 ? -1 : (p - 1) % 24, l = p == 0 ? -1 : (p - 1) / 24;
        int kind;
        if (p == 0) kind = 0; else if (p == PH_FINAL) kind = 14;
        else { if (l > 1) continue; if (l == 0 && rel > 10) continue; if (l == 1 && (rel == 9 || rel == 10 || rel > 20)) continue;
            kind = rel <= 10 ? rel + 1 : (((rel - 11) & 1) ? 13 : 12); }
        a.ph_lo = p; a.ph_hi = p + 1;
        switch (kind) {
#define LK(K) case K: hipLaunchKernelGGL(fwd_kernel<1u << K>, dim3(grid), dim3(NTHREADS), LDS_BYTES, stream, a); break;
            LK(0) LK(1) LK(2) LK(3) LK(4) LK(5) LK(6) LK(7) LK(8) LK(9) LK(10) LK(11) LK(12) LK(13) LK(14)
#undef LK
        }
    }
#else
    a.ph_lo = 0; a.ph_hi = PH_END;
    hipLaunchKernelGGL(fwd_kernel<0xFFFFFFFFu>, dim3(grid), dim3(NTHREADS), LDS_BYTES, stream, a);
#endif
}
```

```cpp
#include <hip/hip_runtime.h>
#include <stdint.h>
#include <stdio.h>

#ifndef MK_MULTI
#define MK_MULTI 0
#endif

#define LAS __attribute__((address_space(3)))
typedef unsigned short bf16_t;
typedef short bf16x8 __attribute__((ext_vector_type(8)));
typedef float f32x4 __attribute__((ext_vector_type(4)));
typedef float f32x2 __attribute__((ext_vector_type(2)));
typedef unsigned u32x4 __attribute__((ext_vector_type(4)));
typedef unsigned u32x2 __attribute__((ext_vector_type(2)));
typedef int i32x4 __attribute__((ext_vector_type(4)));
typedef int i32x8 __attribute__((ext_vector_type(8)));

constexpr int BATCH = 8, SEQ = 4096, DM = 1024, CTXL = 256;
constexpr int NL = BATCH * SEQ;
constexpr int NCX = BATCH * CTXL;
constexpr int MT = NL + NCX;
constexpr int HEADS = 4, DH = 256, CHUNK = 64;
constexpr int IN_COLS = 6672, O_OFF = 3072, IF_OFF = 4096, POOL_OFF = 4112, GA_OFF = 4624, GB_OFF = 5648;
constexpr int DFF = 2816, NEXP = 8, DFE = 3584;
constexpr int NQKV = 3072, NZB = 3584;
constexpr int NCHUNK_L = NL / CHUNK;
constexpr int NCHUNK = MT / CHUNK;
constexpr float EPS = 1e-6f;
constexpr int NTHREADS = 512;
constexpr int LDS_BYTES = 163840;
#ifndef FP8_MOE
#define FP8_MOE 1
#endif
#if FP8_MOE
constexpr int MOE_RT = 264;
constexpr int MOE_ROUNDS = 1;
#else
constexpr int MOE_RT = 64;
constexpr int MOE_ROUNDS = 5;
#endif

#ifndef FP8_MOE
#define FP8_MOE 1
#endif
#define FP8_MOE_DEFAULT FP8_MOE
#ifndef MLSTM_TR
#define MLSTM_TR 1
#endif
constexpr size_t al256(size_t x) { return (x + 255) & ~(size_t)255; }
constexpr size_t WS_CTL = 0;
constexpr size_t CTL_BYTES = 65536;
constexpr size_t WS_MOD = WS_CTL + CTL_BYTES;
constexpr size_t WS_GATES = al256(WS_MOD + (size_t)2 * 9 * 6144 * 4);
constexpr size_t WS_HALO = al256(WS_GATES + (size_t)MT * 16 * 4);
constexpr size_t WS_HCTX = al256(WS_HALO + (size_t)NCHUNK * 2 * 2048 * 2);
constexpr size_t WS_RPROB = al256(WS_HCTX + (size_t)NCX * DM * 4);
constexpr size_t WS_RLIST = al256(WS_RPROB + (size_t)NL * 2 * 4);
constexpr size_t WS_GSC = al256(WS_RLIST + (size_t)NEXP * NL * 4);
constexpr size_t WS_WQKV = al256(WS_GSC + (size_t)NCHUNK * 8 * 64 * 16);
constexpr size_t WS_WB = al256(WS_WQKV + (size_t)2 * NQKV * DM * 2);
constexpr size_t WS_WPA = al256(WS_WB + (size_t)2 * NZB * DM * 2);
constexpr size_t WS_WPBC = al256(WS_WPA + (size_t)2 * DM * DM * 2);
constexpr size_t WS_WOUT = al256(WS_WPBC + (size_t)2 * DM * 512 * 2);
constexpr size_t WS_WFGU = al256(WS_WOUT + (size_t)2 * DM * DM * 2);
constexpr size_t WS_WFD = al256(WS_WFGU + (size_t)2 * DFF * DM * 2);
constexpr size_t WS_ARENA = al256(WS_WFD + (size_t)DM * DFF * 2);
constexpr size_t R0_BYTES = (size_t)MT * DM * 2;
constexpr size_t WS_R0 = WS_ARENA;
constexpr size_t WS_R1 = WS_R0 + R0_BYTES;
constexpr size_t WS_R2 = WS_R1 + (size_t)MT * NQKV * 2;
constexpr size_t WS_R3 = WS_R2 + 2 * R0_BYTES;
constexpr size_t WS_END = WS_R3 + 2 * R0_BYTES;
constexpr size_t WS_KT = WS_R2, WS_VT = WS_R2 + R0_BYTES;
constexpr size_t WS_HF = WS_R3, WS_HB = WS_R3 + R0_BYTES;
constexpr size_t WS_ZS = WS_R2;
constexpr size_t WS_ZP = WS_ZS + (size_t)MT * 3072;
constexpr int HLD = 2048;
constexpr size_t WS_HC16 = WS_END;
constexpr size_t WS_END2 = WS_HC16 + (size_t)NCX * HLD * 2;
constexpr size_t WS_ACAT = WS_R1;
constexpr int KCAT = 1536;
constexpr size_t WS_WCAT = WS_WPA;
static_assert(WS_WPBC == WS_WPA + (size_t)2 * DM * DM * 2 && WS_WOUT >= WS_WCAT + (size_t)2 * DM * KCAT * 2, "concatenated merge weights");
static_assert(WS_ZP + (size_t)MT * 512 * 2 <= WS_R3, "gate planes + pool projection fit the old K^T/V^T region");
constexpr size_t WS_ACT = WS_R1;
constexpr size_t WS_WEGU = WS_R1;
constexpr size_t ES_MOE = FP8_MOE ? 1 : 2;
constexpr size_t WS_WED = WS_WEGU + (size_t)NEXP * 2 * DFE * DM * ES_MOE;
constexpr size_t WS_MACT = WS_WED + (size_t)NEXP * DM * DFE * ES_MOE;
constexpr size_t WS_Y = WS_R3;
constexpr size_t MACT_BYTES = (size_t)MOE_RT * 256 * DFE * 2;
static_assert(WS_MACT + (MOE_ROUNDS > 1 ? 2 : 1) * (FP8_MOE_DEFAULT ? MACT_BYTES / 2 : MACT_BYTES) <= WS_R3, "MoE overlay (activation buffers)");
static_assert((size_t)2 * NL * DM * 2 <= 2 * R0_BYTES, "Y overlay");

constexpr int CW_BAR = 0;
constexpr int CW_ECNT = 4096;
constexpr int CW_ERR = 8192;
#ifndef DEPMASK
#define DEPMASK 7u
#endif
constexpr int CW_NONCANON = 8256;
constexpr int CW_DEP_MERGE = 10240;
constexpr int CW_DEP_FFN = 10752;
constexpr int CW_DEP_MOE = 11264;

#ifndef FP8_MOE
#define FP8_MOE 1
#endif
#ifndef FP8_FFN2
#define FP8_FFN2 1
#endif
#ifndef FP8_DENSE
#define FP8_DENSE 0
#endif
constexpr float WSCALE = 64.0f, WSCALE_INV = 1.0f / 64.0f;
__device__ __forceinline__ unsigned pack4_fp8(float a, float b, float c, float d) {
    a = __builtin_amdgcn_fmed3f(a, -448.f, 448.f); b = __builtin_amdgcn_fmed3f(b, -448.f, 448.f); c = __builtin_amdgcn_fmed3f(c, -448.f, 448.f); d = __builtin_amdgcn_fmed3f(d, -448.f, 448.f);
    int w = __builtin_amdgcn_cvt_pk_fp8_f32(a, b, 0, false); w = __builtin_amdgcn_cvt_pk_fp8_f32(c, d, w, true); return (unsigned)w; }
__device__ __forceinline__ unsigned cvt_pk_bf16(float lo, float hi) { unsigned r; asm("v_cvt_pk_bf16_f32 %0, %1, %2" : "=v"(r) : "v"(lo), "v"(hi)); return r; }
__device__ __forceinline__ float bf_lo(unsigned w) { return __uint_as_float(w << 16); }
__device__ __forceinline__ float bf_hi(unsigned w) { return __uint_as_float(w & 0xffff0000u); }
__device__ __forceinline__ float bf2f(bf16_t b) { return __uint_as_float(((unsigned)b) << 16); }
__device__ __forceinline__ bf16_t f2bf(float f) { return (bf16_t)(cvt_pk_bf16(f, 0.f) & 0xffffu); }
__device__ __forceinline__ float sigm(float x) { return __builtin_amdgcn_rcpf(1.0f + __expf(-x)); }
__device__ __forceinline__ float silu(float x) { return x * __builtin_amdgcn_rcpf(1.0f + __expf(-x)); }
__device__ __forceinline__ float lx_xor(float v, int m, int lane) { return __int_as_float(__builtin_amdgcn_ds_bpermute((lane ^ m) << 2, __float_as_int(v))); }
__device__ __forceinline__ float lx_up(float v, int o, int lane) { return __int_as_float(__builtin_amdgcn_ds_bpermute((lane - o) << 2, __float_as_int(v))); }
__device__ __forceinline__ float lx_idx(float v, int src) { return __int_as_float(__builtin_amdgcn_ds_bpermute(src << 2, __float_as_int(v))); }
#define DPP_F(v, ctrl) __int_as_float(__builtin_amdgcn_update_dpp(0, __float_as_int(v), ctrl, 0xf, 0xf, true))
#define RDL_F(v, l) __int_as_float(__builtin_amdgcn_readlane(__float_as_int(v), l))
__device__ __forceinline__ float wave_sum(float v, int) {
    v += DPP_F(v, 0xB1); v += DPP_F(v, 0x4E); v += DPP_F(v, 0x141); v += DPP_F(v, 0x140);
    return (RDL_F(v, 0) + RDL_F(v, 16)) + (RDL_F(v, 32) + RDL_F(v, 48));
}
__device__ __forceinline__ float wave_max(float v, int) {
    v = fmaxf(v, DPP_F(v, 0xB1)); v = fmaxf(v, DPP_F(v, 0x4E)); v = fmaxf(v, DPP_F(v, 0x141)); v = fmaxf(v, DPP_F(v, 0x140));
    return fmaxf(fmaxf(RDL_F(v, 0), RDL_F(v, 16)), fmaxf(RDL_F(v, 32), RDL_F(v, 48)));
}

#define XB_TMO      128
#define XB_XCNT(j)  (256  + 64 * (j))
#define XB_XSUB(j)  (1280 + 64 * (j))
#define XB_XGEN(j)  (2304 + 64 * (j))
#define XB_TOP      3328
#define XB_TOPGEN   3392
#define XCD_BAR_WORDS 3456
#define XB_SPIN_CAP (1u << 18)

__device__ __forceinline__ unsigned xb_ld(unsigned* p)              { return __hip_atomic_load(p, __ATOMIC_RELAXED, __HIP_MEMORY_SCOPE_AGENT); }
__device__ __forceinline__ unsigned xb_add(unsigned* p, unsigned v) { return __hip_atomic_fetch_add(p, v, __ATOMIC_RELAXED, __HIP_MEMORY_SCOPE_AGENT); }
__device__ __forceinline__ unsigned xb_xcc_id() { return (unsigned)__builtin_amdgcn_s_getreg((3 << 11) | 20) & 0xFu; }
__device__ __forceinline__ void dep_spin(unsigned* p, unsigned need) { unsigned sp = 0; while (xb_ld(p) < need) { __builtin_amdgcn_s_sleep(2); if (++sp > (1u << 20)) break; } }
#define XB_SPIN(cond, bar) do { unsigned _sp = 0; while (cond) { __builtin_amdgcn_s_sleep(1); \
    if ((++_sp & 255u) == 0u) { if (xb_ld(&(bar)[XB_TMO])) break; if (_sp > XB_SPIN_CAP) { atomicAdd(&(bar)[XB_TMO], 1u); break; } } } } while (0)

struct XcdBarrier { unsigned* bar; unsigned x; volatile LAS unsigned* st; };

__device__ __forceinline__ XcdBarrier xcd_barrier_post(unsigned* bar, volatile LAS unsigned* st) {
    XcdBarrier b; b.bar = bar; b.x = xb_xcc_id(); b.st = st;
    if (threadIdx.x == 0) (void)xb_add(&bar[XB_XCNT(b.x)], 1u);
    return b;
}
__device__ __forceinline__ void xcd_barrier_complete(unsigned* bar, unsigned x, unsigned& nloc, unsigned& nx) {
    const unsigned G = gridDim.x * gridDim.y * gridDim.z;
    unsigned sum, cnt, mine, sp = 0u;
    for (;;) {
        sum = 0u; cnt = 0u; mine = 0u;
#pragma unroll
        for (unsigned j = 0; j < 16; ++j) { const unsigned c = xb_ld(&bar[XB_XCNT(j)]); sum += c; cnt += (c > 0u) ? 1u : 0u; mine = (j == x) ? c : mine; }
        if (sum == G) break;
        __builtin_amdgcn_s_sleep(1);
        if ((++sp & 255u) == 0u) { if (xb_ld(&bar[XB_TMO])) break; if (sp > XB_SPIN_CAP) { atomicAdd(&bar[XB_TMO], 1u); break; } }
    }
    nloc = mine > 0u ? mine : 1u; nx = cnt > 0u ? cnt : 1u;
}
__device__ __forceinline__ void xcd_barrier(const XcdBarrier& b, const bool thread0) {
    asm volatile("s_waitcnt vmcnt(0)" ::: "memory");
    __syncthreads();
    if (thread0) {
        unsigned* bar = b.bar;
        __builtin_amdgcn_s_waitcnt(0);
        unsigned nloc = b.st[0], nx = b.st[1];
        if (nloc == 0u) { xcd_barrier_complete(bar, b.x, nloc, nx); b.st[0] = nloc; b.st[1] = nx; }
        const unsigned old = xb_add(&bar[XB_XSUB(b.x)], 1u);
        const unsigned gen = old / nloc;
        if (old + 1u == (gen + 1u) * nloc) {
            __builtin_amdgcn_fence(__ATOMIC_RELEASE, "agent");
            asm volatile("s_waitcnt vmcnt(0)" ::: "memory");
            const unsigned og = xb_add(&bar[XB_TOP], 1u);
            const unsigned tg = og / nx;
            if (og + 1u == (tg + 1u) * nx) xb_add(&bar[XB_TOPGEN], 1u);
            else XB_SPIN(xb_ld(&bar[XB_TOPGEN]) == tg, bar);
            __builtin_amdgcn_fence(__ATOMIC_ACQUIRE, "agent");
            xb_add(&bar[XB_XGEN(b.x)], 1u);
            asm volatile("s_waitcnt vmcnt(0)" ::: "memory");
        } else {
            XB_SPIN(xb_ld(&bar[XB_XGEN(b.x)]) == gen, bar);
            __builtin_amdgcn_fence(__ATOMIC_ACQUIRE, "agent");
            asm volatile("s_waitcnt vmcnt(0)" ::: "memory");
        }
    }
    __syncthreads();
}

typedef const char __attribute__((address_space(4)))* karg_t;
__device__ __forceinline__ const float* karg_in(int i) {
    karg_t ka = (karg_t)__builtin_amdgcn_kernarg_segment_ptr();
    unsigned long long v;
    asm volatile("s_load_dwordx2 %0, %1, %2\n\ts_waitcnt lgkmcnt(0)" : "=s"(v) : "s"(ka), "s"(i * 8) : "memory");
    return (const float*)(const __attribute__((address_space(1))) float*)v;
}
namespace gp {
constexpr int BM = 256, BK = 64, HALF = 128, HTB = HALF * BK * 2, STAGE_BYTES = 8 * HTB, NXCD = 8, WGM = 8;
constexpr int LDS_GV = 135168;
__device__ __forceinline__ int lds_byte(int r, int c) { const int st = (r >> 4) * 2 + (c >> 5), rr = r & 15, cc = c & 31, ob = rr * 64 + cc * 2; return st * 1024 + (ob ^ (((ob >> 9) & 1) << 5)); }
__device__ __forceinline__ void stage_rc(int b, int& R, int& C) { const int st = b / 1024, sb = b % 1024, swz = sb ^ (((sb >> 9) & 1) << 5); R = (st >> 1) * 16 + swz / 64; C = (st & 1) * 32 + (swz % 64) / 2; }
__device__ __forceinline__ int perm32(int rho) { const int n = rho >> 4, i = rho & 15; return 8 * (i >> 2) + 4 * n + (i & 3); }

struct Unit { int pm, pn, ex, cnt; };

__device__ __forceinline__ bool static_next(int i, int G, int c, int nM, int nN, int& pm, int& pn) {
    const int nwg = nM * nN;
    const long L = (long)i * G + c; if (L >= nwg) return false;
    int wgid = (int)L; { const int q = nwg / NXCD, r = nwg % NXCD, xcd = wgid % NXCD, off = wgid / NXCD; wgid = (xcd < r ? xcd * (q + 1) : r * (q + 1) + (xcd - r) * q) + off; }
    const int nig = WGM * nN, gid = wgid / nig, fm = gid * WGM, gsz = (nM - fm) < WGM ? (nM - fm) : WGM;
    pm = fm + ((wgid % nig) % gsz); pn = (wgid % nig) / gsz; return true;
}

__device__ __forceinline__ bool chunk_next(int i, int G, int c, int nM, int nN, int& pm, int& pn) {
    const int x = c % NXCD, slot = c / NXCD, nslots = (G - x + NXCD - 1) / NXCD;
    const int r0 = x * nM / NXCD, nr = (x + 1) * nM / NXCD - r0;
    const int off = i * nslots + slot; if (off >= nr * nN) return false;
    const int nig = WGM * nN, gid = off / nig, fm = gid * WGM, gsz = (nr - fm) < WGM ? (nr - fm) : WGM;
    pm = r0 + fm + ((off % nig) % gsz); pn = (off % nig) / gsz; return true;
}

template <int FP8, class Epi, class Sched>
__device__ __forceinline__ void gemm_phase(LAS unsigned char* lds, const int Kb, const Sched& S, const Epi& E, const int tid) {
    const int wid = __builtin_amdgcn_readfirstlane(tid >> 6), lane = tid & 63, wr = wid >> 2, wc = wid & 3, fr = lane & 15, fq = lane >> 4;
    const int nt = Kb / (BK * 2);
    const int lda = S.lda, ldb = S.ldb;
    unsigned voffA[2], voffB[2];
#pragma unroll
    for (int i = 0; i < 2; ++i) { int R, C; stage_rc(tid * 16 + i * 8192, R, C); const int Rb = Epi::PERM ? ((R & ~31) + perm32(R & 31)) : R;
        voffA[i] = (unsigned)(R * lda + C * 2); voffB[i] = (unsigned)(Rb * ldb + C * 2); }
#define GP_GATHER(dst, u_) do { _Pragma("unroll") for (int _i = 0; _i < 2; ++_i) { int _R, _C; stage_rc(tid * 16 + _i * 8192, _R, _C); \
        _Pragma("unroll") for (int _h = 0; _h < 2; ++_h) dst[_h][_i] = (unsigned)(S.arow(u_, _h * HALF + _R) * lda + _C * 2); } } while (0)
    const size_t kstep = (size_t)(BK * 2);
    const size_t hstepA = (size_t)HALF * lda, hstepB = (size_t)HALF * ldb;
    const unsigned ldsw = (unsigned)wid * 1024u;
    const int aoff = lds_byte(wr * 64 + fr, fq * 8), boff = lds_byte(wc * 32 + fr, fq * 8);
    unsigned gvc[2][2];
#define GP_SA(b, h) (((b) * 2 + (h)) * HTB)
#define GP_SB(b, h) ((4 + (b) * 2 + (h)) * HTB)
#define GP_STAGE_B(bufoff, gbase) do { _Pragma("unroll") for (int _i = 0; _i < 2; ++_i) { unsigned _vo = voffB[_i]; asm volatile("" : "+v"(_vo));     \
        __builtin_amdgcn_global_load_lds((const unsigned*)((const char*)(gbase) + _vo), (LAS unsigned*)(lds + (bufoff) + ldsw + _i * 8192), 16, 0, 0); } } while (0)
#define GP_STAGE_A(bufoff, p, nx, h) do { _Pragma("unroll") for (int _i = 0; _i < 2; ++_i) { \
        unsigned _vo = Sched::GATHER ? gvc[h][_i] : voffA[_i]; asm volatile("" : "+v"(_vo)); \
        __builtin_amdgcn_global_load_lds((const unsigned*)((const char*)(p) + (Sched::GATHER ? (size_t)0 : (size_t)(h) * hstepA) + _vo), (LAS unsigned*)(lds + (bufoff) + ldsw + _i * 8192), 16, 0, 0); } } while (0)
#define GP_LDA(dst, b, h) do { _Pragma("unroll") for (int m = 0; m < 4; ++m) _Pragma("unroll") for (int k = 0; k < 2; ++k) dst[m][k] = *(const LAS bf16x8*)(lds + GP_SA(b, h) + aoff + m * 2048 + k * 1024); } while (0)
#define GP_LDB(dst, b, h) do { _Pragma("unroll") for (int n = 0; n < 2; ++n) _Pragma("unroll") for (int k = 0; k < 2; ++k) dst[n][k] = *(const LAS bf16x8*)(lds + GP_SB(b, h) + boff + n * 2048 + k * 1024); } while (0)
#define GP_MMA(ai, bj, At, Bt) do { __builtin_amdgcn_s_setprio(1); _Pragma("unroll") for (int m = 0; m < 4; ++m) _Pragma("unroll") for (int n = 0; n < 2; ++n) { \
        if (FP8) { const i32x8 _b = __builtin_shufflevector(__builtin_bit_cast(i32x4, Bt[n][0]), __builtin_bit_cast(i32x4, Bt[n][1]), 0, 1, 2, 3, 4, 5, 6, 7); \
                   const i32x8 _a = __builtin_shufflevector(__builtin_bit_cast(i32x4, At[m][0]), __builtin_bit_cast(i32x4, At[m][1]), 0, 1, 2, 3, 4, 5, 6, 7); \
                   asm volatile("v_mfma_f32_16x16x128_f8f6f4 %0, %1, %2, %0" : "+v"(acc[ai][bj][m][n]) : "v"(_b), "v"(_a)); }     \
        else { _Pragma("unroll") for (int k = 0; k < 2; ++k) acc[ai][bj][m][n] = __builtin_amdgcn_mfma_f32_16x16x32_bf16(Bt[n][k], At[m][k], acc[ai][bj][m][n], 0, 0, 0); } } \
        __builtin_amdgcn_s_setprio(0); } while (0)
#define GP_WAIT_V(n) asm volatile("s_waitcnt vmcnt(" #n ")" ::: "memory")
#define GP_WAIT_L(n) asm volatile("s_waitcnt lgkmcnt(" #n ")" ::: "memory")
#define GP_BAR __builtin_amdgcn_s_barrier()
#define GP_SCHED __builtin_amdgcn_sched_barrier(0)
    Unit cur, nxt; int ui = 0;
    if (!S.next(0, cur)) return;
    f32x4 acc[2][2][4][2];
#pragma unroll
    for (int a = 0; a < 2; ++a)
#pragma unroll
        for (int b = 0; b < 2; ++b)
#pragma unroll
            for (int m = 0; m < 4; ++m)
#pragma unroll
                for (int n = 0; n < 2; ++n) acc[a][b][m][n] = (f32x4){0.f, 0.f, 0.f, 0.f};
    bf16x8 At[4][2], B0[2][2], B1[2][2];
    const char* cA = S.aptr(cur); const char* cB = S.bptr(cur);
    if (Sched::GATHER) GP_GATHER(gvc, cur);
    int sig_pm = -1;
#define GP_CTL() ((unsigned*)((unsigned char*)karg_in(26) + WS_CTL))
#define GP_SIGNAL(pm_) do { if (lane == 0) (void)xb_add(GP_CTL() + S.depw + (pm_), 1u); } while (0)
#define GP_AWAIT(pm_) do { if (wid == 0) dep_spin(GP_CTL() + S.depw + (pm_), S.need); } while (0)
    if constexpr (Sched::DEP == 2) { GP_AWAIT(cur.pm); GP_BAR; }
    GP_STAGE_B(GP_SB(0, 0), cB); GP_STAGE_A(GP_SA(0, 0), cA, false, 0); GP_STAGE_B(GP_SB(0, 1), cB + hstepB); GP_STAGE_A(GP_SA(0, 1), cA, false, 1);
    if (wr == 1) GP_BAR;
    GP_WAIT_V(4); GP_BAR;
    GP_STAGE_B(GP_SB(1, 0), cB + kstep); GP_STAGE_A(GP_SA(1, 0), cA + kstep, false, 0); GP_STAGE_B(GP_SB(1, 1), cB + hstepB + kstep);
    GP_WAIT_V(6); GP_BAR;
    for (;;) {
        const bool has_next = S.next(ui + 1, nxt);
        const char* nA = has_next ? S.aptr(nxt) : cA; const char* nB = has_next ? S.bptr(nxt) : cB;
        if (Sched::GATHER && has_next) { unsigned gn[2][2]; GP_GATHER(gn, nxt); *(LAS u32x4*)(lds + LDS_GV + tid * 16) = (u32x4){gn[0][0], gn[0][1], gn[1][0], gn[1][1]}; }
        for (int t = 0; t < nt; t += 2) {
            const bool last = (t == nt - 2);
            if constexpr (Epi::MID_T > 0) { if (t == Epi::MID_T) { int t3 = tid; asm volatile("" : "+v"(t3)); E.mid(acc, cur, wr, wc, t3 & 15, (t3 & 63) >> 4); } }
            const char* a1 = cA + (size_t)(t + 1) * kstep;
            const char* a2 = last ? nA : cA + (size_t)(t + 2) * kstep; const char* b2 = last ? nB : cB + (size_t)(t + 2) * kstep;
            const char* a3 = a2 + kstep; const char* b3 = b2 + kstep;
            if constexpr (Sched::DEP == 2) { if (last && has_next) GP_AWAIT(nxt.pm); }
            GP_LDB(B0, 0, 0); GP_SCHED; GP_LDA(At, 0, 0); GP_STAGE_A(GP_SA(1, 1), a1, false, 1);
            GP_WAIT_L(8); GP_BAR; GP_WAIT_L(0); GP_MMA(0, 0, At, B0); GP_BAR; GP_SCHED;
            if (Sched::GATHER && last && has_next) { const u32x4 gq = *(const LAS u32x4*)(lds + LDS_GV + tid * 16); gvc[0][0] = gq.x; gvc[0][1] = gq.y; gvc[1][0] = gq.z; gvc[1][1] = gq.w; }
            GP_LDB(B1, 0, 1); GP_STAGE_B(GP_SB(0, 0), b2);
            GP_BAR; GP_WAIT_L(0); GP_MMA(0, 1, At, B1); GP_BAR;
            GP_LDA(At, 0, 1); GP_STAGE_A(GP_SA(0, 0), a2, last, 0);
            GP_BAR; GP_WAIT_L(0); GP_MMA(1, 0, At, B0); GP_BAR; GP_SCHED;
            GP_STAGE_B(GP_SB(0, 1), b2 + hstepB);
            GP_WAIT_V(6); GP_BAR; GP_MMA(1, 1, At, B1); GP_BAR;
            GP_LDB(B0, 1, 0); GP_SCHED; GP_LDA(At, 1, 0); GP_STAGE_A(GP_SA(0, 1), a2, last, 1);
            GP_WAIT_L(8); GP_BAR; GP_WAIT_L(0); GP_MMA(0, 0, At, B0); GP_BAR; GP_SCHED;
            GP_LDB(B1, 1, 1); GP_STAGE_B(GP_SB(1, 0), b3);
            GP_BAR; GP_WAIT_L(0); GP_MMA(0, 1, At, B1); GP_BAR;
            GP_LDA(At, 1, 1); GP_STAGE_A(GP_SA(1, 0), a3, last, 0);
            GP_BAR; GP_WAIT_L(0); GP_MMA(1, 0, At, B0); GP_BAR; GP_SCHED;
            GP_STAGE_B(GP_SB(1, 1), b3 + hstepB);
            GP_WAIT_V(6); GP_BAR; GP_MMA(1, 1, At, B1); GP_BAR;
            if constexpr (Sched::DEP == 1) {
                if (t == 0 && sig_pm >= 0) { GP_SIGNAL(sig_pm); sig_pm = -1; } }
        }
        if (FP8) asm volatile("s_nop 15\n\ts_nop 15" ::: "memory");
        { int t2 = tid; asm volatile("" : "+v"(t2));
          E(acc, cur, wr, wc, t2 & 15, (t2 & 63) >> 4); }
        if constexpr (Sched::DEP == 1) sig_pm = cur.pm;
        if (!has_next) break;
#pragma unroll
        for (int a = 0; a < 2; ++a)
#pragma unroll
            for (int b = 0; b < 2; ++b)
#pragma unroll
                for (int m = 0; m < 4; ++m)
#pragma unroll
                    for (int n = 0; n < 2; ++n) acc[a][b][m][n] = (f32x4){0.f, 0.f, 0.f, 0.f};
        cur = nxt; cA = nA; cB = nB; ++ui;
    }
    GP_WAIT_V(0);
    if constexpr (Sched::DEP == 1) { if (sig_pm >= 0) GP_SIGNAL(sig_pm); }
    if (wr == 0) GP_BAR;
    GP_BAR;
#undef GP_SA
#undef GP_CTL
#undef GP_SIGNAL
#undef GP_AWAIT
#undef GP_GATHER
#undef GP_SB
#undef GP_STAGE_A
#undef GP_STAGE_B
#undef GP_LDA
#undef GP_LDB
#undef GP_MMA
#undef GP_WAIT_V
#undef GP_WAIT_L
#undef GP_BAR
#undef GP_SCHED
}
}

struct Frame {
    float* out; unsigned char* ws; unsigned* ctl; LAS unsigned char* lds;
    int G, bid, tid, lane, wave;
    __device__ __forceinline__ const float* in(int i) const { return karg_in(i); }
};
enum { I_X = 0, I_C, I_CTX, I_CCTX, I_WADA, I_BADA, I_GMIX, I_WIN, I_CONV, I_BIF, I_HGAIN, I_WPOOL, I_PSCALE, I_WPA, I_WPB, I_WOUT, I_GFFN,
       I_WFG, I_WFU, I_WFD, I_WROUTER, I_WEG, I_WEU, I_WED, I_GFINAL };
constexpr int MOD_SH1 = 0, MOD_SC1 = 1024, MOD_GT1 = 2048, MOD_SH2 = 3072, MOD_SC2 = 4096, MOD_GT2 = 5120;

template <class Base, int MODE> struct WithDep : Base { static constexpr int DEP = MODE; int depw; unsigned need; };
template <bool CH> struct SchedDenseT {
    static constexpr bool GATHER = false; static constexpr int DEP = 0;
    const char* A; const char* B; int lda, ldb, nM, nN, G, c;
    __device__ __forceinline__ bool next(int i, gp::Unit& u) const { u.ex = 0; u.cnt = 256; return CH ? gp::chunk_next(i, G, c, nM, nN, u.pm, u.pn) : gp::static_next(i, G, c, nM, nN, u.pm, u.pn); }
    __device__ __forceinline__ const char* aptr(const gp::Unit& u) const { return A + (size_t)u.pm * 256 * lda; }
    __device__ __forceinline__ const char* bptr(const gp::Unit& u) const { return B + (size_t)u.pn * 256 * ldb; }
    __device__ __forceinline__ int arow(const gp::Unit&, int) const { return 0; }
};
typedef SchedDenseT<false> SchedDense;
constexpr int LDS_MOE_TAB = 131072;
__device__ __forceinline__ int moe_build_table(const Frame& F) {
    LAS int* tab = (LAS int*)(F.lds + LDS_MOE_TAB);
    int acc = 0, myex = -1, myr0 = 0, mycnt = 0;
#pragma unroll
    for (int e = 0; e < 8; ++e) { const int c = (int)__hip_atomic_load(F.ctl + CW_ECNT + 64 * e, __ATOMIC_RELAXED, __HIP_MEMORY_SCOPE_AGENT); const int nt = (c + 255) >> 8;
        if (F.tid >= acc && F.tid < acc + nt) { myex = e; myr0 = (F.tid - acc) * 256; mycnt = c - myr0; mycnt = mycnt > 256 ? 256 : mycnt; }
        acc += nt; }
    if (myex >= 0) { tab[2 * F.tid] = myex; tab[2 * F.tid + 1] = (myr0 << 9) | mycnt; }
    __syncthreads();
    return acc;
}
struct SchedMoe1 {
    static constexpr bool GATHER = true; static constexpr int DEP = 0;
    const char* A; const char* B; const int* list; LAS const int* tab; int lda, ldb, G, c, g0, ntile;
    __device__ __forceinline__ bool next(int i, gp::Unit& u) const {
        if (ntile <= 0) return false;
        if (!((DEPMASK & 4u) ? gp::chunk_next(i, G, c, ntile, DFE / 128, u.pm, u.pn) : gp::static_next(i, G, c, ntile, DFE / 128, u.pm, u.pn))) return false;
        u.ex = __builtin_amdgcn_readfirstlane(tab[2 * (g0 + u.pm)]); u.cnt = __builtin_amdgcn_readfirstlane(tab[2 * (g0 + u.pm) + 1]);
        return true;
    }
    __device__ __forceinline__ const char* aptr(const gp::Unit&) const { return A; }
    __device__ __forceinline__ const char* bptr(const gp::Unit& u) const { return B + ((size_t)u.ex * (2 * DFE) + (size_t)u.pn * 256) * ldb; }
    __device__ __forceinline__ int arow(const gp::Unit& u, int r) const {
        const int cnt = u.cnt & 511, r0 = u.cnt >> 9;
        return r < cnt ? (list[(size_t)u.ex * NL + r0 + r] >> 1) : 0;
    }
};
struct SchedMoe2 {
    static constexpr bool GATHER = false; static constexpr int DEP = 0;
    const char* A; const char* B; LAS const int* tab; int lda, ldb, G, c, g0, ntile;
    __device__ __forceinline__ bool next(int i, gp::Unit& u) const {
        if (ntile <= 0) return false;
        if (!((DEPMASK & 4u) ? gp::chunk_next(i, G, c, ntile, DM / 256, u.pm, u.pn) : gp::static_next(i, G, c, ntile, DM / 256, u.pm, u.pn))) return false;
        u.ex = __builtin_amdgcn_readfirstlane(tab[2 * (g0 + u.pm)]); u.cnt = __builtin_amdgcn_readfirstlane(tab[2 * (g0 + u.pm) + 1]);
        return true;
    }
    __device__ __forceinline__ const char* aptr(const gp::Unit& u) const { return A + (size_t)u.pm * 256 * lda; }
    __device__ __forceinline__ const char* bptr(const gp::Unit& u) const { return B + ((size_t)u.ex * DM + (size_t)u.pn * 256) * ldb; }
    __device__ __forceinline__ int arow(const gp::Unit&, int) const { return 0; }
};

#define EPI_ARGS const f32x4 (&acc)[2][2][4][2], const gp::Unit& u, int wr, int wc, int fr, int fq
#define EPI_ROWS(ai, m) ((ai) * 128 + wr * 64 + (m) * 16 + fr)
__device__ __forceinline__ u32x4 pack8(const f32x4& a, const f32x4& b) { u32x4 w; w.x = cvt_pk_bf16(a[0], a[1]); w.y = cvt_pk_bf16(a[2], a[3]); w.z = cvt_pk_bf16(b[0], b[1]); w.w = cvt_pk_bf16(b[2], b[3]); return w; }
__device__ __forceinline__ void unpack8(const u32x4& w, f32x4& a, f32x4& b) { a = (f32x4){bf_lo(w.x), bf_hi(w.x), bf_lo(w.y), bf_hi(w.y)}; b = (f32x4){bf_lo(w.z), bf_hi(w.z), bf_lo(w.w), bf_hi(w.w)}; }

struct EpiQKV {
    static constexpr bool PERM = true; static constexpr int MID_T = 0;
    bf16_t* O; bf16_t* halo;
    __device__ __forceinline__ void operator()(EPI_ARGS) const {
        const int c8 = u.pn * 256 + wc * 32 + 8 * fq;
#pragma unroll
        for (int ai = 0; ai < 2; ++ai)
#pragma unroll
            for (int m = 0; m < 4; ++m) { const int row = u.pm * 256 + EPI_ROWS(ai, m);
#pragma unroll
                for (int bj = 0; bj < 2; ++bj) { const u32x4 w = pack8(acc[ai][bj][m][0], acc[ai][bj][m][1]);
                    *(u32x4*)(O + (size_t)row * NQKV + c8 + bj * 128) = w;
                    const int rr = row & 63;
                    if (u.pn < 8 && (rr == 0 || rr == 63)) *(u32x4*)(halo + ((size_t)(row >> 6) * 2 + (rr ? 1 : 0)) * 2048 + c8 + bj * 128) = w; } }
    }
};
__device__ __forceinline__ unsigned pack4_u8(float a, float b, float c, float d) {
    unsigned w = 0;
    w = __builtin_amdgcn_cvt_pk_u8_f32(fmaxf(__builtin_rintf(a * 255.f), 1.f), 0, w); w = __builtin_amdgcn_cvt_pk_u8_f32(fmaxf(__builtin_rintf(b * 255.f), 1.f), 1, w);
    w = __builtin_amdgcn_cvt_pk_u8_f32(fmaxf(__builtin_rintf(c * 255.f), 1.f), 2, w); w = __builtin_amdgcn_cvt_pk_u8_f32(fmaxf(__builtin_rintf(d * 255.f), 1.f), 3, w); return w; }
__device__ __forceinline__ f32x4 unpack4_u8(unsigned w) { return (f32x4){(float)(w & 0xffu), (float)((w >> 8) & 0xffu), (float)((w >> 16) & 0xffu), (float)(w >> 24)} * (1.0f / 255.0f); }
struct EpiZB {
    static constexpr bool PERM = true; static constexpr int MID_T = 0;
    unsigned char* ZS; bf16_t* ZP;
    __device__ __forceinline__ void operator()(EPI_ARGS) const {
        const int c8 = wc * 32 + 8 * fq; const bool sg = u.pn < 12;
#pragma unroll
        for (int ai = 0; ai < 2; ++ai)
#pragma unroll
            for (int m = 0; m < 4; ++m) { const int row = u.pm * 256 + EPI_ROWS(ai, m);
#pragma unroll
                for (int bj = 0; bj < 2; ++bj) { const f32x4 a = acc[ai][bj][m][0], b = acc[ai][bj][m][1];
                    if (sg) { u32x2 w; w.x = pack4_u8(sigm(a[0]), sigm(a[1]), sigm(a[2]), sigm(a[3])); w.y = pack4_u8(sigm(b[0]), sigm(b[1]), sigm(b[2]), sigm(b[3]));
                        *(u32x2*)(ZS + (size_t)row * 3072 + u.pn * 256 + c8 + bj * 128) = w; }
                    else *(u32x4*)(ZP + (size_t)row * 512 + (u.pn - 12) * 256 + c8 + bj * 128) = pack8(a, b); }
                asm volatile("" ::: "memory"); }
    }
};
struct EpiMerge {
    static constexpr bool PERM = true; static constexpr int MID_T = 16;
    bf16_t* O; const unsigned char* Z;
    __device__ __forceinline__ void mid(f32x4 (&acc)[2][2][4][2], const gp::Unit& u, int wr, int wc, int fr, int fq) const {
        const int c8 = u.pn * 256 + wc * 32 + 8 * fq;
#pragma unroll
        for (int ai = 0; ai < 2; ++ai) {
            u32x2 ga[2][4], gb[2][4];
#pragma unroll
            for (int bj = 0; bj < 2; ++bj)
#pragma unroll
                for (int m = 0; m < 4; ++m) { const unsigned char* zp = Z + (size_t)(u.pm * 256 + EPI_ROWS(ai, m)) * 3072 + c8 + bj * 128; ga[bj][m] = *(const u32x2*)(zp + 1024); gb[bj][m] = *(const u32x2*)(zp + 2048); }
#pragma unroll
            for (int bj = 0; bj < 2; ++bj)
#pragma unroll
                for (int m = 0; m < 4; ++m) { const f32x4 a0 = unpack4_u8(ga[bj][m].x), a1 = unpack4_u8(ga[bj][m].y), b0 = unpack4_u8(gb[bj][m].x), b1 = unpack4_u8(gb[bj][m].y);
#pragma unroll
                    for (int j = 0; j < 4; ++j) { acc[ai][bj][m][0][j] *= a0[j] * __builtin_amdgcn_rcpf(b0[j]); acc[ai][bj][m][1][j] *= a1[j] * __builtin_amdgcn_rcpf(b1[j]); } }
            asm volatile("" ::: "memory"); }
    }
    __device__ __forceinline__ void operator()(EPI_ARGS) const {
        const int c8 = u.pn * 256 + wc * 32 + 8 * fq;
#pragma unroll
        for (int ai = 0; ai < 2; ++ai) {
            u32x2 gb[4][2];
#pragma unroll
            for (int m = 0; m < 4; ++m)
#pragma unroll
                for (int bj = 0; bj < 2; ++bj) gb[m][bj] = *(const u32x2*)(Z + (size_t)(u.pm * 256 + EPI_ROWS(ai, m)) * 3072 + 2048 + c8 + bj * 128);
#pragma unroll
            for (int m = 0; m < 4; ++m) { const int row = u.pm * 256 + EPI_ROWS(ai, m);
#pragma unroll
                for (int bj = 0; bj < 2; ++bj) *(u32x4*)(O + (size_t)row * DM + c8 + bj * 128) = pack8(acc[ai][bj][m][0] * unpack4_u8(gb[m][bj].x), acc[ai][bj][m][1] * unpack4_u8(gb[m][bj].y)); }
            asm volatile("" ::: "memory"); }
    }
};
template <bool SRC32> struct EpiResid {
    static constexpr bool PERM = true; static constexpr int MID_T = 0;
    const void* srcL; bf16_t* dstL; const void* srcC; bf16_t* dstC; const float* modl; int gtoff; float sin;
    __device__ __forceinline__ void operator()(EPI_ARGS) const {
        const bool isc = u.pm >= NL / 256; const int mrow = isc ? 8 : (u.pm >> 4);
        const void* src = isc ? srcC : srcL; bf16_t* dst = isc ? dstC : dstL; const int rbase = isc ? u.pm * 256 - NL : u.pm * 256;
        constexpr int lds_ = SRC32 ? DM : HLD, ldd_ = HLD;
        const float* gt = modl + (size_t)mrow * 6144 + gtoff;
        const int c8 = u.pn * 256 + wc * 32 + 8 * fq;
        f32x4 gv[2][2];
#pragma unroll
        for (int bj = 0; bj < 2; ++bj)
#pragma unroll
            for (int n = 0; n < 2; ++n) gv[bj][n] = *(const f32x4*)(gt + c8 + bj * 128 + n * 4) * sin;
#pragma unroll
        for (int ai = 0; ai < 2; ++ai) {
            if constexpr (SRC32) {
                f32x4 s[4][2][2];
#pragma unroll
                for (int m = 0; m < 4; ++m) { const size_t off = (size_t)(rbase + EPI_ROWS(ai, m)) * lds_ + c8;
#pragma unroll
                    for (int bj = 0; bj < 2; ++bj)
#pragma unroll
                        for (int n = 0; n < 2; ++n) s[m][bj][n] = *(const f32x4*)((const float*)src + off + bj * 128 + n * 4); }
#pragma unroll
                for (int m = 0; m < 4; ++m) { const size_t off = (size_t)(rbase + EPI_ROWS(ai, m)) * ldd_ + c8;
#pragma unroll
                    for (int bj = 0; bj < 2; ++bj) *(u32x4*)(dst + off + bj * 128) = pack8(s[m][bj][0] + gv[bj][0] * acc[ai][bj][m][0], s[m][bj][1] + gv[bj][1] * acc[ai][bj][m][1]); }
            } else {
                u32x4 s[4][2];
#pragma unroll
                for (int m = 0; m < 4; ++m) { const size_t off = (size_t)(rbase + EPI_ROWS(ai, m)) * lds_ + c8;
#pragma unroll
                    for (int bj = 0; bj < 2; ++bj) s[m][bj] = *(const u32x4*)((const bf16_t*)src + off + bj * 128); }
#pragma unroll
                for (int m = 0; m < 4; ++m) { const size_t off = (size_t)(rbase + EPI_ROWS(ai, m)) * ldd_ + c8;
#pragma unroll
                    for (int bj = 0; bj < 2; ++bj) { f32x4 s0, s1; unpack8(s[m][bj], s0, s1);
                        *(u32x4*)(dst + off + bj * 128) = pack8(s0 + gv[bj][0] * acc[ai][bj][m][0], s1 + gv[bj][1] * acc[ai][bj][m][1]); } }
            }
            asm volatile("" ::: "memory"); }
    }
};
template <int FP8OUT> struct EpiSwiglu {
    static constexpr bool PERM = true; static constexpr int MID_T = 0;
    unsigned char* O; int ldo; float sin;
    __device__ __forceinline__ void operator()(EPI_ARGS) const {
        const int c8 = u.pn * 128 + wc * 32 + 8 * fq;
#pragma unroll
        for (int ai = 0; ai < 2; ++ai)
#pragma unroll
            for (int m = 0; m < 4; ++m) { const int row = u.pm * 256 + EPI_ROWS(ai, m);
                f32x4 a, b;
#pragma unroll
                for (int j = 0; j < 4; ++j) { a[j] = silu(acc[ai][0][m][0][j] * sin) * (acc[ai][1][m][0][j] * sin); b[j] = silu(acc[ai][0][m][1][j] * sin) * (acc[ai][1][m][1][j] * sin); }
                if (FP8OUT) { u32x2 w; w.x = pack4_fp8(a[0], a[1], a[2], a[3]); w.y = pack4_fp8(b[0], b[1], b[2], b[3]); *(u32x2*)(O + (size_t)row * ldo + c8) = w; }
                else *(u32x4*)(O + (size_t)row * ldo + c8 * 2) = pack8(a, b);
                asm volatile("" ::: "memory"); }
    }
};
struct EpiMoe2 {
    static constexpr bool PERM = true; static constexpr int MID_T = 0;
    bf16_t* Y; const int* list; const float* prob; float sin;
    __device__ __forceinline__ void operator()(EPI_ARGS) const {
        const int cnt = u.cnt & 511, r0 = u.cnt >> 9;
        const int c8 = u.pn * 256 + wc * 32 + 8 * fq;
        int en[2][4]; float pr[2][4];
#pragma unroll
        for (int ai = 0; ai < 2; ++ai)
#pragma unroll
            for (int m = 0; m < 4; ++m) { const int r = EPI_ROWS(ai, m); en[ai][m] = r < cnt ? list[(size_t)u.ex * NL + r0 + r] : -1; }
#pragma unroll
        for (int ai = 0; ai < 2; ++ai)
#pragma unroll
            for (int m = 0; m < 4; ++m) pr[ai][m] = en[ai][m] >= 0 ? prob[en[ai][m]] * sin : 0.f;
#pragma unroll
        for (int ai = 0; ai < 2; ++ai)
#pragma unroll
            for (int m = 0; m < 4; ++m) {
                if (en[ai][m] >= 0) { const float p = pr[ai][m];
                    bf16_t* op = Y + ((size_t)(en[ai][m] & 1) * NL + (size_t)(en[ai][m] >> 1)) * DM + c8;
#pragma unroll
                    for (int bj = 0; bj < 2; ++bj) *(u32x4*)(op + bj * 128) = pack8(acc[ai][bj][m][0] * p, acc[ai][bj][m][1] * p); }
                asm volatile("" ::: "memory"); }
    }
};

template <int FP8>
__device__ __forceinline__ void conv_mat_t(const Frame& F, const float* src, int ld, int Krows, int c0, int ncols, void* dstv, int dld, int dr0, int mode, int rot, LAS float* tl, int kper = 1 << 20, size_t sub_stride = 0) {
    const int ntn = ncols / 64, ntk = Krows / 128, tot = ntn * ntk, t = F.tid;
    const int lr = t >> 4, lc4 = (t & 15) * 4;
    const int sn = t >> 3, skc = (t & 7) * 16;
    f32x4 v[4];
    int j = (F.bid + rot) % F.G;
    if (j < tot) { const int tn = j % ntn, tk = j / ntn;
#pragma unroll
        for (int i = 0; i < 4; ++i) v[i] = *(const f32x4*)(src + (size_t)(tk * 128 + lr + 32 * i) * ld + c0 + tn * 64 + lc4); }
    for (; j < tot; j += F.G) {
        const int tn = j % ntn, tk = j / ntn, cc = tn * 64;
#pragma unroll
        for (int i = 0; i < 4; ++i) { LAS float* p = tl + (lr + 32 * i) * 65 + lc4; p[0] = v[i][0]; p[1] = v[i][1]; p[2] = v[i][2]; p[3] = v[i][3]; }
        __syncthreads();
        const int jn = j + F.G;
        if (jn < tot) { const int tn2 = jn % ntn, tk2 = jn / ntn;
#pragma unroll
            for (int i = 0; i < 4; ++i) v[i] = *(const f32x4*)(src + (size_t)(tk2 * 128 + lr + 32 * i) * ld + c0 + tn2 * 64 + lc4); }
        float o[16];
#pragma unroll
        for (int q = 0; q < 16; ++q) o[q] = tl[(skc + q) * 65 + sn];
        const int dr = mode ? ((cc >> 7) * 256 + (cc & 127) + dr0) : (dr0 + cc);
        if (FP8) { u32x4 w;
#pragma unroll
            for (int q = 0; q < 16; ++q) o[q] *= WSCALE;
            w.x = pack4_fp8(o[0], o[1], o[2], o[3]); w.y = pack4_fp8(o[4], o[5], o[6], o[7]); w.z = pack4_fp8(o[8], o[9], o[10], o[11]); w.w = pack4_fp8(o[12], o[13], o[14], o[15]);
            *(u32x4*)((unsigned char*)dstv + (size_t)(tk / kper) * sub_stride + (size_t)(dr + sn) * dld + (tk % kper) * 128 + skc) = w; }
        else { u32x4 w0, w1;
            w0.x = cvt_pk_bf16(o[0], o[1]); w0.y = cvt_pk_bf16(o[2], o[3]); w0.z = cvt_pk_bf16(o[4], o[5]); w0.w = cvt_pk_bf16(o[6], o[7]);
            w1.x = cvt_pk_bf16(o[8], o[9]); w1.y = cvt_pk_bf16(o[10], o[11]); w1.z = cvt_pk_bf16(o[12], o[13]); w1.w = cvt_pk_bf16(o[14], o[15]);
            bf16_t* dp = (bf16_t*)dstv + (size_t)(tk / kper) * sub_stride + (size_t)(dr + sn) * dld + (tk % kper) * 128 + skc;
            *(u32x4*)dp = w0; *(u32x4*)(dp + 8) = w1; }
        __syncthreads();
    }
}

__device__ __forceinline__ void conv_mat(const Frame& F, const float* src, int ld, int Krows, int c0, int ncols, bf16_t* dst, int dld, int dr0, int mode, int rot, LAS float* tl) {
    conv_mat_t<0>(F, src, ld, Krows, c0, ncols, dst, dld, dr0, mode, rot, tl); }
__device__ __forceinline__ void prologue_phase(const Frame& F) {
    LAS float* tl = (LAS float*)F.lds;
    for (int l = 0; l < 2; ++l) {
        const float* win = F.in(I_WIN) + (size_t)l * DM * IN_COLS;
        bf16_t* wqkv = (bf16_t*)(F.ws + WS_WQKV) + (size_t)l * NQKV * DM;
        bf16_t* wb = (bf16_t*)(F.ws + WS_WB) + (size_t)l * NZB * DM;
        conv_mat(F, win, IN_COLS, DM, 0, NQKV, wqkv, DM, 0, 0, 0, tl);
        conv_mat(F, win, IN_COLS, DM, O_OFF, 1024, wb, DM, 0, 0, 64, tl);
        conv_mat(F, win, IN_COLS, DM, GA_OFF, 1024, wb, DM, 1024, 0, 128, tl);
        conv_mat(F, win, IN_COLS, DM, GB_OFF, 1024, wb, DM, 2048, 0, 192, tl);
        conv_mat(F, win, IN_COLS, DM, POOL_OFF, 512, wb, DM, 3072, 0, 0, tl);
        conv_mat(F, F.in(I_WPA) + (size_t)l * DM * DM, DM, DM, 0, DM, (bf16_t*)(F.ws + WS_WCAT) + (size_t)l * DM * KCAT, KCAT, 0, 0, 128, tl);
        conv_mat(F, F.in(I_WOUT) + (size_t)l * DM * DM, DM, DM, 0, DM, (bf16_t*)(F.ws + WS_WOUT) + (size_t)l * DM * DM, DM, 0, 0, 0, tl);
    }
    conv_mat_t<FP8_DENSE>(F, F.in(I_WFG), DFF, DM, 0, DFF, F.ws + WS_WFGU, DM, 0, 1, 0, tl);
    conv_mat_t<FP8_DENSE>(F, F.in(I_WFU), DFF, DM, 0, DFF, F.ws + WS_WFGU, DM, 128, 1, 64, tl);
    conv_mat_t<(FP8_DENSE || FP8_FFN2)>(F, F.in(I_WFD), DM, DFF, 0, DM, F.ws + WS_WFD, DFF, 0, 0, 128, tl);
    const float* wpool = F.in(I_WPOOL); const float* pscale = F.in(I_PSCALE); const float* wpb = F.in(I_WPB);
    for (int idx = F.bid * NTHREADS + F.tid; idx < 2 * 512 * 1024; idx += F.G * NTHREADS) {
        const int l = idx >> 19, rem = idx & ((1 << 19) - 1), gc = rem >> 10, n = rem & 1023, g = gc >> 7;
        const float* wp = wpool + ((size_t)l * 512 + gc) * 128; const float* ps = pscale + l * 512 + g * 128;
        const float* pb = wpb + ((size_t)l * 512 + g * 128) * DM + n;
        float s = 0.f;
        for (int e0 = 0; e0 < 128; e0 += 8) { float x[8], y[8], z[8];
#pragma unroll
            for (int j = 0; j < 8; ++j) { x[j] = wp[e0 + j]; y[j] = ps[e0 + j]; z[j] = pb[(size_t)(e0 + j) * DM]; }
#pragma unroll
            for (int j = 0; j < 8; ++j) s += x[j] * y[j] * z[j]; }
        ((bf16_t*)(F.ws + WS_WCAT))[((size_t)l * DM + n) * KCAT + 1024 + gc] = f2bf(s);
    }
    {
        LAS float* sl = (LAS float*)(F.lds + 40960);
        LAS float* red = (LAS float*)(F.lds + 40960 + 36864);
        const float* cvec = F.in(I_C); const float* ccv = F.in(I_CCTX); const float* bada = F.in(I_BADA);
        for (int idx = F.tid; idx < 9 * 1024; idx += NTHREADS) { const int r = idx >> 10, k = idx & 1023; const float v = r < 8 ? cvec[r * 1024 + k] : ccv[k]; sl[idx] = silu(v); }
        __syncthreads();
        float* mod = (float*)(F.ws + WS_MOD);
        for (int job = F.bid; job < 2 * 96; job += F.G) {
            const int l = job / 96, n0 = (job % 96) * 64, cidx = F.tid & 63, kg = F.tid >> 6;
            const float* w = F.in(I_WADA) + (size_t)l * DM * 6144 + n0 + cidx;
            float a[9];
#pragma unroll
            for (int r = 0; r < 9; ++r) a[r] = 0.f;
            for (int k0 = kg * 128; k0 < kg * 128 + 128; k0 += 8) { float wv[8];
#pragma unroll
                for (int j = 0; j < 8; ++j) wv[j] = w[(size_t)(k0 + j) * 6144];
#pragma unroll
                for (int j = 0; j < 8; ++j)
#pragma unroll
                    for (int r = 0; r < 9; ++r) a[r] += sl[r * 1024 + k0 + j] * wv[j]; }
#pragma unroll
            for (int r = 0; r < 9; ++r) red[(kg * 64 + cidx) * 9 + r] = a[r];
            __syncthreads();
            for (int idx = F.tid; idx < 576; idx += NTHREADS) { const int ci = idx & 63, r = idx >> 6; float s = 0.f;
#pragma unroll
                for (int g = 0; g < 8; ++g) s += red[(g * 64 + ci) * 9 + r];
                mod[((size_t)l * 9 + r) * 6144 + n0 + ci] = s + bada[l * 6144 + n0 + ci]; }
            __syncthreads();
        }
    }
}

__device__ __forceinline__ void expert_convert(const Frame& F, LAS float* tl) {
    constexpr int ES = FP8_MOE ? 1 : 2;
    conv_mat_t<FP8_MOE>(F, F.in(I_WEG), DFE, NEXP * DM, 0, DFE, F.ws + WS_WEGU, DM, 0, 1, 0, tl, DM / 128, (size_t)2 * DFE * DM);
    conv_mat_t<FP8_MOE>(F, F.in(I_WEU), DFE, NEXP * DM, 0, DFE, F.ws + WS_WEGU, DM, 128, 1, 128, tl, DM / 128, (size_t)2 * DFE * DM);
    conv_mat_t<FP8_MOE>(F, F.in(I_WED), DM, NEXP * DFE, 0, DM, F.ws + WS_WED, DFE, 0, 0, 0, tl, DFE / 128, (size_t)DM * DFE);
}

template <bool SRC32> struct RowRaw;
template <> struct RowRaw<true> { f32x4 v[4];
    __device__ __forceinline__ void load(const void* p, int lane) {
#pragma unroll
        for (int i = 0; i < 4; ++i) v[i] = *(const f32x4*)((const float*)p + i * 256 + lane * 4); }
    __device__ __forceinline__ f32x4 get(int i) const { return v[i]; } };
template <> struct RowRaw<false> { u32x2 v[4];
    __device__ __forceinline__ void load(const void* p, int lane) {
#pragma unroll
        for (int i = 0; i < 4; ++i) v[i] = *(const u32x2*)((const bf16_t*)p + i * 256 + lane * 4); }
    __device__ __forceinline__ f32x4 get(int i) const { return (f32x4){bf_lo(v[i].x), bf_hi(v[i].x), bf_lo(v[i].y), bf_hi(v[i].y)}; } };
template <bool SRC32>
__device__ __forceinline__ void norm_phase(const Frame& F, int l, int which) {
    const bool n1 = which == 0;
    const int M = (which == 2) ? NL : (n1 ? MT : (l == 0 ? MT : NL));
    const char* srcL = SRC32 ? (const char*)F.in(I_X) : (const char*)F.out; const char* srcC = SRC32 ? (const char*)F.in(I_CTX) : (const char*)(F.ws + WS_HC16);
    constexpr size_t RB = SRC32 ? DM * 4 : HLD * 2, RBC = SRC32 ? DM * 4 : HLD * 2;
    const float* g = (n1 ? F.in(I_GMIX) : F.in(I_GFFN)) + l * DM;
    const float* modl = (const float*)(F.ws + WS_MOD) + (size_t)l * 9 * 6144;
    const int shoff = n1 ? MOD_SH1 : MOD_SH2, scoff = n1 ? MOD_SC1 : MOD_SC2;
    bf16_t* U = (bf16_t*)(F.ws + WS_R0);
    const bool u8 = (which == 2 && FP8_MOE) || (which == 1 && FP8_DENSE);
    LAS float* W = (LAS float*)F.lds;
    LAS float* rlog = (LAS float*)(F.lds + 65536);
    LAS int* lcnt = (LAS int*)(F.lds + 65536 + 8192);
    const int ncol = n1 ? 16 : 8;
    const float* bif = F.in(I_BIF) + l * 16;
    if (which != 1) {
        const float* wsrc = n1 ? (F.in(I_WIN) + (size_t)l * DM * IN_COLS + IF_OFF) : (F.in(I_WROUTER));
        const int ld = n1 ? IN_COLS : NEXP;
        for (int idx = F.tid; idx < ncol * 1024; idx += NTHREADS) { const int k = idx / ncol, c = idx % ncol; W[c * 1024 + k] = wsrc[(size_t)k * ld + c]; }
        if (F.tid < 16) lcnt[F.tid] = 0;
        __syncthreads();
    }
    const int rpb = (M + F.G - 1) / F.G, rb0 = F.bid * rpb, rb1 = (rb0 + rpb) < M ? (rb0 + rpb) : M;
    RowRaw<SRC32> nv;
    { const int row = rb0 + F.wave;
      if (row < rb1) nv.load(row >= NL ? srcC + (size_t)(row - NL) * RBC : srcL + (size_t)row * RB, F.lane); }
    f32x4 fac[4], sft[4]; int mcur = -1;
    for (int row = rb0 + F.wave; row < rb1; row += 8) {
        const bool isc = row >= NL;
        const int mrow = isc ? 8 : (row >> 12);
        if (mrow != mcur) { mcur = mrow; const float* mr = modl + (size_t)mrow * 6144;
#pragma unroll
            for (int i = 0; i < 4; ++i) { const int k = i * 256 + F.lane * 4; fac[i] = *(const f32x4*)(g + k) * (*(const f32x4*)(mr + scoff + k) + 1.0f); sft[i] = *(const f32x4*)(mr + shoff + k); } }
        f32x4 v[4]; float ss = 0.f;
#pragma unroll
        for (int i = 0; i < 4; ++i) { v[i] = nv.get(i); ss += v[i][0] * v[i][0] + v[i][1] * v[i][1] + v[i][2] * v[i][2] + v[i][3] * v[i][3]; }
        { const int rn = row + 8;
          if (rn < rb1) nv.load(rn >= NL ? srcC + (size_t)(rn - NL) * RBC : srcL + (size_t)rn * RB, F.lane); }
        ss = wave_sum(ss, F.lane);
        const float r = rsqrtf(ss * (1.0f / DM) + EPS);
#pragma unroll
        for (int i = 0; i < 4; ++i) { const int k = i * 256 + F.lane * 4;
            v[i] = (v[i] * r) * fac[i] + sft[i];
            if (u8) *(unsigned*)((unsigned char*)U + (size_t)row * DM + k) = pack4_fp8(v[i][0], v[i][1], v[i][2], v[i][3]);
            else { u32x2 w; w.x = cvt_pk_bf16(v[i][0], v[i][1]); w.y = cvt_pk_bf16(v[i][2], v[i][3]); *(u32x2*)(U + (size_t)row * DM + k) = w; } }
        if (which == 0) {
            float p[16];
#pragma unroll
            for (int c = 0; c < 16; ++c) { f32x2 s2 = {0.f, 0.f};
#pragma unroll
                for (int i = 0; i < 4; ++i) { const f32x4 w4 = *(const LAS f32x4*)(W + c * 1024 + i * 256 + F.lane * 4);
                    s2 += (f32x2){v[i][0], v[i][1]} * (f32x2){w4[0], w4[1]}; s2 += (f32x2){v[i][2], v[i][3]} * (f32x2){w4[2], w4[3]}; }
                p[c] = s2[0] + s2[1]; }
            { const bool hi = F.lane & 32;
#pragma unroll
              for (int i = 0; i < 8; ++i) { const float keep = hi ? p[i + 8] : p[i], send = hi ? p[i] : p[i + 8]; p[i] = keep + lx_xor(send, 32, F.lane); } }
            { const bool hi = F.lane & 16;
#pragma unroll
              for (int i = 0; i < 4; ++i) { const float keep = hi ? p[i + 4] : p[i], send = hi ? p[i] : p[i + 4]; p[i] = keep + lx_xor(send, 16, F.lane); } }
            { const bool hi = F.lane & 8;
#pragma unroll
              for (int i = 0; i < 2; ++i) { const float keep = hi ? p[i + 2] : p[i], send = hi ? p[i] : p[i + 2]; p[i] = keep + lx_xor(send, 8, F.lane); } }
            { const bool hi = F.lane & 4; const float keep = hi ? p[1] : p[0], send = hi ? p[0] : p[1]; p[0] = keep + lx_xor(send, 4, F.lane); }
            p[0] += lx_xor(p[0], 2, F.lane); p[0] += lx_xor(p[0], 1, F.lane);
            if ((F.lane & 3) == 0) { const int c = ((F.lane >> 5) & 1) * 8 + ((F.lane >> 4) & 1) * 4 + ((F.lane >> 3) & 1) * 2 + ((F.lane >> 2) & 1);
                ((float*)(F.ws + WS_GATES))[(size_t)row * 16 + c] = p[0] + bif[c]; }
        } else if (which == 2) {
            float p[8];
#pragma unroll
            for (int c = 0; c < 8; ++c) { f32x2 s2 = {0.f, 0.f};
#pragma unroll
                for (int i = 0; i < 4; ++i) { const f32x4 w4 = *(const LAS f32x4*)(W + c * 1024 + i * 256 + F.lane * 4);
                    s2 += (f32x2){v[i][0], v[i][1]} * (f32x2){w4[0], w4[1]}; s2 += (f32x2){v[i][2], v[i][3]} * (f32x2){w4[2], w4[3]}; }
                p[c] = s2[0] + s2[1]; }
            { const bool hi = F.lane & 32;
#pragma unroll
              for (int i = 0; i < 4; ++i) { const float keep = hi ? p[i + 4] : p[i], send = hi ? p[i] : p[i + 4]; p[i] = keep + lx_xor(send, 32, F.lane); } }
            { const bool hi = F.lane & 16;
#pragma unroll
              for (int i = 0; i < 2; ++i) { const float keep = hi ? p[i + 2] : p[i], send = hi ? p[i] : p[i + 2]; p[i] = keep + lx_xor(send, 16, F.lane); } }
            { const bool hi = F.lane & 8; const float keep = hi ? p[1] : p[0], send = hi ? p[0] : p[1]; p[0] = keep + lx_xor(send, 8, F.lane); }
            p[0] += lx_xor(p[0], 4, F.lane); p[0] += lx_xor(p[0], 2, F.lane); p[0] += lx_xor(p[0], 1, F.lane);
            if ((F.lane & 7) == 0) { const int c = ((F.lane >> 5) & 1) * 4 + ((F.lane >> 4) & 1) * 2 + ((F.lane >> 3) & 1); rlog[(row - rb0) * 8 + c] = p[0]; }
        }
    }
    if (which == 2) {
        __syncthreads();
        const int nr = rb1 - rb0; int e0 = 0, e1 = 0, k0 = 0, k1 = 0; float p0 = 0.f, p1 = 0.f;
        const bool act = F.tid < nr;
        if (act) {
            float lg[8];
#pragma unroll
            for (int e = 0; e < 8; ++e) lg[e] = rlog[F.tid * 8 + e];
            float v0 = lg[0]; e0 = 0;
#pragma unroll
            for (int e = 1; e < 8; ++e) if (lg[e] > v0) { v0 = lg[e]; e0 = e; }
            float v1 = -3.0e38f; e1 = -1;
#pragma unroll
            for (int e = 0; e < 8; ++e) if (e != e0 && (e1 < 0 || lg[e] > v1)) { v1 = lg[e]; e1 = e; }
            p0 = 1.0f / (1.0f + __expf(v1 - v0)); p1 = 1.0f - p0;
            k0 = atomicAdd((int*)(lcnt + e0), 1); k1 = atomicAdd((int*)(lcnt + e1), 1);
        }
        __syncthreads();
        if (F.tid < 8) lcnt[8 + F.tid] = (int)__hip_atomic_fetch_add(F.ctl + CW_ECNT + 64 * F.tid, (unsigned)lcnt[F.tid], __ATOMIC_RELAXED, __HIP_MEMORY_SCOPE_AGENT);
        __syncthreads();
        if (act) { const int tok = rb0 + F.tid; int* list = (int*)(F.ws + WS_RLIST); float* prob = (float*)(F.ws + WS_RPROB);
            list[(size_t)e0 * NL + lcnt[8 + e0] + k0] = tok * 2; list[(size_t)e1 * NL + lcnt[8 + e1] + k1] = tok * 2 + 1;
            prob[tok * 2] = p0; prob[tok * 2 + 1] = p1; }
        __syncthreads();
    }
}

__device__ __forceinline__ void final_phase(const Frame& F) {
    const float* modl = (const float*)(F.ws + WS_MOD) + (size_t)1 * 9 * 6144;
    const bf16_t* Y0 = (const bf16_t*)(F.ws + WS_Y); const bf16_t* Y1 = Y0 + (size_t)NL * DM; const float* gfin = F.in(I_GFINAL);
    const bf16_t* H = (const bf16_t*)F.out;
    u32x2 nh[4]; u32x2 na[4], nb[4];
    f32x4 gfv[4], gtv[4]; int bcur = -1;
#pragma unroll
    for (int i = 0; i < 4; ++i) gfv[i] = *(const f32x4*)(gfin + i * 256 + F.lane * 4);
    const int stride = F.G * 8;
    { const int row = F.bid * 8 + F.wave;
      if (row < NL) {
#pragma unroll
          for (int i = 0; i < 4; ++i) { const int k = i * 256 + F.lane * 4; nh[i] = *(const u32x2*)(H + (size_t)row * HLD + k);
              na[i] = *(const u32x2*)(Y0 + (size_t)row * DM + k); nb[i] = *(const u32x2*)(Y1 + (size_t)row * DM + k); } } }
    for (int row = F.bid * 8 + F.wave; row < NL; row += stride) {
        float* hr = F.out + (size_t)row * DM;
        if ((row >> 12) != bcur) { bcur = row >> 12; const float* gt = modl + (size_t)bcur * 6144 + MOD_GT2;
#pragma unroll
            for (int i = 0; i < 4; ++i) gtv[i] = *(const f32x4*)(gt + i * 256 + F.lane * 4); }
        f32x4 v[4]; u32x2 ya[4], yb[4];
#pragma unroll
        for (int i = 0; i < 4; ++i) { v[i] = (f32x4){bf_lo(nh[i].x), bf_hi(nh[i].x), bf_lo(nh[i].y), bf_hi(nh[i].y)}; ya[i] = na[i]; yb[i] = nb[i]; }
        { const int rn = row + stride;
          if (rn < NL) {
#pragma unroll
              for (int i = 0; i < 4; ++i) { const int k = i * 256 + F.lane * 4; nh[i] = *(const u32x2*)(H + (size_t)rn * HLD + k);
                  na[i] = *(const u32x2*)(Y0 + (size_t)rn * DM + k); nb[i] = *(const u32x2*)(Y1 + (size_t)rn * DM + k); } } }
        float ss = 0.f;
#pragma unroll
        for (int i = 0; i < 4; ++i) { const int k = i * 256 + F.lane * 4; const u32x2 a = ya[i], b = yb[i];
            const f32x4 y = (f32x4){bf_lo(a.x) + bf_lo(b.x), bf_hi(a.x) + bf_hi(b.x), bf_lo(a.y) + bf_lo(b.y), bf_hi(a.y) + bf_hi(b.y)};
            v[i] += gtv[i] * y;
            ss += v[i][0] * v[i][0] + v[i][1] * v[i][1] + v[i][2] * v[i][2] + v[i][3] * v[i][3]; }
        ss = wave_sum(ss, F.lane);
        const float r = rsqrtf(ss * (1.0f / DM) + EPS);
#pragma unroll
        for (int i = 0; i < 4; ++i) { const int k = i * 256 + F.lane * 4; *(f32x4*)(hr + k) = (v[i] * r) * gfv[i]; }
    }
}

__device__ __forceinline__ float logsigmoid(float x) { return fminf(x, 0.f) - log1pf(__expf(-fabsf(x))); }
__device__ __forceinline__ float scan_add(float v, int lane) {
#pragma unroll
    for (int o = 1; o < 64; o <<= 1) { const float t = lx_up(v, o, lane); if (lane >= o) v += t; }
    return v;
}
__device__ __forceinline__ float scan_max(float v, int lane) {
#pragma unroll
    for (int o = 1; o < 64; o <<= 1) { const float t = lx_up(v, o, lane); if (lane >= o) v = fmaxf(v, t); }
    return v;
}
__device__ __forceinline__ void prep_phase(const Frame& F, int l) {
    bf16_t* QKV = (bf16_t*)(F.ws + WS_R1); const bf16_t* halo = (const bf16_t*)(F.ws + WS_HALO);
    bf16_t* KT = (bf16_t*)(F.ws + WS_KT); bf16_t* VT = (bf16_t*)(F.ws + WS_VT);
    const float* cw = F.in(I_CONV) + (size_t)l * 3 * 2048;
    LAS bf16_t* T = (LAS bf16_t*)F.lds;
    constexpr int TP = 258;
    const int cg = F.tid & 31, rg = F.tid >> 5;
    { const float* gates = (const float*)(F.ws + WS_GATES); f32x4* gsc = (f32x4*)(F.ws + WS_GSC);
      for (int task = F.bid * 8 + F.wave; task < NCHUNK * 8; task += F.G * 8) {
          const int ci = task >> 3, dh = task & 7, dir = dh >> 2, h = dh & 3, rr = dir ? 63 - F.lane : F.lane;
          const float ig = gates[(size_t)(ci * 64 + rr) * 16 + dir * 8 + h], fp = gates[(size_t)(ci * 64 + rr) * 16 + dir * 8 + 4 + h];
          const float bcum = scan_add(logsigmoid(fp), F.lane), a_ = ig - bcum, pmax = scan_max(a_, F.lane);
          gsc[(size_t)task * 64 + rr] = (f32x4){a_, bcum, pmax, 0.f}; } }
#if MLSTM_TR
    {
        u32x4 nraw[6];
#define PREP_LOAD(un_) do { const int _ci = (un_) >> 3, _hc = (un_) & 7, _row0 = _ci * 64, _col0 = _hc * 256 + cg * 8; bool _first, _lastc; \
        if (_ci < NCHUNK_L) { _first = (_ci & 63) == 0; _lastc = (_ci & 63) == 63; } else { const int _cc = _ci - NCHUNK_L; _first = (_cc & 3) == 0; _lastc = (_cc & 3) == 3; } \
        _Pragma("unroll") for (int i = 0; i < 6; ++i) { const int r = rg * 4 - 1 + i; \
            if (r < 0) nraw[i] = _first ? (u32x4){0u, 0u, 0u, 0u} : *(const u32x4*)(halo + ((size_t)(_ci - 1) * 2 + 1) * 2048 + _col0); \
            else if (r > 63) nraw[i] = _lastc ? (u32x4){0u, 0u, 0u, 0u} : *(const u32x4*)(halo + ((size_t)(_ci + 1) * 2 + 0) * 2048 + _col0); \
            else nraw[i] = *(const u32x4*)(QKV + (size_t)(_row0 + r) * NQKV + _col0); } } while (0)
        f32x4 w[3][2]; int hcw = -1;
        if (F.bid < NCHUNK * 8) PREP_LOAD(F.bid);
        for (int un = F.bid; un < NCHUNK * 8; un += F.G) {
            const int ci = un >> 3, hc = un & 7, row0 = ci * 64, col0 = hc * 256 + cg * 8;
            u32x4 raw[6];
#pragma unroll
            for (int i = 0; i < 6; ++i) raw[i] = nraw[i];
            if (hc != hcw) { hcw = hc;
#pragma unroll
                for (int j = 0; j < 3; ++j) { w[j][0] = *(const f32x4*)(cw + j * 2048 + col0); w[j][1] = *(const f32x4*)(cw + j * 2048 + col0 + 4); } }
            if (un + F.G < NCHUNK * 8) PREP_LOAD(un + F.G);
            const float scl = hc >= 4 ? 0.0625f : 1.0f;
            f32x4 x[6][2]; u32x4 ow[4];
#pragma unroll
            for (int i = 0; i < 6; ++i) unpack8(raw[i], x[i][0], x[i][1]);
#pragma unroll
            for (int i = 0; i < 4; ++i) { f32x4 o[2];
#pragma unroll
                for (int hh = 0; hh < 2; ++hh) { o[hh] = x[i][hh] * w[0][hh] + x[i + 1][hh] * w[1][hh] + x[i + 2][hh] * w[2][hh];
#pragma unroll
                    for (int j = 0; j < 4; ++j) o[hh][j] = silu(o[hh][j]) * scl; }
                ow[i] = pack8(o[0], o[1]); }
            __syncthreads();
#pragma unroll
            for (int i = 0; i < 4; ++i) *(u32x4*)(QKV + (size_t)(row0 + rg * 4 + i) * NQKV + col0) = ow[i];
        }
#undef PREP_LOAD
        return;
    }
#endif
    constexpr int NHC = 12;
    for (int un = F.bid; un < NCHUNK * NHC; un += F.G) {
        const int ci = un / NHC, hc = un % NHC, row0 = ci * 64, col0 = hc * 256 + cg * 8;
        bool first, lastc;
        if (ci < NCHUNK_L) { first = (ci & 63) == 0; lastc = (ci & 63) == 63; } else { const int cc = ci - NCHUNK_L; first = (cc & 3) == 0; lastc = (cc & 3) == 3; }
        u32x4 ow[4];
        if (hc < 8) {
            u32x4 raw[6];
#pragma unroll
            for (int i = 0; i < 6; ++i) { const int r = rg * 4 - 1 + i;
                if (r < 0) raw[i] = first ? (u32x4){0u, 0u, 0u, 0u} : *(const u32x4*)(halo + ((size_t)(ci - 1) * 2 + 1) * 2048 + col0);
                else if (r > 63) raw[i] = lastc ? (u32x4){0u, 0u, 0u, 0u} : *(const u32x4*)(halo + ((size_t)(ci + 1) * 2 + 0) * 2048 + col0);
                else raw[i] = *(const u32x4*)(QKV + (size_t)(row0 + r) * NQKV + col0); }
            f32x4 w[3][2];
#pragma unroll
            for (int j = 0; j < 3; ++j) { w[j][0] = *(const f32x4*)(cw + j * 2048 + col0); w[j][1] = *(const f32x4*)(cw + j * 2048 + col0 + 4); }
            const float scl = hc >= 4 ? 0.0625f : 1.0f;
            f32x4 x[6][2];
#pragma unroll
            for (int i = 0; i < 6; ++i) unpack8(raw[i], x[i][0], x[i][1]);
#pragma unroll
            for (int i = 0; i < 4; ++i) { f32x4 o[2];
#pragma unroll
                for (int hh = 0; hh < 2; ++hh) { o[hh] = x[i][hh] * w[0][hh] + x[i + 1][hh] * w[1][hh] + x[i + 2][hh] * w[2][hh];
#pragma unroll
                    for (int j = 0; j < 4; ++j) o[hh][j] = silu(o[hh][j]) * scl; }
                ow[i] = pack8(o[0], o[1]); }
            __syncthreads();
#pragma unroll
            for (int i = 0; i < 4; ++i) *(u32x4*)(QKV + (size_t)(row0 + rg * 4 + i) * NQKV + col0) = ow[i];
        } else {
#pragma unroll
            for (int i = 0; i < 4; ++i) ow[i] = *(const u32x4*)(QKV + (size_t)(row0 + rg * 4 + i) * NQKV + col0);
        }
        if (hc >= 4 && !MLSTM_TR) {
#pragma unroll
            for (int i = 0; i < 4; ++i) { LAS unsigned* tp = (LAS unsigned*)(T + (rg * 4 + i) * TP + cg * 8);
                tp[0] = ow[i].x; tp[1] = ow[i].y; tp[2] = ow[i].z; tp[3] = ow[i].w; }
            __syncthreads();
            bf16_t* dst = (hc < 8 ? KT : VT) + ((size_t)ci * 4 + (hc & 3)) * (256 * 64);
#pragma unroll
            for (int o = 0; o < 4; ++o) { const int idx = F.tid + o * NTHREADS, d = idx >> 3, sc = idx & 7; unsigned short v[8];
#pragma unroll
                for (int j = 0; j < 8; ++j) v[j] = T[(sc * 8 + j) * TP + d];
                u32x4 w; w.x = v[0] | ((unsigned)v[1] << 16); w.y = v[2] | ((unsigned)v[3] << 16); w.z = v[4] | ((unsigned)v[5] << 16); w.w = v[6] | ((unsigned)v[7] << 16);
                *(u32x4*)(dst + (size_t)d * 64 + sc * 8) = w; }
            __syncthreads();
        }
    }
}

__device__ __forceinline__ void mlstm_phase_ref(const Frame& F, int l) {
    const bf16_t* QKV = (const bf16_t*)(F.ws + WS_R1); const float* gates = (const float*)(F.ws + WS_GATES);
    LAS bf16_t* Qs = (LAS bf16_t*)F.lds;
    LAS bf16_t* Ks = (LAS bf16_t*)(F.lds + 32768);
    LAS float* Cs = (LAS float*)(F.lds + 65536);
    LAS bf16_t* Vs = (LAS bf16_t*)(F.lds + 131072);
    LAS bf16_t* Ps = (LAS bf16_t*)(F.lds + 139264);
    LAS float* sc = (LAS float*)(F.lds + 147456);
    LAS float* s_a = sc, *s_mj = sc + 64, *s_wi = sc + 128, *s_en = sc + 192, *s_wk = sc + 256, *s_den = sc + 320, *s_n = sc + 384;
    const int tid = F.tid, lane = F.lane;
    for (int un = F.bid; un < 256; un += F.G) {
        const int xcd = un & 7, q = un >> 3, seq = xcd * 8 + (q >> 2), es = q & 3;
        const int b = seq >> 3, h = (seq >> 1) & 3, dir = seq & 1;
        bf16_t* HO = (bf16_t*)(F.ws + (dir ? WS_HB : WS_HF));
        for (int i = tid; i < 256 * 64; i += NTHREADS) Cs[i] = 0.f;
        if (tid < 256) s_n[tid] = 0.f;
        float m_st = 0.f;
        __syncthreads();
        for (int step = 0; step < 68; ++step) {
            const bool isctx = step < 4; const int cidx = isctx ? step : step - 4, nch = isctx ? 4 : 64;
            const int cact = dir ? (nch - 1 - cidx) : cidx;
            const int row0 = isctx ? (NL + b * CTXL + cact * 64) : (b * SEQ + cact * 64);
#pragma unroll
            for (int o = 0; o < 4; ++o) { const int idx = tid + o * NTHREADS, r = idx >> 5, c8 = (idx & 31) * 8;
                const u32x4 qv = *(const u32x4*)(QKV + (size_t)(row0 + r) * NQKV + h * 256 + c8);
                const u32x4 kv = *(const u32x4*)(QKV + (size_t)(row0 + r) * NQKV + 1024 + h * 256 + c8);
                *(LAS u32x4*)(Qs + r * 256 + c8) = qv; *(LAS u32x4*)(Ks + r * 256 + c8) = kv; }
            { const int r = tid >> 3, c8 = (tid & 7) * 8;
              *(LAS u32x4*)(Vs + r * 64 + c8) = *(const u32x4*)(QKV + (size_t)(row0 + r) * NQKV + 2048 + h * 256 + es * 64 + c8); }
            float wc;
            { const int r = dir ? 63 - lane : lane;
              const float ig = gates[(size_t)(row0 + r) * 16 + dir * 8 + h], fp = gates[(size_t)(row0 + r) * 16 + dir * 8 + 4 + h];
              const float fc = logsigmoid(fp);
              const float bcum = scan_add(fc, lane);
              const float blast = lx_idx(bcum, 63);
              const float a = ig - bcum;
              const float pmax = scan_max(a, lane);
              const float mj = fmaxf(m_st, pmax);
              const float gend = blast + a;
              const float mnew = fmaxf(blast + m_st, wave_max(gend, lane));
              const float wk = __expf(gend - mnew);
              wc = __expf(blast + m_st - mnew);
              if (F.wave == 0) { s_a[r] = a; s_mj[r] = mj; s_wi[r] = __expf(m_st - mj); s_en[r] = __expf(-(bcum + mj)); s_wk[r] = wk; }
              m_st = mnew; }
            __syncthreads();
            { const int j = tid >> 3, sg = tid & 7; float acc[8];
#pragma unroll
              for (int i = 0; i < 8; ++i) acc[i] = 0.f;
#pragma unroll 2
              for (int kk = 0; kk < 32; ++kk) { const u32x4 qv = *(const LAS u32x4*)(Qs + j * 256 + kk * 8);
                  const float q0 = bf_lo(qv.x), q1 = bf_hi(qv.x), q2 = bf_lo(qv.y), q3 = bf_hi(qv.y), q4 = bf_lo(qv.z), q5 = bf_hi(qv.z), q6 = bf_lo(qv.w), q7 = bf_hi(qv.w);
#pragma unroll
                  for (int i = 0; i < 8; ++i) { const u32x4 kv = *(const LAS u32x4*)(Ks + (sg * 8 + i) * 256 + kk * 8);
                      acc[i] += q0 * bf_lo(kv.x) + q1 * bf_hi(kv.x) + q2 * bf_lo(kv.y) + q3 * bf_hi(kv.y) + q4 * bf_lo(kv.z) + q5 * bf_hi(kv.z) + q6 * bf_lo(kv.w) + q7 * bf_hi(kv.w); } }
              const float mjj = s_mj[j]; float rs = 0.f; float pv[8];
#pragma unroll
              for (int i = 0; i < 8; ++i) { const int s = sg * 8 + i; const bool ok = dir ? (s >= j) : (s <= j);
                  pv[i] = ok ? acc[i] * __expf(s_a[s] - mjj) : 0.f; rs += pv[i]; }
              u32x4 pw; pw.x = cvt_pk_bf16(pv[0], pv[1]); pw.y = cvt_pk_bf16(pv[2], pv[3]); pw.z = cvt_pk_bf16(pv[4], pv[5]); pw.w = cvt_pk_bf16(pv[6], pv[7]);
              *(LAS u32x4*)(Ps + j * 64 + sg * 8) = pw;
              rs += lx_xor(rs, 1, F.lane); rs += lx_xor(rs, 2, F.lane); rs += lx_xor(rs, 4, F.lane);
              if (sg == 0) s_den[j] = rs; }
            __syncthreads();
            { const int e = tid & 63, jg = tid >> 6; float acc[8], qn[8];
#pragma unroll
              for (int i = 0; i < 8; ++i) { acc[i] = 0.f;
                  const u32x2 qq = *(const LAS u32x2*)(Qs + (jg * 8 + i) * 256 + e * 4); const f32x4 nn = *(const LAS f32x4*)(s_n + e * 4);
                  qn[i] = wave_sum(bf_lo(qq.x) * nn[0] + bf_hi(qq.x) * nn[1] + bf_lo(qq.y) * nn[2] + bf_hi(qq.y) * nn[3], lane); }
#pragma unroll 4
              for (int d = 0; d < 256; d += 2) { const float c0 = Cs[d * 64 + e], c1 = Cs[(d + 1) * 64 + e];
#pragma unroll
                  for (int i = 0; i < 8; ++i) { const unsigned qq = *(const LAS unsigned*)(Qs + (jg * 8 + i) * 256 + d); acc[i] += bf_lo(qq) * c0 + bf_hi(qq) * c1; } }
#pragma unroll
              for (int i = 0; i < 8; ++i) acc[i] *= s_wi[jg * 8 + i];
#pragma unroll 4
              for (int s = 0; s < 64; s += 2) { const float v0 = bf2f(Vs[s * 64 + e]), v1 = bf2f(Vs[(s + 1) * 64 + e]);
#pragma unroll
                  for (int i = 0; i < 8; ++i) { const unsigned pp = *(const LAS unsigned*)(Ps + (jg * 8 + i) * 64 + s); acc[i] += bf_lo(pp) * v0 + bf_hi(pp) * v1; } }
              if (!isctx || l == 0) {
#pragma unroll
                  for (int i = 0; i < 8; ++i) { const int j = jg * 8 + i; const float den = s_wi[j] * qn[i] + s_den[j];
                      HO[(size_t)(row0 + j) * DM + h * 256 + es * 64 + e] = f2bf(acc[i] / fmaxf(fabsf(den), s_en[j])); } } }
            __syncthreads();
            { const int e = tid & 63, dg = tid >> 6;
#pragma unroll 1
              for (int sh = 0; sh < 64; sh += 32) { float vv[32]; const float cf = sh == 0 ? wc : 1.0f;
#pragma unroll
                  for (int s = 0; s < 32; ++s) vv[s] = s_wk[sh + s] * bf2f(Vs[(sh + s) * 64 + e]);
#pragma unroll 1
                  for (int i = 0; i < 32; i += 2) { const int d = dg * 32 + i; float a0 = cf * Cs[d * 64 + e], a1 = cf * Cs[(d + 1) * 64 + e];
#pragma unroll
                      for (int s = 0; s < 32; ++s) { const unsigned kk = *(const LAS unsigned*)(Ks + (sh + s) * 256 + d); a0 += bf_lo(kk) * vv[s]; a1 += bf_hi(kk) * vv[s]; }
                      Cs[d * 64 + e] = a0; Cs[(d + 1) * 64 + e] = a1; } }
              if (tid < 256) { float nn = wc * s_n[tid];
                  for (int s = 0; s < 64; ++s) nn += s_wk[s] * bf2f(Ks[s * 256 + tid]);
                  s_n[tid] = nn; } }
            __syncthreads();
        }
    }
}

#define LDS_BARRIER() do { asm volatile("s_waitcnt lgkmcnt(0)" ::: "memory"); __builtin_amdgcn_s_barrier(); asm volatile("" ::: "memory"); } while (0)
__device__ __forceinline__ void mlstm_phase_mfma(const Frame& F, int l) {
    constexpr int QP = 528, TP = 144;
    constexpr int O_Q = 0, O_K = 33792, O_KT = 67584, O_CT = 104448, O_VT = O_CT + 65 * QP, O_P = O_VT + 65 * TP, O_SC = O_P + 64 * TP;
    constexpr int SC_PAR = 1280;
    constexpr int O_DEN = O_SC + 2 * SC_PAR, O_MISC = O_DEN + 256, O_RAW = O_MISC + 64;
    static_assert(O_RAW + 2048 <= LDS_BYTES - 16, "mlstm LDS map");
    const bf16_t* QKV = (const bf16_t*)(F.ws + WS_R1); const f32x4* gsc = (const f32x4*)(F.ws + WS_GSC);
    const bf16_t* KTg = (const bf16_t*)(F.ws + WS_KT); const bf16_t* VTg = (const bf16_t*)(F.ws + WS_VT);
    LAS unsigned char* lds = F.lds;
    const int tid = F.tid, lane = F.lane, w = F.wave, r16 = lane & 15, g = lane >> 4;
    const int jh = w & 1, mg = w >> 1; const bool isS = mg < 2; const int nmt = mg == 3 ? 3 : 2;
    for (int un = F.bid; un < 256; un += F.G) {
        const int xcd = un & 7, q = un >> 3, seq = xcd * 8 + (q >> 2), es = q & 3;
        const int b = seq >> 3, h = (seq >> 1) & 3, dir = seq & 1;
        bf16_t* HO = (bf16_t*)(F.ws + (dir ? WS_HB : WS_HF));
        __syncthreads();
        for (int i = tid; i < 65 * QP / 4; i += NTHREADS) ((LAS unsigned*)(lds + O_CT))[i] = 0u;
        if (tid < 32) ((LAS unsigned*)(lds + O_VT + 64 * TP))[tid] = 0x3F803F80u;
        f32x4 accC[2][5];
#pragma unroll
        for (int a = 0; a < 2; ++a)
#pragma unroll
            for (int e = 0; e < 5; ++e) accC[a][e] = (f32x4){0.f, 0.f, 0.f, 0.f};
        float m_st = 0.f;
        u32x4 rq[4], rk[4], rt[4], rv; f32x4 gs4 = {0.f, 0.f, 0.f, 0.f}; int row0n = 0;
#define ML_LOAD(step_) do { const int _st = (step_); const bool _ic = _st < 4; const int _ci = _ic ? _st : _st - 4, _n = _ic ? 4 : 64, _ca = dir ? (_n - 1 - _ci) : _ci; \
        row0n = _ic ? (NL + b * CTXL + _ca * 64) : (b * SEQ + _ca * 64); const size_t _tile = (size_t)(row0n >> 6) * 4 + h; \
        _Pragma("unroll") for (int o = 0; o < 4; ++o) { const int idx = tid + o * NTHREADS, r = idx >> 5, c8 = (idx & 31) * 8; \
            rq[o] = *(const u32x4*)(QKV + (size_t)(row0n + r) * NQKV + h * 256 + c8); rk[o] = *(const u32x4*)(QKV + (size_t)(row0n + r) * NQKV + 1024 + h * 256 + c8); \
            rt[o] = *(const u32x4*)(KTg + _tile * 16384 + (size_t)idx * 8); } \
        rv = *(const u32x4*)(VTg + _tile * 16384 + (size_t)es * 4096 + (size_t)tid * 8); } while (0)
#define ML_SCAL(par_) do { LAS float* sp = (LAS float*)(lds + O_SC + (par_) * SC_PAR); const int lastr = dir ? 0 : 63; \
        const f32x4 g4 = *(const LAS f32x4*)(lds + O_RAW + (par_) * 1024 + lane * 16); const float a_ = g4[0], bcum = g4[1], pmax = g4[2]; \
        const float blast = __int_as_float(__builtin_amdgcn_readlane(__float_as_int(bcum), lastr)), gmax = blast + __int_as_float(__builtin_amdgcn_readlane(__float_as_int(pmax), lastr)); \
        const float mj = fmaxf(m_st, pmax), mnew = fmaxf(blast + m_st, gmax); \
        sp[lane] = a_; sp[64 + lane] = mj; sp[128 + lane] = __expf(m_st - mj); sp[192 + lane] = __expf(-(bcum + mj)); sp[256 + lane] = __expf(blast + a_ - mnew); \
        if (lane == 0) ((LAS float*)(lds + O_MISC))[(par_)] = __expf(blast + m_st - mnew); m_st = mnew; } while (0)
#define ML_STORE() do { _Pragma("unroll") for (int jt = 0; jt < 2; ++jt) \
        *(u32x4*)(HO + (size_t)(prow0 + jh * 32 + jt * 16 + r16) * DM + h * 256 + es * 64 + (mg - 2) * 32 + 8 * g) = (u32x4){pow_[jt][0].x, pow_[jt][0].y, pow_[jt][1].x, pow_[jt][1].y}; } while (0)
        u32x2 pow_[2][2]; bool pend = false; int prow0 = 0;
#define ML_ROW0(step_) (((step_) < 4) ? (NL + b * CTXL + (dir ? (3 - (step_)) : (step_)) * 64) : (b * SEQ + (dir ? (63 - ((step_) - 4)) : ((step_) - 4)) * 64))
        gs4 = gsc[((size_t)(ML_ROW0(0) >> 6) * 8 + dir * 4 + h) * 64 + lane];
        if (w == 0) *(LAS f32x4*)(lds + O_RAW + lane * 16) = gs4;
        gs4 = gsc[((size_t)(ML_ROW0(1) >> 6) * 8 + dir * 4 + h) * 64 + lane];
        ML_LOAD(0);
        if (w == 0) ML_SCAL(0);
        LDS_BARRIER();
        for (int step = 0; step < 68; ++step) {
            const int p = step & 1; const int row0 = row0n; const bool wr_out = (step >= 4) || (l == 0);
            const LAS float* sp = (const LAS float*)(lds + O_SC + p * SC_PAR);
            const f32x4 wkA = *(const LAS f32x4*)(sp + 256 + (tid & 7) * 8), wkB = *(const LAS f32x4*)(sp + 256 + (tid & 7) * 8 + 4);
#pragma unroll
            for (int o = 0; o < 4; ++o) { const int idx = tid + o * NTHREADS, r = idx >> 5, c8 = (idx & 31) * 8;
                *(LAS u32x4*)(lds + O_Q + r * QP + c8 * 2) = rq[o]; *(LAS u32x4*)(lds + O_K + r * QP + c8 * 2) = rk[o];
                { const u32x4 rw = rt[o]; u32x4 sw;
                  sw.x = cvt_pk_bf16(bf_lo(rw.x) * wkA[0], bf_hi(rw.x) * wkA[1]); sw.y = cvt_pk_bf16(bf_lo(rw.y) * wkA[2], bf_hi(rw.y) * wkA[3]);
                  sw.z = cvt_pk_bf16(bf_lo(rw.z) * wkB[0], bf_hi(rw.z) * wkB[1]); sw.w = cvt_pk_bf16(bf_lo(rw.w) * wkB[2], bf_hi(rw.w) * wkB[3]);
                  *(LAS u32x4*)(lds + O_KT + (idx >> 3) * TP + (idx & 7) * 16) = sw; } }
            { const int ev = tid >> 3, evr = (ev & 32) | ((ev & 4) << 2) | ((ev & 24) >> 1) | (ev & 3);
              *(LAS u32x4*)(lds + O_VT + evr * TP + (tid & 7) * 16) = rv; }
            if (w == 0) *(LAS f32x4*)(lds + O_RAW + (p ^ 1) * 1024 + lane * 16) = gs4;
            { const int sn = step + 2 < 68 ? step + 2 : 67; gs4 = gsc[((size_t)(ML_ROW0(sn) >> 6) * 8 + dir * 4 + h) * 64 + lane]; }
            LDS_BARRIER();
            if (pend) { ML_STORE(); pend = false; }
            if (step + 1 < 68) ML_LOAD(step + 1);
            f32x4 acc[3][2];
#pragma unroll
            for (int t = 0; t < 3; ++t) { acc[t][0] = (f32x4){0.f, 0.f, 0.f, 0.f}; acc[t][1] = acc[t][0]; }
            { const int abase = (isS ? O_K + mg * 32 * QP : O_CT + (mg - 2) * 32 * QP) + r16 * QP + g * 16;
              const int qbase = O_Q + (jh * 32 + r16) * QP + g * 16;
#pragma unroll
              for (int ks = 0; ks < 8; ++ks) {
                  const bf16x8 b0 = *(const LAS bf16x8*)(lds + qbase + ks * 64), b1 = *(const LAS bf16x8*)(lds + qbase + 16 * QP + ks * 64);
                  const bf16x8 a0 = *(const LAS bf16x8*)(lds + abase + ks * 64), a1 = *(const LAS bf16x8*)(lds + abase + 16 * QP + ks * 64);
                  acc[0][0] = __builtin_amdgcn_mfma_f32_16x16x32_bf16(a0, b0, acc[0][0], 0, 0, 0); acc[0][1] = __builtin_amdgcn_mfma_f32_16x16x32_bf16(a0, b1, acc[0][1], 0, 0, 0);
                  acc[1][0] = __builtin_amdgcn_mfma_f32_16x16x32_bf16(a1, b0, acc[1][0], 0, 0, 0); acc[1][1] = __builtin_amdgcn_mfma_f32_16x16x32_bf16(a1, b1, acc[1][1], 0, 0, 0);
                  if (nmt == 3) { const bf16x8 a2 = *(const LAS bf16x8*)(lds + abase + 32 * QP + ks * 64);
                      acc[2][0] = __builtin_amdgcn_mfma_f32_16x16x32_bf16(a2, b0, acc[2][0], 0, 0, 0); acc[2][1] = __builtin_amdgcn_mfma_f32_16x16x32_bf16(a2, b1, acc[2][1], 0, 0, 0); } } }
            if (isS) {
#pragma unroll
                for (int t = 0; t < 2; ++t) { const int s0 = mg * 32 + t * 16 + 4 * g; const f32x4 as = *(const LAS f32x4*)(sp + s0);
#pragma unroll
                    for (int jt = 0; jt < 2; ++jt) { const int j = jh * 32 + jt * 16 + r16; const float mjj = sp[64 + j]; float pv[4];
#pragma unroll
                        for (int i = 0; i < 4; ++i) { const int s = s0 + i; const bool ok = dir ? (s >= j) : (s <= j); pv[i] = ok ? acc[t][jt][i] * __expf(as[i] - mjj) : 0.f; }
                        u32x2 pw; pw.x = cvt_pk_bf16(pv[0], pv[1]); pw.y = cvt_pk_bf16(pv[2], pv[3]);
                        *(LAS u32x2*)(lds + O_P + j * TP + s0 * 2) = pw; } }
            }
            LDS_BARRIER();
            if (!isS) {
#pragma unroll
                for (int jt = 0; jt < 2; ++jt) { const float wi = sp[128 + jh * 32 + jt * 16 + r16];
#pragma unroll
                    for (int t = 0; t < 3; ++t) acc[t][jt] *= wi; }
                const int vbase = O_VT + ((mg - 2) * 32 + r16) * TP + g * 16, pbase = O_P + (jh * 32 + r16) * TP + g * 16;
#pragma unroll
                for (int ks = 0; ks < 2; ++ks) {
                    const bf16x8 b0 = *(const LAS bf16x8*)(lds + pbase + ks * 64), b1 = *(const LAS bf16x8*)(lds + pbase + 16 * TP + ks * 64);
                    const bf16x8 a0 = *(const LAS bf16x8*)(lds + vbase + ks * 64), a1 = *(const LAS bf16x8*)(lds + vbase + 16 * TP + ks * 64);
                    acc[0][0] = __builtin_amdgcn_mfma_f32_16x16x32_bf16(a0, b0, acc[0][0], 0, 0, 0); acc[0][1] = __builtin_amdgcn_mfma_f32_16x16x32_bf16(a0, b1, acc[0][1], 0, 0, 0);
                    acc[1][0] = __builtin_amdgcn_mfma_f32_16x16x32_bf16(a1, b0, acc[1][0], 0, 0, 0); acc[1][1] = __builtin_amdgcn_mfma_f32_16x16x32_bf16(a1, b1, acc[1][1], 0, 0, 0);
                    if (nmt == 3) { const bf16x8 a2 = *(const LAS bf16x8*)(lds + vbase + 32 * TP + ks * 64);
                        acc[2][0] = __builtin_amdgcn_mfma_f32_16x16x32_bf16(a2, b0, acc[2][0], 0, 0, 0); acc[2][1] = __builtin_amdgcn_mfma_f32_16x16x32_bf16(a2, b1, acc[2][1], 0, 0, 0); } }
                if (mg == 3 && g == 0) { LAS float* dn = (LAS float*)(lds + O_DEN); dn[jh * 32 + r16] = acc[2][0][0]; dn[jh * 32 + 16 + r16] = acc[2][1][0]; }
            } else if (w == 0 && step + 1 < 68) { ML_SCAL(p ^ 1); }
            { const float wc = ((const LAS float*)(lds + O_MISC))[p];
#pragma unroll
              for (int a = 0; a < 2; ++a)
#pragma unroll
                  for (int e = 0; e < 5; ++e) accC[a][e] *= wc;
#pragma unroll
              for (int ks = 0; ks < 2; ++ks) {
                  bf16x8 bv[5];
#pragma unroll
                  for (int e = 0; e < 5; ++e) bv[e] = *(const LAS bf16x8*)(lds + O_VT + (e * 16 + r16) * TP + ks * 64 + g * 16);
#pragma unroll
                  for (int a = 0; a < 2; ++a) { const bf16x8 ka = *(const LAS bf16x8*)(lds + O_KT + ((w * 2 + a) * 16 + r16) * TP + ks * 64 + g * 16);
#pragma unroll
                      for (int e = 0; e < 5; ++e) accC[a][e] = __builtin_amdgcn_mfma_f32_16x16x32_bf16(ka, bv[e], accC[a][e], 0, 0, 0); } } }
            LDS_BARRIER();
#pragma unroll
            for (int a = 0; a < 2; ++a)
#pragma unroll
                for (int e = 0; e < 5; ++e) { const int er = e * 16 + r16;
                    if (er <= 64) { u32x2 cw; cw.x = cvt_pk_bf16(accC[a][e][0], accC[a][e][1]); cw.y = cvt_pk_bf16(accC[a][e][2], accC[a][e][3]);
                        *(LAS u32x2*)(lds + O_CT + er * QP + ((w * 2 + a) * 16 + 4 * g) * 2) = cw; } }
            pend = !isS && wr_out; prow0 = row0;
            if (pend) {
#pragma unroll
                for (int jt = 0; jt < 2; ++jt) { const int j = jh * 32 + jt * 16 + r16;
                    const float den = ((const LAS float*)(lds + O_DEN))[j]; const float inv = __builtin_amdgcn_rcpf(fmaxf(fabsf(den), sp[192 + j]));
#pragma unroll
                    for (int t = 0; t < 2; ++t) { pow_[jt][t].x = cvt_pk_bf16(acc[t][jt][0] * inv, acc[t][jt][1] * inv); pow_[jt][t].y = cvt_pk_bf16(acc[t][jt][2] * inv, acc[t][jt][3] * inv); } }
            }
        }
        if (pend) { ML_STORE(); pend = false; }
#undef ML_LOAD
#undef ML_ROW0
#undef ML_SCAL
#undef ML_STORE
    }
}

typedef short s16x4 __attribute__((ext_vector_type(4)));
__device__ __forceinline__ bf16x8 tr_frag(LAS unsigned char* img, int pitch, int ks, int c, int lane) {
    const int g = lane >> 4, q = (lane & 15) >> 2, p = lane & 3;
    LAS unsigned char* a0 = img + (32 * ks + 8 * g + q) * pitch + (16 * c + 4 * p) * 2;
    const s16x4 lo = __builtin_amdgcn_ds_read_tr16_b64_v4i16((LAS s16x4*)a0), hi = __builtin_amdgcn_ds_read_tr16_b64_v4i16((LAS s16x4*)(a0 + 4 * pitch));
    return __builtin_shufflevector(lo, hi, 0, 1, 2, 3, 4, 5, 6, 7);
}
__device__ __forceinline__ void mlstm_phase_tr(const Frame& F, int l) {
    constexpr int QP = 544, KP = 544, VP = 208, TP = 160;
    constexpr int O_Q = 0, O_K = O_Q + 64 * QP, O_VR = O_K + 64 * KP, O_VS = O_VR + 64 * VP, O_CT = O_VS + 64 * VP, O_P = O_CT + 65 * QP, O_SC = O_P + 64 * TP;
    constexpr int SC_PAR = 1280;
    constexpr int O_DEN = O_SC + 2 * SC_PAR, O_MISC = O_DEN + 256, O_RAW = O_MISC + 64;
    static_assert(O_RAW + 2048 <= LDS_BYTES - 16, "mlstm LDS map");
    const bf16_t* QKV = (const bf16_t*)(F.ws + WS_R1); const f32x4* gsc = (const f32x4*)(F.ws + WS_GSC);
    LAS unsigned char* lds = F.lds;
    const int tid = F.tid, lane = F.lane, w = F.wave, r16 = lane & 15, g = lane >> 4;
    const int jh = w & 1, mg = w >> 1; const bool isS = mg < 2; const int nmt = mg == 3 ? 3 : 2;
    for (int un = F.bid; un < 256; un += F.G) {
        const int xcd = un & 7, q = un >> 3, seq = xcd * 8 + (q >> 2), es = q & 3;
        const int b = seq >> 3, h = (seq >> 1) & 3, dir = seq & 1;
        bf16_t* HO = (bf16_t*)(F.ws + (dir ? WS_HB : WS_HF));
        __syncthreads();
        for (int i = tid; i < 65 * QP / 4; i += NTHREADS) ((LAS unsigned*)(lds + O_CT))[i] = 0u;
        if (tid < 64) {
            LAS unsigned short* vr = (LAS unsigned short*)(lds + O_VR + tid * VP + 128); LAS unsigned short* vs = (LAS unsigned short*)(lds + O_VS + tid * VP + 128);
            unsigned one16 = 0x3F80u, zero16 = 0u; asm volatile("" : "+v"(one16), "+v"(zero16));
#pragma unroll
            for (int c = 0; c < 16; ++c) { vr[c] = c == 0 ? (unsigned short)one16 : (unsigned short)zero16; vs[c] = (unsigned short)zero16; } }
        f32x4 accC[2][5];
#pragma unroll
        for (int a = 0; a < 2; ++a)
#pragma unroll
            for (int e = 0; e < 5; ++e) accC[a][e] = (f32x4){0.f, 0.f, 0.f, 0.f};
        float m_st = 0.f;
        u32x4 rq[4], rk[4], rv; f32x4 gs4 = {0.f, 0.f, 0.f, 0.f}; int row0n = 0;
#define ML_LOAD(step_) do { const int _st = (step_); const bool _ic = _st < 4; const int _ci = _ic ? _st : _st - 4, _n = _ic ? 4 : 64, _ca = dir ? (_n - 1 - _ci) : _ci; \
        row0n = _ic ? (NL + b * CTXL + _ca * 64) : (b * SEQ + _ca * 64); \
        _Pragma("unroll") for (int o = 0; o < 4; ++o) { const int idx = tid + o * NTHREADS, r = idx >> 5, c8 = (idx & 31) * 8; \
            rq[o] = *(const u32x4*)(QKV + (size_t)(row0n + r) * NQKV + h * 256 + c8); rk[o] = *(const u32x4*)(QKV + (size_t)(row0n + r) * NQKV + 1024 + h * 256 + c8); } \
        rv = *(const u32x4*)(QKV + (size_t)(row0n + (tid >> 3)) * NQKV + 2048 + h * 256 + es * 64 + (tid & 7) * 8); } while (0)
#define ML_SCAL(par_) do { LAS float* sp = (LAS float*)(lds + O_SC + (par_) * SC_PAR); const int lastr = dir ? 0 : 63; \
        const f32x4 g4 = *(const LAS f32x4*)(lds + O_RAW + (par_) * 1024 + lane * 16); const float a_ = g4[0], bcum = g4[1], pmax = g4[2]; \
        const float blast = __int_as_float(__builtin_amdgcn_readlane(__float_as_int(bcum), lastr)), gmax = blast + __int_as_float(__builtin_amdgcn_readlane(__float_as_int(pmax), lastr)); \
        const float mj = fmaxf(m_st, pmax), mnew = fmaxf(blast + m_st, gmax); \
        sp[lane] = a_; sp[64 + lane] = mj; sp[128 + lane] = __expf(m_st - mj); sp[192 + lane] = __expf(-(bcum + mj)); sp[256 + lane] = __expf(blast + a_ - mnew); \
        if (lane == 0) ((LAS float*)(lds + O_MISC))[(par_)] = __expf(blast + m_st - mnew); m_st = mnew; } while (0)
#define ML_STORE() do { _Pragma("unroll") for (int jt = 0; jt < 2; ++jt) \
        *(u32x4*)(HO + (size_t)(prow0 + jh * 32 + jt * 16 + r16) * DM + h * 256 + es * 64 + (mg - 2) * 32 + 8 * g) = (u32x4){pow_[jt][0].x, pow_[jt][0].y, pow_[jt][1].x, pow_[jt][1].y}; } while (0)
        u32x2 pow_[2][2]; bool pend = false; int prow0 = 0;
#define ML_ROW0(step_) (((step_) < 4) ? (NL + b * CTXL + (dir ? (3 - (step_)) : (step_)) * 64) : (b * SEQ + (dir ? (63 - ((step_) - 4)) : ((step_) - 4)) * 64))
        gs4 = gsc[((size_t)(ML_ROW0(0) >> 6) * 8 + dir * 4 + h) * 64 + lane];
        if (w == 0) *(LAS f32x4*)(lds + O_RAW + lane * 16) = gs4;
        gs4 = gsc[((size_t)(ML_ROW0(1) >> 6) * 8 + dir * 4 + h) * 64 + lane];
        ML_LOAD(0);
        if (w == 0) ML_SCAL(0);
        LDS_BARRIER();
        for (int step = 0; step < 68; ++step) {
            const int p = step & 1; const int row0 = row0n; const bool wr_out = (step >= 4) || (l == 0);
            const LAS float* sp = (const LAS float*)(lds + O_SC + p * SC_PAR);
#pragma unroll
            for (int o = 0; o < 4; ++o) { const int idx = tid + o * NTHREADS, r = idx >> 5, c8 = (idx & 31) * 8;
                *(LAS u32x4*)(lds + O_Q + r * QP + c8 * 2) = rq[o]; *(LAS u32x4*)(lds + O_K + r * KP + c8 * 2) = rk[o]; }
            {
              const int vs_ = tid >> 3, c8 = (tid & 7) * 8, cl = (c8 & 32) + ((c8 >> 3) & 3) * 4; const float wks = sp[256 + vs_];
              u32x2 lo, hi; lo.x = rv.x; lo.y = rv.y; hi.x = rv.z; hi.y = rv.w;
              *(LAS u32x2*)(lds + O_VR + vs_ * VP + cl * 2) = lo; *(LAS u32x2*)(lds + O_VR + vs_ * VP + (cl + 16) * 2) = hi;
              u32x2 slo, shi; slo.x = cvt_pk_bf16(bf_lo(rv.x) * wks, bf_hi(rv.x) * wks); slo.y = cvt_pk_bf16(bf_lo(rv.y) * wks, bf_hi(rv.y) * wks);
              shi.x = cvt_pk_bf16(bf_lo(rv.z) * wks, bf_hi(rv.z) * wks); shi.y = cvt_pk_bf16(bf_lo(rv.w) * wks, bf_hi(rv.w) * wks);
              *(LAS u32x2*)(lds + O_VS + vs_ * VP + cl * 2) = slo; *(LAS u32x2*)(lds + O_VS + vs_ * VP + (cl + 16) * 2) = shi;
              if ((tid & 7) == 0) *(LAS unsigned short*)(lds + O_VS + vs_ * VP + 128) = f2bf(wks); }
            if (w == 0) *(LAS f32x4*)(lds + O_RAW + (p ^ 1) * 1024 + lane * 16) = gs4;
            { const int sn = step + 2 < 68 ? step + 2 : 67; gs4 = gsc[((size_t)(ML_ROW0(sn) >> 6) * 8 + dir * 4 + h) * 64 + lane]; }
            LDS_BARRIER();
            if (pend) { ML_STORE(); pend = false; }
            if (step + 1 < 68) ML_LOAD(step + 1);
            f32x4 acc[3][2];
#pragma unroll
            for (int t = 0; t < 3; ++t) { acc[t][0] = (f32x4){0.f, 0.f, 0.f, 0.f}; acc[t][1] = acc[t][0]; }
            if (wr_out) { const int apitch = isS ? KP : QP;            const int abase = (isS ? O_K + mg * 32 * KP : O_CT + (mg - 2) * 32 * QP) + r16 * apitch + g * 16;
              const int qbase = O_Q + (jh * 32 + r16) * QP + g * 16;
#pragma unroll
              for (int ks = 0; ks < 8; ++ks) {
                  const bf16x8 b0 = *(const LAS bf16x8*)(lds + qbase + ks * 64), b1 = *(const LAS bf16x8*)(lds + qbase + 16 * QP + ks * 64);
                  const bf16x8 a0 = *(const LAS bf16x8*)(lds + abase + ks * 64), a1 = *(const LAS bf16x8*)(lds + abase + 16 * apitch + ks * 64);
                  acc[0][0] = __builtin_amdgcn_mfma_f32_16x16x32_bf16(a0, b0, acc[0][0], 0, 0, 0); acc[0][1] = __builtin_amdgcn_mfma_f32_16x16x32_bf16(a0, b1, acc[0][1], 0, 0, 0);
                  acc[1][0] = __builtin_amdgcn_mfma_f32_16x16x32_bf16(a1, b0, acc[1][0], 0, 0, 0); acc[1][1] = __builtin_amdgcn_mfma_f32_16x16x32_bf16(a1, b1, acc[1][1], 0, 0, 0);
                  if (nmt == 3) { const bf16x8 a2 = *(const LAS bf16x8*)(lds + abase + 32 * apitch + ks * 64);
                      acc[2][0] = __builtin_amdgcn_mfma_f32_16x16x32_bf16(a2, b0, acc[2][0], 0, 0, 0); acc[2][1] = __builtin_amdgcn_mfma_f32_16x16x32_bf16(a2, b1, acc[2][1], 0, 0, 0); } } }
            if (isS && wr_out) {
#pragma unroll
                for (int t = 0; t < 2; ++t) { const int s0 = mg * 32 + t * 16 + 4 * g; const f32x4 as = *(const LAS f32x4*)(sp + s0);
#pragma unroll
                    for (int jt = 0; jt < 2; ++jt) { const int j = jh * 32 + jt * 16 + r16; const float mjj = sp[64 + j]; float pv[4];
#pragma unroll
                        for (int i = 0; i < 4; ++i) { const int s = s0 + i; const bool ok = dir ? (s >= j) : (s <= j); pv[i] = ok ? acc[t][jt][i] * __expf(as[i] - mjj) : 0.f; }
                        u32x2 pw; pw.x = cvt_pk_bf16(pv[0], pv[1]); pw.y = cvt_pk_bf16(pv[2], pv[3]);
                        *(LAS u32x2*)(lds + O_P + j * TP + s0 * 2) = pw; } }
            }
            LDS_BARRIER();
            if (!isS) { if (wr_out) {
#pragma unroll
                for (int jt = 0; jt < 2; ++jt) { const float wi = sp[128 + jh * 32 + jt * 16 + r16];
#pragma unroll
                    for (int t = 0; t < 3; ++t) acc[t][jt] *= wi; }
                const int et0 = (mg - 2) * 2, pbase = O_P + (jh * 32 + r16) * TP + g * 16;
#pragma unroll
                for (int ks = 0; ks < 2; ++ks) {
                    const bf16x8 b0 = *(const LAS bf16x8*)(lds + pbase + ks * 64), b1 = *(const LAS bf16x8*)(lds + pbase + 16 * TP + ks * 64);
                    const bf16x8 a0 = tr_frag(lds + O_VR, VP, ks, et0, lane), a1 = tr_frag(lds + O_VR, VP, ks, et0 + 1, lane);
                    acc[0][0] = __builtin_amdgcn_mfma_f32_16x16x32_bf16(a0, b0, acc[0][0], 0, 0, 0); acc[0][1] = __builtin_amdgcn_mfma_f32_16x16x32_bf16(a0, b1, acc[0][1], 0, 0, 0);
                    acc[1][0] = __builtin_amdgcn_mfma_f32_16x16x32_bf16(a1, b0, acc[1][0], 0, 0, 0); acc[1][1] = __builtin_amdgcn_mfma_f32_16x16x32_bf16(a1, b1, acc[1][1], 0, 0, 0);
                    if (nmt == 3) { const bf16x8 a2 = tr_frag(lds + O_VR, VP, ks, et0 + 2, lane);
                        acc[2][0] = __builtin_amdgcn_mfma_f32_16x16x32_bf16(a2, b0, acc[2][0], 0, 0, 0); acc[2][1] = __builtin_amdgcn_mfma_f32_16x16x32_bf16(a2, b1, acc[2][1], 0, 0, 0); } }
                if (mg == 3 && g == 0) { LAS float* dn = (LAS float*)(lds + O_DEN); dn[jh * 32 + r16] = acc[2][0][0]; dn[jh * 32 + 16 + r16] = acc[2][1][0]; } }
            } else if (w == 0 && step + 1 < 68) { ML_SCAL(p ^ 1); }
            { const float wc = ((const LAS float*)(lds + O_MISC))[p];
#pragma unroll
              for (int a = 0; a < 2; ++a)
#pragma unroll
                  for (int e = 0; e < 5; ++e) accC[a][e] *= wc;
#pragma unroll
              for (int ks = 0; ks < 2; ++ks) {
                  bf16x8 bv[5];
#pragma unroll
                  for (int e = 0; e < 5; ++e) bv[e] = tr_frag(lds + O_VS, VP, ks, e, lane);
#pragma unroll
                  for (int a = 0; a < 2; ++a) { const bf16x8 ka = tr_frag(lds + O_K, KP, ks, w * 2 + a, lane);
#pragma unroll
                      for (int e = 0; e < 5; ++e) accC[a][e] = __builtin_amdgcn_mfma_f32_16x16x32_bf16(ka, bv[e], accC[a][e], 0, 0, 0); } } }
            LDS_BARRIER();
#pragma unroll
            for (int a = 0; a < 2; ++a)
#pragma unroll
                for (int e = 0; e < 5; ++e) { const int er = e * 16 + r16;
                    if (er <= 64) { u32x2 cw; cw.x = cvt_pk_bf16(accC[a][e][0], accC[a][e][1]); cw.y = cvt_pk_bf16(accC[a][e][2], accC[a][e][3]);
                        *(LAS u32x2*)(lds + O_CT + er * QP + ((w * 2 + a) * 16 + 4 * g) * 2) = cw; } }
            pend = !isS && wr_out; prow0 = row0;
            if (pend) {
#pragma unroll
                for (int jt = 0; jt < 2; ++jt) { const int j = jh * 32 + jt * 16 + r16;
                    const float den = ((const LAS float*)(lds + O_DEN))[j]; const float inv = __builtin_amdgcn_rcpf(fmaxf(fabsf(den), sp[192 + j]));
#pragma unroll
                    for (int t = 0; t < 2; ++t) { pow_[jt][t].x = cvt_pk_bf16(acc[t][jt][0] * inv, acc[t][jt][1] * inv); pow_[jt][t].y = cvt_pk_bf16(acc[t][jt][2] * inv, acc[t][jt][3] * inv); } }
            }
        }
        if (pend) { ML_STORE(); pend = false; }
#undef ML_LOAD
#undef ML_ROW0
#undef ML_SCAL
#undef ML_STORE
    }
}

__device__ __forceinline__ void post_phase(const Frame& F, int l) {
    const int M = l == 0 ? MT : NL;
    bf16_t* AC = (bf16_t*)(F.ws + WS_ACAT); const bf16_t* HF = (const bf16_t*)(F.ws + WS_HF); const bf16_t* HB = (const bf16_t*)(F.ws + WS_HB); const unsigned char* ZS = (const unsigned char*)(F.ws + WS_ZS); const bf16_t* ZP = (const bf16_t*)(F.ws + WS_ZP);
    const float* hg = F.in(I_HGAIN) + l * DM;
    u32x2 pa[4], pb[4]; unsigned po[4];
    f32x4 hgv[4];
#pragma unroll
    for (int hh = 0; hh < 4; ++hh) hgv[hh] = *(const f32x4*)(hg + hh * 256 + F.lane * 4);
    { const int row = F.bid * 8 + F.wave;
      if (row < M) {
#pragma unroll
          for (int hh = 0; hh < 4; ++hh) { const int k = hh * 256 + F.lane * 4;
              pa[hh] = *(const u32x2*)(HF + (size_t)row * DM + k); pb[hh] = *(const u32x2*)(HB + (size_t)row * DM + k); po[hh] = *(const unsigned*)(ZS + (size_t)row * 3072 + k); } } }
    for (int row = F.bid * 8 + F.wave; row < M; row += F.G * 8) {
        u32x2 ca[4], cb[4]; unsigned co[4];
#pragma unroll
        for (int hh = 0; hh < 4; ++hh) { ca[hh] = pa[hh]; cb[hh] = pb[hh]; co[hh] = po[hh]; }
        { const int rn = row + F.G * 8;
          if (rn < M) {
#pragma unroll
              for (int hh = 0; hh < 4; ++hh) { const int k = hh * 256 + F.lane * 4;
                  pa[hh] = *(const u32x2*)(HF + (size_t)rn * DM + k); pb[hh] = *(const u32x2*)(HB + (size_t)rn * DM + k); po[hh] = *(const unsigned*)(ZS + (size_t)rn * 3072 + k); } } }
#pragma unroll
        for (int hh = 0; hh < 4; ++hh) { const int k = hh * 256 + F.lane * 4;
            const u32x2 a = ca[hh], b = cb[hh]; const unsigned o = co[hh];
            f32x4 x = (f32x4){bf_lo(a.x) + bf_lo(b.x), bf_hi(a.x) + bf_hi(b.x), bf_lo(a.y) + bf_lo(b.y), bf_hi(a.y) + bf_hi(b.y)};
            const float mu = wave_sum(x[0] + x[1] + x[2] + x[3], F.lane) * (1.0f / 256.0f);
            x -= mu;
            const float var = wave_sum(x[0] * x[0] + x[1] * x[1] + x[2] * x[2] + x[3] * x[3], F.lane) * (1.0f / 256.0f);
            const float rs = rsqrtf(var + EPS);
            const f32x4 g4 = hgv[hh], so = unpack4_u8(o);
            x = so * ((x * rs) * g4);
            u32x2 w; w.x = cvt_pk_bf16(x[0], x[1]); w.y = cvt_pk_bf16(x[2], x[3]);
            *(u32x2*)(AC + (size_t)row * KCAT + k) = w; }
    }
    bf16_t* PO = AC + 1024;
    LAS float* Vs = (LAS float*)F.lds;
    constexpr int VP = 132;
    const int nun = 8 * 64 * 4 + (l == 0 ? 8 * 4 * 4 : 0);
    const int c = F.tid >> 3, q = F.tid & 7;
    for (int un = F.bid; un < nun; un += F.G) {
        float xc[16]; int lo, hi, nrow; size_t orow;
        if (un < 2048) {
            const int b = un >> 8, gr = (un >> 2) & 63, g = (un + (un >> 8)) & 3, hw = 1 << g;
            const int rlo = (gr - hw) > 0 ? (gr - hw) : 0, rhi = (gr + hw) < 64 ? (gr + hw) : 64;
            float vs[16];
#pragma unroll
            for (int i = 0; i < 16; ++i) vs[i] = 0.f;
#define POOL_ROWS(NB) \
            for (int r4 = rlo; r4 < rhi; r4 += NB) {        \
                u32x4 w0[NB], w1[NB]; \
                _Pragma("unroll") \
                for (int k = 0; k < NB; ++k) { const int r = (r4 + k) < rhi ? (r4 + k) : (rhi - 1); const bf16_t* p = ZP + (size_t)(b * SEQ + r * 64 + c) * 512 + g * 128 + q * 16; \
                    w0[k] = *(const u32x4*)p; w1[k] = *(const u32x4*)(p + 8); } \
                _Pragma("unroll") \
                for (int k = 0; k < NB; ++k) { if (r4 + k < rhi) { f32x4 f0, f1, f2, f3; unpack8(w0[k], f0, f1); unpack8(w1[k], f2, f3); \
                    _Pragma("unroll") \
                    for (int i = 0; i < 4; ++i) { vs[i] += f0[i]; vs[4 + i] += f1[i]; vs[8 + i] += f2[i]; vs[12 + i] += f3[i]; } \
                    if (r4 + k == gr) { \
                        _Pragma("unroll") \
                        for (int i = 0; i < 4; ++i) { xc[i] = f0[i]; xc[4 + i] = f1[i]; xc[8 + i] = f2[i]; xc[12 + i] = f3[i]; } } } } }
            if (g >= 2) { POOL_ROWS(8) } else { POOL_ROWS(4) }
#undef POOL_ROWS
#pragma unroll
            for (int i = 0; i < 4; ++i) *(LAS f32x4*)(Vs + (c + 8) * VP + q * 16 + i * 4) = (f32x4){vs[i * 4], vs[i * 4 + 1], vs[i * 4 + 2], vs[i * 4 + 3]};
            nrow = rhi - rlo; lo = (c - hw) > 0 ? (c - hw) : 0; hi = (c + hw) < 64 ? (c + hw) : 64; lo += 8; hi += 8;
            orow = (size_t)(b * SEQ + gr * 64 + c);
        } else {
            const int u2 = un - 2048, b = u2 >> 4, tb = (u2 >> 2) & 3, g = u2 & 3, hw = 1 << g, t0 = tb * 64;
            for (int pp = c; pp < 80; pp += 64) { const int t = t0 - 8 + pp; f32x4 f0 = {0.f, 0.f, 0.f, 0.f}, f1 = f0, f2 = f0, f3 = f0;
                if (t >= 0 && t < CTXL) { const bf16_t* p = ZP + (size_t)(NL + b * CTXL + t) * 512 + g * 128 + q * 16;
                    unpack8(*(const u32x4*)p, f0, f1); unpack8(*(const u32x4*)(p + 8), f2, f3); }
                *(LAS f32x4*)(Vs + pp * VP + q * 16) = f0; *(LAS f32x4*)(Vs + pp * VP + q * 16 + 4) = f1; *(LAS f32x4*)(Vs + pp * VP + q * 16 + 8) = f2; *(LAS f32x4*)(Vs + pp * VP + q * 16 + 12) = f3;
                }
            { const int t = t0 + c; const bf16_t* p = ZP + (size_t)(NL + b * CTXL + t) * 512 + g * 128 + q * 16; f32x4 f0, f1, f2, f3;
              unpack8(*(const u32x4*)p, f0, f1); unpack8(*(const u32x4*)(p + 8), f2, f3);
#pragma unroll
              for (int i = 0; i < 4; ++i) { xc[i] = f0[i]; xc[4 + i] = f1[i]; xc[8 + i] = f2[i]; xc[12 + i] = f3[i]; }
              const int tlo = (t - hw) > 0 ? (t - hw) : 0, thi = (t + hw) < CTXL ? (t + hw) : CTXL;
              lo = tlo - t0 + 8; hi = thi - t0 + 8; nrow = 1; orow = (size_t)(NL + b * CTXL + t); }
        }
        LDS_BARRIER();
        { float sm[16];
#pragma unroll
          for (int i = 0; i < 16; ++i) sm[i] = 0.f;
          for (int pp = lo; pp < hi; ++pp) {
#pragma unroll
              for (int i = 0; i < 4; ++i) { const f32x4 f = *(const LAS f32x4*)(Vs + pp * VP + q * 16 + i * 4); sm[i * 4] += f[0]; sm[i * 4 + 1] += f[1]; sm[i * 4 + 2] += f[2]; sm[i * 4 + 3] += f[3]; } }
          const float inv = 1.0f / (float)(nrow * (hi - lo));
          const int g = un < 2048 ? ((un + (un >> 8)) & 3) : ((un - 2048) & 3);
          u32x4 w0, w1;
          w0.x = cvt_pk_bf16(sm[0] * inv - xc[0], sm[1] * inv - xc[1]); w0.y = cvt_pk_bf16(sm[2] * inv - xc[2], sm[3] * inv - xc[3]);
          w0.z = cvt_pk_bf16(sm[4] * inv - xc[4], sm[5] * inv - xc[5]); w0.w = cvt_pk_bf16(sm[6] * inv - xc[6], sm[7] * inv - xc[7]);
          w1.x = cvt_pk_bf16(sm[8] * inv - xc[8], sm[9] * inv - xc[9]); w1.y = cvt_pk_bf16(sm[10] * inv - xc[10], sm[11] * inv - xc[11]);
          w1.z = cvt_pk_bf16(sm[12] * inv - xc[12], sm[13] * inv - xc[13]); w1.w = cvt_pk_bf16(sm[14] * inv - xc[14], sm[15] * inv - xc[15]);
          bf16_t* op = PO + orow * KCAT + g * 128 + q * 16;
          *(u32x4*)op = w0; *(u32x4*)(op + 8) = w1; }
        LDS_BARRIER();
    }
}

constexpr int PH_FINAL = 49, PH_END = 50;
struct Args { const float* in[25]; float* out; unsigned char* ws; int ph_lo, ph_hi; };
extern __shared__ __attribute__((aligned(16))) unsigned char lds_raw[];

__device__ __forceinline__ int lane_id_volatile() { int l_; asm volatile("v_mbcnt_lo_u32_b32 %0, -1, 0\n\tv_mbcnt_hi_u32_b32 %0, -1, %0" : "=v"(l_)); return l_; }
__device__ __forceinline__ Frame make_frame(const int wv) {
    Frame F;
    F.out = (float*)karg_in(25); F.ws = (unsigned char*)karg_in(26); F.ctl = (unsigned*)(F.ws + WS_CTL); F.lds = (LAS unsigned char*)lds_raw;
    int tid = wv * 64 + lane_id_volatile(), bid = blockIdx.x, G = gridDim.x;
    asm volatile("" : "+v"(tid)); asm volatile("" : "+s"(bid)); asm volatile("" : "+s"(G));
    F.G = G; F.bid = bid; F.tid = tid; F.lane = tid & 63; F.wave = __builtin_amdgcn_readfirstlane(tid >> 6);
    return F;
}
#if MK_MULTI
#define PHASE_FN __device__ __forceinline__
#else
#define PHASE_FN __device__ __forceinline__
#endif
#define UNI(x) __builtin_amdgcn_readfirstlane(x)
PHASE_FN void ph_prologue(const int wv) { const Frame F = make_frame(wv); prologue_phase(F); }
PHASE_FN void ph_norm(const int wv, int l, int which) { const Frame F = make_frame(wv); l = UNI(l); which = UNI(which); if (l == 0 && which == 0) norm_phase<true>(F, l, which); else norm_phase<false>(F, l, which); }
PHASE_FN void ph_norm2x(const int wv, int l) { const Frame F = make_frame(wv); l = UNI(l); norm_phase<false>(F, l, l == 0 ? 1 : 2); if (l == 1) expert_convert(F, (LAS float*)(F.lds + 81920)); }
PHASE_FN void ph_gemm_a(const int wv, int l) { const Frame F = make_frame(wv); l = UNI(l);
    SchedDense S{(const char*)(F.ws + WS_R0), (const char*)(F.ws + WS_WQKV) + (size_t)l * NQKV * DM * 2, DM * 2, DM * 2, MT / 256, NQKV / 256, F.G, F.bid};
    EpiQKV E{(bf16_t*)(F.ws + WS_R1), (bf16_t*)(F.ws + WS_HALO)};
    gp::gemm_phase<0>(F.lds, DM * 2, S, E, F.tid); }
PHASE_FN void ph_prep(const int wv, int l) { const Frame F = make_frame(wv); prep_phase(F, UNI(l)); }
#ifndef MLSTM_REF
#define MLSTM_REF 0
#endif
PHASE_FN void ph_mlstm(const int wv, int l) { const Frame F = make_frame(wv);
#if MLSTM_REF
    mlstm_phase_ref(F, UNI(l));
#else
#if MLSTM_TR
    mlstm_phase_tr(F, UNI(l));
#else
    mlstm_phase_mfma(F, UNI(l));
#endif
#endif
}
PHASE_FN void ph_gemm_b(const int wv, int l) { const Frame F = make_frame(wv); l = UNI(l); const int M = l == 0 ? MT : NL;
    SchedDense S{(const char*)(F.ws + WS_R0), (const char*)(F.ws + WS_WB) + (size_t)l * NZB * DM * 2, DM * 2, DM * 2, M / 256, NZB / 256, F.G, (F.bid + F.G / 2) % F.G};
    EpiZB E{(unsigned char*)(F.ws + WS_ZS), (bf16_t*)(F.ws + WS_ZP)};
    gp::gemm_phase<0>(F.lds, DM * 2, S, E, F.tid); }
PHASE_FN void ph_post(const int wv, int l) { const Frame F = make_frame(wv); post_phase(F, UNI(l)); }
PHASE_FN void ph_merge1(const int wv, int l) { const Frame F = make_frame(wv); l = UNI(l); const int M = l == 0 ? MT : NL;
    WithDep<SchedDenseT<(DEPMASK & 1u) != 0>, (DEPMASK & 1u) ? 1 : 0> S{{(const char*)(F.ws + WS_ACAT), (const char*)(F.ws + WS_WCAT) + (size_t)l * DM * KCAT * 2, KCAT * 2, KCAT * 2, M / 256, DM / 256, F.G, F.bid}, CW_DEP_MERGE + l * 256, 0u};
    EpiMerge E{(bf16_t*)(F.ws + WS_R0), (const unsigned char*)(F.ws + WS_ZS)};
    gp::gemm_phase<0>(F.lds, KCAT * 2, S, E, F.tid); }
PHASE_FN void ph_merge2(const int wv, int l) { (void)wv; (void)l; }
PHASE_FN void ph_out(const int wv, int l) { const Frame F = make_frame(wv); l = UNI(l); const int M = l == 0 ? MT : NL;
    const float* modl = (const float*)(F.ws + WS_MOD) + (size_t)l * 9 * 6144;
    WithDep<SchedDenseT<(DEPMASK & 1u) != 0>, (DEPMASK & 1u) ? 2 : 0> S{{(const char*)(F.ws + WS_R0), (const char*)(F.ws + WS_WOUT) + (size_t)l * DM * DM * 2, DM * 2, DM * 2, M / 256, DM / 256, F.G, (F.bid + F.G / 2) % F.G}, CW_DEP_MERGE + l * 256, 32u};
    bf16_t* H = (bf16_t*)F.out; bf16_t* HC = (bf16_t*)(F.ws + WS_HC16);
    if (l == 0) { EpiResid<true> E{F.in(I_X), H, F.in(I_CTX), HC, modl, MOD_GT1, 1.0f}; gp::gemm_phase<0>(F.lds, DM * 2, S, E, F.tid); }
    else { EpiResid<false> E{H, H, HC, HC, modl, MOD_GT1, 1.0f}; gp::gemm_phase<0>(F.lds, DM * 2, S, E, F.tid); } }
PHASE_FN void ph_ffn1(const int wv) { const Frame F = make_frame(wv);
    constexpr int ES = FP8_DENSE ? 1 : 2;
    WithDep<SchedDenseT<(DEPMASK & 2u) != 0>, (DEPMASK & 2u) ? 1 : 0> S{{(const char*)(F.ws + WS_R0), (const char*)(F.ws + WS_WFGU), DM * ES, DM * ES, MT / 256, 2 * DFF / 256, F.G, F.bid}, CW_DEP_FFN, 0u};
    EpiSwiglu<(FP8_DENSE || FP8_FFN2)> E{(unsigned char*)(F.ws + WS_ACT), DFF * ((FP8_DENSE || FP8_FFN2) ? 1 : 2), FP8_DENSE ? WSCALE_INV : 1.0f};
    gp::gemm_phase<FP8_DENSE>(F.lds, DM * ES, S, E, F.tid); }
PHASE_FN void ph_ffn2(const int wv) { const Frame F = make_frame(wv);
    constexpr int F8 = (FP8_DENSE || FP8_FFN2) ? 1 : 0, ES = F8 ? 1 : 2;
    const float* modl = (const float*)(F.ws + WS_MOD);
    WithDep<SchedDenseT<(DEPMASK & 2u) != 0>, (DEPMASK & 2u) ? 2 : 0> S{{(const char*)(F.ws + WS_ACT), (const char*)(F.ws + WS_WFD), DFF * ES, DFF * ES, MT / 256, DM / 256, F.G, (F.bid + 80) % F.G}, CW_DEP_FFN, (unsigned)(2 * DFF / 256) * 8u};
    bf16_t* H = (bf16_t*)F.out; bf16_t* HC = (bf16_t*)(F.ws + WS_HC16);
    EpiResid<false> E{H, H, HC, HC, modl, MOD_GT2, F8 ? WSCALE_INV : 1.0f};
    gp::gemm_phase<F8>(F.lds, DFF * ES, S, E, F.tid); }
PHASE_FN void ph_moe1(const int wv, int r) { const Frame F = make_frame(wv); r = UNI(r);
    constexpr int ES = FP8_MOE ? 1 : 2;
    const int ttot = moe_build_table(F); int ntile = ttot - r * MOE_RT; ntile = ntile > MOE_RT ? MOE_RT : ntile;
    WithDep<SchedMoe1, (DEPMASK & 4u) ? 1 : 0> S{{(const char*)(F.ws + WS_R0), (const char*)(F.ws + WS_WEGU), (const int*)(F.ws + WS_RLIST), (LAS const int*)(F.lds + LDS_MOE_TAB), DM * ES, DM * ES, F.G, F.bid, r * MOE_RT, ntile}, CW_DEP_MOE, 0u};
    EpiSwiglu<FP8_MOE> E{(unsigned char*)(F.ws + WS_MACT + (size_t)(r & 1) * (MACT_BYTES / (FP8_MOE ? 2 : 1))), DFE * ES, FP8_MOE ? WSCALE_INV : 1.0f};
    gp::gemm_phase<FP8_MOE>(F.lds, DM * ES, S, E, F.tid); }
PHASE_FN void ph_moe2(const int wv, int r) { const Frame F = make_frame(wv); r = UNI(r);
    constexpr int ES = FP8_MOE ? 1 : 2;
    const int ttot = moe_build_table(F); int ntile = ttot - r * MOE_RT; ntile = ntile > MOE_RT ? MOE_RT : ntile;
    WithDep<SchedMoe2, (DEPMASK & 4u) ? 2 : 0> S{{(const char*)(F.ws + WS_MACT + (size_t)(r & 1) * (MACT_BYTES / (FP8_MOE ? 2 : 1))), (const char*)(F.ws + WS_WED), (LAS const int*)(F.lds + LDS_MOE_TAB), DFE * ES, DFE * ES, F.G, (F.bid + 168) % F.G, r * MOE_RT, ntile}, CW_DEP_MOE, (unsigned)(DFE / 128) * 8u};
    EpiMoe2 E{(bf16_t*)(F.ws + WS_Y), (const int*)(F.ws + WS_RLIST), (const float*)(F.ws + WS_RPROB), FP8_MOE ? WSCALE_INV : 1.0f};
    gp::gemm_phase<FP8_MOE>(F.lds, DFE * ES, S, E, F.tid); }
PHASE_FN void ph_final(const int wv) { const Frame F = make_frame(wv); final_phase(F); }

__device__ __forceinline__ void grid_sync(const int wv) {
    const bool thread0 = (wv == 0) && (lane_id_volatile() == 0);
    XcdBarrier b; b.bar = (unsigned*)((unsigned char*)karg_in(26) + WS_CTL) + CW_BAR; b.x = xb_xcc_id();
    b.st = (volatile LAS unsigned*)((LAS unsigned char*)lds_raw + LDS_BYTES - 16);
    xcd_barrier(b, thread0);
}
#ifndef REPMASK
#define REPMASK 0u
#endif
#ifndef DEPMASK
#define DEPMASK 7u
#endif
#define RP(k) (((REPMASK >> (k)) & 1u) ? 2 : 1)
template <unsigned PMASK>
__global__ void __launch_bounds__(NTHREADS, 2) fwd_kernel(Args args) {
    unsigned* ctl = (unsigned*)(args.ws + WS_CTL);
    volatile LAS unsigned* bst = (volatile LAS unsigned*)((LAS unsigned char*)lds_raw + LDS_BYTES - 16);
    const int wv = __builtin_amdgcn_readfirstlane((int)(threadIdx.x >> 6));
    if (threadIdx.x < 4) bst[threadIdx.x] = 0u;
    if (threadIdx.x == 0 && (xb_xcc_id() != (blockIdx.x % gp::NXCD) || gridDim.x < gp::NXCD)) (void)xb_add(ctl + CW_NONCANON, 1u);
    __syncthreads();
    const int lo = args.ph_lo, hi = args.ph_hi;
    const bool single = (hi - lo) > 1;
    if (single) (void)xcd_barrier_post(ctl + CW_BAR, bst);
#define IN(k) (lo <= (k) && (k) < hi)
#define PK(b) ((PMASK >> (b)) & 1u)
#define SEAM(k) do { if (IN((k) + 1) && single) grid_sync(wv); } while (0)

    if (PK(0) && IN(0)) { for (int rep = 0; rep < RP(0); ++rep) { if (rep) __syncthreads(); ph_prologue(wv); } SEAM(0); }
    if (single) { if (threadIdx.x == 0) bst[2] = xb_ld(ctl + CW_NONCANON); __syncthreads(); }
#define DEP_SEAM(bit, k) do { if (!(DEPMASK & (bit)) || bst[2] != 0u) SEAM(k); } while (0)

    for (int l = 0; l < 2; ++l) {
        const int pb = 1 + 24 * l;
        if (hi <= pb || lo >= pb + 24) continue;
        if (PK(1) && IN(pb + 0)) { for (int rep = 0; rep < RP(1); ++rep) { if (rep) __syncthreads(); ph_norm(wv, l, 0); } SEAM(pb + 0); }
        if (PK(2) && IN(pb + 1)) { for (int rep = 0; rep < RP(2); ++rep) { if (rep) __syncthreads(); ph_gemm_a(wv, l); ph_gemm_b(wv, l); } SEAM(pb + 1); }
        if (PK(3) && IN(pb + 2)) { ph_prep(wv, l); SEAM(pb + 2); }
        if (PK(4) && IN(pb + 3)) { for (int rep = 0; rep < RP(4); ++rep) { if (rep) __syncthreads(); ph_mlstm(wv, l); } SEAM(pb + 4); }
        if (PK(6) && IN(pb + 5)) { for (int rep = 0; rep < RP(6); ++rep) { if (rep) __syncthreads(); ph_post(wv, l); } SEAM(pb + 5); }
        if (PK(7) && IN(pb + 6)) { for (int rep = 0; rep < RP(7); ++rep) { if (rep) __syncthreads(); ph_merge1(wv, l); ph_merge2(wv, l); } DEP_SEAM(1u, pb + 6);   }
        if (PK(8) && IN(pb + 7)) { ph_out(wv, l); SEAM(pb + 7); }
        if (PK(9) && IN(pb + 8)) { ph_norm2x(wv, l); SEAM(pb + 8); }
        if (l == 0) {
            if (PK(10) && IN(pb + 9)) { for (int rep = 0; rep < RP(10); ++rep) { if (rep) __syncthreads(); ph_ffn1(wv); } DEP_SEAM(2u, pb + 9);   }
            if (PK(11) && IN(pb + 10)) { ph_ffn2(wv); SEAM(pb + 10); }
        } else {
            if (PK(12) && IN(pb + 11)) { for (int rep = 0; rep < RP(12); ++rep) { if (rep) __syncthreads(); ph_moe1(wv, 0); } DEP_SEAM(4u, pb + 11);   }
            for (int r = 0; r < MOE_ROUNDS; ++r) {
                if (PK(13) && IN(pb + 12 + r)) { for (int rep = 0; rep < RP(13); ++rep) { if (rep) __syncthreads(); ph_moe2(wv, r); if (r + 1 < MOE_ROUNDS) ph_moe1(wv, r + 1); }
                    if (r + 1 < MOE_ROUNDS) SEAM(pb + 12 + r); else { if (single) grid_sync(wv); } }
            }
        }
    }
    if (PK(14) && IN(PH_FINAL)) ph_final(wv);
#undef IN
#undef PK
#undef SEAM
#undef DEP_SEAM
}

extern "C" void kernel_launch(void* const* d_in, const int* in_sizes, int n_in, void* d_out, int out_size, void* d_ws, size_t ws_size, hipStream_t stream) {
    static int grid = 0;
    if (grid == 0) {
        if (n_in != 25 || out_size != NL * DM || ws_size < WS_END2) { fprintf(stderr, "kernel_launch: unexpected shapes (n_in %d out %d ws %zu need %zu)\n", n_in, out_size, ws_size, (size_t)WS_END2); grid = -1; return; }
        int dev = 0, cus = 0, per_cu = 0;
        if (hipGetDevice(&dev) != hipSuccess || hipDeviceGetAttribute(&cus, hipDeviceAttributeMultiprocessorCount, dev) != hipSuccess) { grid = -1; return; }
        const void* ks[16] = { (const void*)fwd_kernel<1u << 0>, (const void*)fwd_kernel<1u << 1>, (const void*)fwd_kernel<1u << 2>, (const void*)fwd_kernel<1u << 3>, (const void*)fwd_kernel<1u << 4>,
            (const void*)fwd_kernel<1u << 5>, (const void*)fwd_kernel<1u << 6>, (const void*)fwd_kernel<1u << 7>, (const void*)fwd_kernel<1u << 8>, (const void*)fwd_kernel<1u << 9>, (const void*)fwd_kernel<1u << 10>,
            (const void*)fwd_kernel<1u << 11>, (const void*)fwd_kernel<1u << 12>, (const void*)fwd_kernel<1u << 13>, (const void*)fwd_kernel<1u << 14>,
#if MK_MULTI
            nullptr };
#else
            (const void*)fwd_kernel<0xFFFFFFFFu> };
#endif
        for (int i = 0; i < (MK_MULTI ? 15 : 16); ++i) { if (!MK_MULTI && i < 15) continue;
            if (hipFuncSetAttribute(ks[i], hipFuncAttributeMaxDynamicSharedMemorySize, LDS_BYTES) != hipSuccess) { fprintf(stderr, "kernel_launch: hipFuncSetAttribute failed\n"); grid = -1; return; }
            if (hipOccupancyMaxActiveBlocksPerMultiprocessor(&per_cu, ks[i], NTHREADS, LDS_BYTES) != hipSuccess || per_cu < 1) { fprintf(stderr, "kernel_launch: occupancy query says %d\n", per_cu); (void)hipGetLastError(); grid = -1; return; } }
        grid = cus;
    }
    if (grid < 0) return;
    (void)in_sizes;
    (void)hipMemsetAsync((char*)d_ws + WS_CTL, 0, CTL_BYTES, stream);
    Args a{};
    for (int i = 0; i < 25; ++i) a.in[i] = (const float*)d_in[i];
    a.out = (float*)d_out; a.ws = (unsigned char*)d_ws;
#if MK_MULTI
    for (int p = 0; p < PH_END; ++p) {
        const int rel = p == 0 ? -1 : (p - 1) % 24, l = p == 0 ? -1 : (p - 1) / 24;
        int kind;
        if (p == 0) kind = 0; else if (p == PH_FINAL) kind = 14;
        else { if (l > 1) continue; if (rel == 4) continue; if (l == 0 && rel > 10) continue; if (l == 1 && (rel == 9 || rel == 10 || rel > 11 + MOE_ROUNDS)) continue;
            kind = rel <= 10 ? rel + 1 : (rel == 11 ? 12 : 13); }
        a.ph_lo = p; a.ph_hi = p + 1;
        switch (kind) {
#define LK(K) case K: hipLaunchKernelGGL(fwd_kernel<1u << K>, dim3(grid), dim3(NTHREADS), LDS_BYTES, stream, a); break;
            LK(0) LK(1) LK(2) LK(3) LK(4) LK(5) LK(6) LK(7) LK(8) LK(9) LK(10) LK(11) LK(12) LK(13) LK(14)
#undef LK
        }
    }
#else
    a.ph_lo = 0; a.ph_hi = PH_END;
    hipLaunchKernelGGL(fwd_kernel<0xFFFFFFFFu>, dim3(grid), dim3(NTHREADS), LDS_BYTES, stream, a);
#endif
}
```

```cpp
#include <hip/hip_runtime.h>
#include <stdint.h>
#include <stdio.h>

#ifndef MK_MULTI
#define MK_MULTI 0
#endif

#define LAS __attribute__((address_space(3)))
typedef unsigned short bf16_t;
typedef short bf16x8 __attribute__((ext_vector_type(8)));
typedef float f32x4 __attribute__((ext_vector_type(4)));
typedef float f32x2 __attribute__((ext_vector_type(2)));
typedef unsigned u32x4 __attribute__((ext_vector_type(4)));
typedef unsigned u32x2 __attribute__((ext_vector_type(2)));
typedef int i32x4 __attribute__((ext_vector_type(4)));
typedef int i32x8 __attribute__((ext_vector_type(8)));

constexpr int BATCH = 8, SEQ = 4096, DM = 1024, CTXL = 256;
constexpr int NL = BATCH * SEQ;
constexpr int NCX = BATCH * CTXL;
constexpr int MT = NL + NCX;
constexpr int HEADS = 4, DH = 256, CHUNK = 64;
constexpr int IN_COLS = 6672, O_OFF = 3072, IF_OFF = 4096, POOL_OFF = 4112, GA_OFF = 4624, GB_OFF = 5648;
constexpr int DFF = 2816, NEXP = 8, DFE = 3584;
constexpr int NQKV = 3072, NZB = 3584;
constexpr int NCHUNK_L = NL / CHUNK;
constexpr int NCHUNK = MT / CHUNK;
constexpr float EPS = 1e-6f;
constexpr int NTHREADS = 512;
constexpr int LDS_BYTES = 163840;
#ifndef FP8_MOE
#define FP8_MOE 1
#endif
#if FP8_MOE
constexpr int MOE_RT = 264;
constexpr int MOE_ROUNDS = 1;
#else
constexpr int MOE_RT = 64;
constexpr int MOE_ROUNDS = 5;
#endif

#ifndef FP8_MOE
#define FP8_MOE 1
#endif
#define FP8_MOE_DEFAULT FP8_MOE
#ifndef MLSTM_TR
#define MLSTM_TR 1
#endif
constexpr size_t al256(size_t x) { return (x + 255) & ~(size_t)255; }
constexpr size_t WS_CTL = 0;
constexpr size_t CTL_BYTES = 65536;
constexpr size_t WS_MOD = WS_CTL + CTL_BYTES;
constexpr size_t WS_GATES = al256(WS_MOD + (size_t)2 * 9 * 6144 * 4);
constexpr size_t WS_HALO = al256(WS_GATES + (size_t)MT * 16 * 4);
constexpr size_t WS_HCTX = al256(WS_HALO + (size_t)NCHUNK * 2 * 2048 * 2);
constexpr size_t WS_RPROB = al256(WS_HCTX + (size_t)NCX * DM * 4);
constexpr size_t WS_RLIST = al256(WS_RPROB + (size_t)NL * 2 * 4);
constexpr size_t WS_GSC = al256(WS_RLIST + (size_t)NEXP * NL * 4);
constexpr size_t WS_WQKV = al256(WS_GSC + (size_t)NCHUNK * 8 * 64 * 16);
constexpr size_t WS_WB = al256(WS_WQKV + (size_t)2 * NQKV * DM * 2);
constexpr size_t WS_WPA = al256(WS_WB + (size_t)2 * NZB * DM * 2);
constexpr size_t WS_WPBC = al256(WS_WPA + (size_t)2 * DM * DM * 2);
constexpr size_t WS_WOUT = al256(WS_WPBC + (size_t)2 * DM * 512 * 2);
constexpr size_t WS_WFGU = al256(WS_WOUT + (size_t)2 * DM * DM * 2);
constexpr size_t WS_WFD = al256(WS_WFGU + (size_t)2 * DFF * DM * 2);
constexpr size_t WS_ARENA = al256(WS_WFD + (size_t)DM * DFF * 2);
constexpr size_t R0_BYTES = (size_t)MT * DM * 2;
constexpr size_t WS_R0 = WS_ARENA;
constexpr size_t WS_R1 = WS_R0 + R0_BYTES;
constexpr size_t WS_R2 = WS_R1 + (size_t)MT * NQKV * 2;
constexpr size_t WS_R3 = WS_R2 + 2 * R0_BYTES;
constexpr size_t WS_END = WS_R3 + 2 * R0_BYTES;
constexpr size_t WS_KT = WS_R2, WS_VT = WS_R2 + R0_BYTES;
constexpr size_t WS_HF = WS_R3, WS_HB = WS_R3 + R0_BYTES;
constexpr size_t WS_ZS = WS_R2;
constexpr size_t WS_ZP = WS_ZS + (size_t)MT * 3072;
constexpr int HLD = 2048;
constexpr size_t WS_HC16 = WS_END;
constexpr size_t WS_END2 = WS_HC16 + (size_t)NCX * HLD * 2;
constexpr size_t WS_ACAT = WS_R1;
constexpr int KCAT = 1536;
constexpr size_t WS_WCAT = WS_WPA;
static_assert(WS_WPBC == WS_WPA + (size_t)2 * DM * DM * 2 && WS_WOUT >= WS_WCAT + (size_t)2 * DM * KCAT * 2, "concatenated merge weights");
static_assert(WS_ZP + (size_t)MT * 512 * 2 <= WS_R3, "gate planes + pool projection fit the old K^T/V^T region");
constexpr size_t WS_ACT = WS_R1;
constexpr size_t WS_WEGU = WS_R1;
constexpr size_t ES_MOE = FP8_MOE ? 1 : 2;
constexpr size_t WS_WED = WS_WEGU + (size_t)NEXP * 2 * DFE * DM * ES_MOE;
constexpr size_t WS_MACT = WS_WED + (size_t)NEXP * DM * DFE * ES_MOE;
constexpr size_t WS_Y = WS_R3;
constexpr size_t MACT_BYTES = (size_t)MOE_RT * 256 * DFE * 2;
static_assert(WS_MACT + (MOE_ROUNDS > 1 ? 2 : 1) * (FP8_MOE_DEFAULT ? MACT_BYTES / 2 : MACT_BYTES) <= WS_R3, "MoE overlay (activation buffers)");
static_assert((size_t)2 * NL * DM * 2 <= 2 * R0_BYTES, "Y overlay");

constexpr int CW_BAR = 0;
constexpr int CW_ECNT = 4096;
constexpr int CW_ERR = 8192;
#ifndef DEPMASK
#define DEPMASK 7u
#endif
#ifndef SPLIT_PREP
#define SPLIT_PREP 1
#endif
constexpr int CW_SPLIT = 8320;
constexpr int CW_NONCANON = 8256;
constexpr int CW_DEP_MERGE = 10240;
constexpr int CW_DEP_FFN = 10752;
constexpr int CW_DEP_MOE = 11264;

#ifndef FP8_MOE
#define FP8_MOE 1
#endif
#ifndef FP8_FFN2
#define FP8_FFN2 1
#endif
#ifndef FP8_DENSE
#define FP8_DENSE 0
#endif
constexpr float WSCALE = 64.0f, WSCALE_INV = 1.0f / 64.0f;
__device__ __forceinline__ unsigned pack4_fp8(float a, float b, float c, float d) {
    a = __builtin_amdgcn_fmed3f(a, -448.f, 448.f); b = __builtin_amdgcn_fmed3f(b, -448.f, 448.f); c = __builtin_amdgcn_fmed3f(c, -448.f, 448.f); d = __builtin_amdgcn_fmed3f(d, -448.f, 448.f);
    int w = __builtin_amdgcn_cvt_pk_fp8_f32(a, b, 0, false); w = __builtin_amdgcn_cvt_pk_fp8_f32(c, d, w, true); return (unsigned)w; }
__device__ __forceinline__ unsigned cvt_pk_bf16(float lo, float hi) { unsigned r; asm("v_cvt_pk_bf16_f32 %0, %1, %2" : "=v"(r) : "v"(lo), "v"(hi)); return r; }
__device__ __forceinline__ float bf_lo(unsigned w) { return __uint_as_float(w << 16); }
__device__ __forceinline__ float bf_hi(unsigned w) { return __uint_as_float(w & 0xffff0000u); }
__device__ __forceinline__ float bf2f(bf16_t b) { return __uint_as_float(((unsigned)b) << 16); }
__device__ __forceinline__ bf16_t f2bf(float f) { return (bf16_t)(cvt_pk_bf16(f, 0.f) & 0xffffu); }
__device__ __forceinline__ float sigm(float x) { return __builtin_amdgcn_rcpf(1.0f + __expf(-x)); }
__device__ __forceinline__ float silu(float x) { return x * __builtin_amdgcn_rcpf(1.0f + __expf(-x)); }
__device__ __forceinline__ float lx_xor(float v, int m, int lane) { return __int_as_float(__builtin_amdgcn_ds_bpermute((lane ^ m) << 2, __float_as_int(v))); }
__device__ __forceinline__ float lx_up(float v, int o, int lane) { return __int_as_float(__builtin_amdgcn_ds_bpermute((lane - o) << 2, __float_as_int(v))); }
__device__ __forceinline__ float lx_idx(float v, int src) { return __int_as_float(__builtin_amdgcn_ds_bpermute(src << 2, __float_as_int(v))); }
#define DPP_F(v, ctrl) __int_as_float(__builtin_amdgcn_update_dpp(0, __float_as_int(v), ctrl, 0xf, 0xf, true))
#define RDL_F(v, l) __int_as_float(__builtin_amdgcn_readlane(__float_as_int(v), l))
__device__ __forceinline__ float wave_sum(float v, int) {
    v += DPP_F(v, 0xB1); v += DPP_F(v, 0x4E); v += DPP_F(v, 0x141); v += DPP_F(v, 0x140);
    return (RDL_F(v, 0) + RDL_F(v, 16)) + (RDL_F(v, 32) + RDL_F(v, 48));
}
__device__ __forceinline__ float wave_max(float v, int) {
    v = fmaxf(v, DPP_F(v, 0xB1)); v = fmaxf(v, DPP_F(v, 0x4E)); v = fmaxf(v, DPP_F(v, 0x141)); v = fmaxf(v, DPP_F(v, 0x140));
    return fmaxf(fmaxf(RDL_F(v, 0), RDL_F(v, 16)), fmaxf(RDL_F(v, 32), RDL_F(v, 48)));
}

#define XB_TMO      128
#define XB_XCNT(j)  (256  + 64 * (j))
#define XB_XSUB(j)  (1280 + 64 * (j))
#define XB_XGEN(j)  (2304 + 64 * (j))
#define XB_TOP      3328
#define XB_TOPGEN   3392
#define XCD_BAR_WORDS 3456
#define XB_SPIN_CAP (1u << 18)

__device__ __forceinline__ unsigned xb_ld(unsigned* p)              { return __hip_atomic_load(p, __ATOMIC_RELAXED, __HIP_MEMORY_SCOPE_AGENT); }
__device__ __forceinline__ unsigned xb_add(unsigned* p, unsigned v) { return __hip_atomic_fetch_add(p, v, __ATOMIC_RELAXED, __HIP_MEMORY_SCOPE_AGENT); }
__device__ __forceinline__ unsigned xb_xcc_id() { return (unsigned)__builtin_amdgcn_s_getreg((3 << 11) | 20) & 0xFu; }
__device__ __forceinline__ void dep_spin(unsigned* p, unsigned need) { unsigned sp = 0; while (xb_ld(p) < need) { __builtin_amdgcn_s_sleep(2); if (++sp > (1u << 20)) break; } }
#define XB_SPIN(cond, bar) do { unsigned _sp = 0; while (cond) { __builtin_amdgcn_s_sleep(1); \
    if ((++_sp & 255u) == 0u) { if (xb_ld(&(bar)[XB_TMO])) break; if (_sp > XB_SPIN_CAP) { atomicAdd(&(bar)[XB_TMO], 1u); break; } } } } while (0)

struct XcdBarrier { unsigned* bar; unsigned x; volatile LAS unsigned* st; };

__device__ __forceinline__ XcdBarrier xcd_barrier_post(unsigned* bar, volatile LAS unsigned* st) {
    XcdBarrier b; b.bar = bar; b.x = xb_xcc_id(); b.st = st;
    if (threadIdx.x == 0) (void)xb_add(&bar[XB_XCNT(b.x)], 1u);
    return b;
}
__device__ __forceinline__ void xcd_barrier_complete(unsigned* bar, unsigned x, unsigned& nloc, unsigned& nx) {
    const unsigned G = gridDim.x * gridDim.y * gridDim.z;
    unsigned sum, cnt, mine, sp = 0u;
    for (;;) {
        sum = 0u; cnt = 0u; mine = 0u;
#pragma unroll
        for (unsigned j = 0; j < 16; ++j) { const unsigned c = xb_ld(&bar[XB_XCNT(j)]); sum += c; cnt += (c > 0u) ? 1u : 0u; mine = (j == x) ? c : mine; }
        if (sum == G) break;
        __builtin_amdgcn_s_sleep(1);
        if ((++sp & 255u) == 0u) { if (xb_ld(&bar[XB_TMO])) break; if (sp > XB_SPIN_CAP) { atomicAdd(&bar[XB_TMO], 1u); break; } }
    }
    nloc = mine > 0u ? mine : 1u; nx = cnt > 0u ? cnt : 1u;
}
__device__ __forceinline__ void xcd_barrier(const XcdBarrier& b, const bool thread0) {
    asm volatile("s_waitcnt vmcnt(0)" ::: "memory");
    __syncthreads();
    if (thread0) {
        unsigned* bar = b.bar;
        __builtin_amdgcn_s_waitcnt(0);
        unsigned nloc = b.st[0], nx = b.st[1];
        if (nloc == 0u) { xcd_barrier_complete(bar, b.x, nloc, nx); b.st[0] = nloc; b.st[1] = nx; }
        const unsigned old = xb_add(&bar[XB_XSUB(b.x)], 1u);
        const unsigned gen = old / nloc;
        if (old + 1u == (gen + 1u) * nloc) {
            __builtin_amdgcn_fence(__ATOMIC_RELEASE, "agent");
            asm volatile("s_waitcnt vmcnt(0)" ::: "memory");
            const unsigned og = xb_add(&bar[XB_TOP], 1u);
            const unsigned tg = og / nx;
            if (og + 1u == (tg + 1u) * nx) xb_add(&bar[XB_TOPGEN], 1u);
            else XB_SPIN(xb_ld(&bar[XB_TOPGEN]) == tg, bar);
            __builtin_amdgcn_fence(__ATOMIC_ACQUIRE, "agent");
            xb_add(&bar[XB_XGEN(b.x)], 1u);
            asm volatile("s_waitcnt vmcnt(0)" ::: "memory");
        } else {
            XB_SPIN(xb_ld(&bar[XB_XGEN(b.x)]) == gen, bar);
            __builtin_amdgcn_fence(__ATOMIC_ACQUIRE, "agent");
            asm volatile("s_waitcnt vmcnt(0)" ::: "memory");
        }
    }
    __syncthreads();
}

typedef const char __attribute__((address_space(4)))* karg_t;
__device__ __forceinline__ const float* karg_in(int i) {
    karg_t ka = (karg_t)__builtin_amdgcn_kernarg_segment_ptr();
    unsigned long long v;
    asm volatile("s_load_dwordx2 %0, %1, %2\n\ts_waitcnt lgkmcnt(0)" : "=s"(v) : "s"(ka), "s"(i * 8) : "memory");
    return (const float*)(const __attribute__((address_space(1))) float*)v;
}
namespace gp {
constexpr int BM = 256, BK = 64, HALF = 128, HTB = HALF * BK * 2, STAGE_BYTES = 8 * HTB, NXCD = 8, WGM = 8;
constexpr int LDS_GV = 135168;
__device__ __forceinline__ int lds_byte(int r, int c) { const int st = (r >> 4) * 2 + (c >> 5), rr = r & 15, cc = c & 31, ob = rr * 64 + cc * 2; return st * 1024 + (ob ^ (((ob >> 9) & 1) << 5)); }
__device__ __forceinline__ void stage_rc(int b, int& R, int& C) { const int st = b / 1024, sb = b % 1024, swz = sb ^ (((sb >> 9) & 1) << 5); R = (st >> 1) * 16 + swz / 64; C = (st & 1) * 32 + (swz % 64) / 2; }
__device__ __forceinline__ int perm32(int rho) { const int n = rho >> 4, i = rho & 15; return 8 * (i >> 2) + 4 * n + (i & 3); }

struct Unit { int pm, pn, ex, cnt; };

__device__ __forceinline__ bool static_next(int i, int G, int c, int nM, int nN, int& pm, int& pn) {
    const int nwg = nM * nN;
    const long L = (long)i * G + c; if (L >= nwg) return false;
    int wgid = (int)L; { const int q = nwg / NXCD, r = nwg % NXCD, xcd = wgid % NXCD, off = wgid / NXCD; wgid = (xcd < r ? xcd * (q + 1) : r * (q + 1) + (xcd - r) * q) + off; }
    const int nig = WGM * nN, gid = wgid / nig, fm = gid * WGM, gsz = (nM - fm) < WGM ? (nM - fm) : WGM;
    pm = fm + ((wgid % nig) % gsz); pn = (wgid % nig) / gsz; return true;
}

__device__ __forceinline__ bool chunk_next(int i, int G, int c, int nM, int nN, int& pm, int& pn) {
    const int x = c % NXCD, slot = c / NXCD, nslots = (G - x + NXCD - 1) / NXCD;
    const int r0 = x * nM / NXCD, nr = (x + 1) * nM / NXCD - r0;
    const int off = i * nslots + slot; if (off >= nr * nN) return false;
    const int nig = WGM * nN, gid = off / nig, fm = gid * WGM, gsz = (nr - fm) < WGM ? (nr - fm) : WGM;
    pm = r0 + fm + ((off % nig) % gsz); pn = (off % nig) / gsz; return true;
}

template <int FP8, class Epi, class Sched>
__device__ __forceinline__ void gemm_phase(LAS unsigned char* lds, const int Kb, const Sched& S, const Epi& E, const int tid) {
    const int wid = __builtin_amdgcn_readfirstlane(tid >> 6), lane = tid & 63, wr = wid >> 2, wc = wid & 3, fr = lane & 15, fq = lane >> 4;
    const int nt = Kb / (BK * 2);
    const int lda = S.lda, ldb = S.ldb;
    unsigned voffA[2], voffB[2];
#pragma unroll
    for (int i = 0; i < 2; ++i) { int R, C; stage_rc(tid * 16 + i * 8192, R, C); const int Rb = Epi::PERM ? ((R & ~31) + perm32(R & 31)) : R;
        voffA[i] = (unsigned)(R * lda + C * 2); voffB[i] = (unsigned)(Rb * ldb + C * 2); }
#define GP_GATHER(dst, u_) do { _Pragma("unroll") for (int _i = 0; _i < 2; ++_i) { int _R, _C; stage_rc(tid * 16 + _i * 8192, _R, _C); \
        _Pragma("unroll") for (int _h = 0; _h < 2; ++_h) dst[_h][_i] = (unsigned)(S.arow(u_, _h * HALF + _R) * lda + _C * 2); } } while (0)
    const size_t kstep = (size_t)(BK * 2);
    const size_t hstepA = (size_t)HALF * lda, hstepB = (size_t)HALF * ldb;
    const unsigned ldsw = (unsigned)wid * 1024u;
    const int aoff = lds_byte(wr * 64 + fr, fq * 8), boff = lds_byte(wc * 32 + fr, fq * 8);
    unsigned gvc[2][2];
#define GP_SA(b, h) (((b) * 2 + (h)) * HTB)
#define GP_SB(b, h) ((4 + (b) * 2 + (h)) * HTB)
#define GP_STAGE_B(bufoff, gbase) do { _Pragma("unroll") for (int _i = 0; _i < 2; ++_i) { unsigned _vo = voffB[_i]; asm volatile("" : "+v"(_vo));     \
        __builtin_amdgcn_global_load_lds((const unsigned*)((const char*)(gbase) + _vo), (LAS unsigned*)(lds + (bufoff) + ldsw + _i * 8192), 16, 0, 0); } } while (0)
#define GP_STAGE_A(bufoff, p, nx, h) do { _Pragma("unroll") for (int _i = 0; _i < 2; ++_i) { \
        unsigned _vo = Sched::GATHER ? gvc[h][_i] : voffA[_i]; asm volatile("" : "+v"(_vo)); \
        __builtin_amdgcn_global_load_lds((const unsigned*)((const char*)(p) + (Sched::GATHER ? (size_t)0 : (size_t)(h) * hstepA) + _vo), (LAS unsigned*)(lds + (bufoff) + ldsw + _i * 8192), 16, 0, 0); } } while (0)
#define GP_LDA(dst, b, h) do { _Pragma("unroll") for (int m = 0; m < 4; ++m) _Pragma("unroll") for (int k = 0; k < 2; ++k) dst[m][k] = *(const LAS bf16x8*)(lds + GP_SA(b, h) + aoff + m * 2048 + k * 1024); } while (0)
#define GP_LDB(dst, b, h) do { _Pragma("unroll") for (int n = 0; n < 2; ++n) _Pragma("unroll") for (int k = 0; k < 2; ++k) dst[n][k] = *(const LAS bf16x8*)(lds + GP_SB(b, h) + boff + n * 2048 + k * 1024); } while (0)
#define GP_MMA(ai, bj, At, Bt) do { __builtin_amdgcn_s_setprio(1); _Pragma("unroll") for (int m = 0; m < 4; ++m) _Pragma("unroll") for (int n = 0; n < 2; ++n) { \
        if (FP8) { const i32x8 _b = __builtin_shufflevector(__builtin_bit_cast(i32x4, Bt[n][0]), __builtin_bit_cast(i32x4, Bt[n][1]), 0, 1, 2, 3, 4, 5, 6, 7); \
                   const i32x8 _a = __builtin_shufflevector(__builtin_bit_cast(i32x4, At[m][0]), __builtin_bit_cast(i32x4, At[m][1]), 0, 1, 2, 3, 4, 5, 6, 7); \
                   asm volatile("v_mfma_f32_16x16x128_f8f6f4 %0, %1, %2, %0" : "+v"(acc[ai][bj][m][n]) : "v"(_b), "v"(_a)); }     \
        else { _Pragma("unroll") for (int k = 0; k < 2; ++k) acc[ai][bj][m][n] = __builtin_amdgcn_mfma_f32_16x16x32_bf16(Bt[n][k], At[m][k], acc[ai][bj][m][n], 0, 0, 0); } } \
        __builtin_amdgcn_s_setprio(0); } while (0)
#define GP_WAIT_V(n) asm volatile("s_waitcnt vmcnt(" #n ")" ::: "memory")
#define GP_WAIT_L(n) asm volatile("s_waitcnt lgkmcnt(" #n ")" ::: "memory")
#define GP_BAR __builtin_amdgcn_s_barrier()
#define GP_SCHED __builtin_amdgcn_sched_barrier(0)
    Unit cur, nxt; int ui = 0;
    if (!S.next(0, cur)) return;
    f32x4 acc[2][2][4][2];
#pragma unroll
    for (int a = 0; a < 2; ++a)
#pragma unroll
        for (int b = 0; b < 2; ++b)
#pragma unroll
            for (int m = 0; m < 4; ++m)
#pragma unroll
                for (int n = 0; n < 2; ++n) acc[a][b][m][n] = (f32x4){0.f, 0.f, 0.f, 0.f};
    bf16x8 At[4][2], B0[2][2], B1[2][2];
    const char* cA = S.aptr(cur); const char* cB = S.bptr(cur);
    if (Sched::GATHER) GP_GATHER(gvc, cur);
    int sig_pm = -1;
#define GP_CTL() ((unsigned*)((unsigned char*)karg_in(26) + WS_CTL))
#define GP_SIGNAL(pm_) do { if (lane == 0) (void)xb_add(GP_CTL() + S.depw + (pm_), 1u); } while (0)
#define GP_AWAIT(pm_) do { if (wid == 0) dep_spin(GP_CTL() + S.depw + (pm_), S.need); } while (0)
    if constexpr (Sched::DEP == 2) { GP_AWAIT(cur.pm); GP_BAR; }
    GP_STAGE_B(GP_SB(0, 0), cB); GP_STAGE_A(GP_SA(0, 0), cA, false, 0); GP_STAGE_B(GP_SB(0, 1), cB + hstepB); GP_STAGE_A(GP_SA(0, 1), cA, false, 1);
    if (wr == 1) GP_BAR;
    GP_WAIT_V(4); GP_BAR;
    GP_STAGE_B(GP_SB(1, 0), cB + kstep); GP_STAGE_A(GP_SA(1, 0), cA + kstep, false, 0); GP_STAGE_B(GP_SB(1, 1), cB + hstepB + kstep);
    GP_WAIT_V(6); GP_BAR;
    for (;;) {
        const bool has_next = S.next(ui + 1, nxt);
        const char* nA = has_next ? S.aptr(nxt) : cA; const char* nB = has_next ? S.bptr(nxt) : cB;
        if (Sched::GATHER && has_next) { unsigned gn[2][2]; GP_GATHER(gn, nxt); *(LAS u32x4*)(lds + LDS_GV + tid * 16) = (u32x4){gn[0][0], gn[0][1], gn[1][0], gn[1][1]}; }
        for (int t = 0; t < nt; t += 2) {
            const bool last = (t == nt - 2);
            if constexpr (Epi::MID_T > 0) { if (t == Epi::MID_T) { int t3 = tid; asm volatile("" : "+v"(t3)); E.mid(acc, cur, wr, wc, t3 & 15, (t3 & 63) >> 4); } }
            const char* a1 = cA + (size_t)(t + 1) * kstep;
            const char* a2 = last ? nA : cA + (size_t)(t + 2) * kstep; const char* b2 = last ? nB : cB + (size_t)(t + 2) * kstep;
            const char* a3 = a2 + kstep; const char* b3 = b2 + kstep;
            if constexpr (Sched::DEP == 2) { if (last && has_next) GP_AWAIT(nxt.pm); }
            GP_LDB(B0, 0, 0); GP_SCHED; GP_LDA(At, 0, 0); GP_STAGE_A(GP_SA(1, 1), a1, false, 1);
            GP_WAIT_L(8); GP_BAR; GP_WAIT_L(0); GP_MMA(0, 0, At, B0); GP_BAR; GP_SCHED;
            if (Sched::GATHER && last && has_next) { const u32x4 gq = *(const LAS u32x4*)(lds + LDS_GV + tid * 16); gvc[0][0] = gq.x; gvc[0][1] = gq.y; gvc[1][0] = gq.z; gvc[1][1] = gq.w; }
            GP_LDB(B1, 0, 1); GP_STAGE_B(GP_SB(0, 0), b2);
            GP_BAR; GP_WAIT_L(0); GP_MMA(0, 1, At, B1); GP_BAR;
            GP_LDA(At, 0, 1); GP_STAGE_A(GP_SA(0, 0), a2, last, 0);
            GP_BAR; GP_WAIT_L(0); GP_MMA(1, 0, At, B0); GP_BAR; GP_SCHED;
            GP_STAGE_B(GP_SB(0, 1), b2 + hstepB);
            GP_WAIT_V(6); GP_BAR; GP_MMA(1, 1, At, B1); GP_BAR;
            GP_LDB(B0, 1, 0); GP_SCHED; GP_LDA(At, 1, 0); GP_STAGE_A(GP_SA(0, 1), a2, last, 1);
            GP_WAIT_L(8); GP_BAR; GP_WAIT_L(0); GP_MMA(0, 0, At, B0); GP_BAR; GP_SCHED;
            GP_LDB(B1, 1, 1); GP_STAGE_B(GP_SB(1, 0), b3);
            GP_BAR; GP_WAIT_L(0); GP_MMA(0, 1, At, B1); GP_BAR;
            GP_LDA(At, 1, 1); GP_STAGE_A(GP_SA(1, 0), a3, last, 0);
            GP_BAR; GP_WAIT_L(0); GP_MMA(1, 0, At, B0); GP_BAR; GP_SCHED;
            GP_STAGE_B(GP_SB(1, 1), b3 + hstepB);
            GP_WAIT_V(6); GP_BAR; GP_MMA(1, 1, At, B1); GP_BAR;
            if constexpr (Sched::DEP == 1) {
                if (t == 0 && sig_pm >= 0) { GP_SIGNAL(sig_pm); sig_pm = -1; } }
        }
        if (FP8) asm volatile("s_nop 15\n\ts_nop 15" ::: "memory");
        { int t2 = tid; asm volatile("" : "+v"(t2));
          E(acc, cur, wr, wc, t2 & 15, (t2 & 63) >> 4); }
        if constexpr (Sched::DEP == 1) sig_pm = cur.pm;
        if (!has_next) break;
#pragma unroll
        for (int a = 0; a < 2; ++a)
#pragma unroll
            for (int b = 0; b < 2; ++b)
#pragma unroll
                for (int m = 0; m < 4; ++m)
#pragma unroll
                    for (int n = 0; n < 2; ++n) acc[a][b][m][n] = (f32x4){0.f, 0.f, 0.f, 0.f};
        cur = nxt; cA = nA; cB = nB; ++ui;
    }
    GP_WAIT_V(0);
    if constexpr (Sched::DEP == 1) { if (sig_pm >= 0) GP_SIGNAL(sig_pm); }
    if (wr == 0) GP_BAR;
    GP_BAR;
#undef GP_SA
#undef GP_CTL
#undef GP_SIGNAL
#undef GP_AWAIT
#undef GP_GATHER
#undef GP_SB
#undef GP_STAGE_A
#undef GP_STAGE_B
#undef GP_LDA
#undef GP_LDB
#undef GP_MMA
#undef GP_WAIT_V
#undef GP_WAIT_L
#undef GP_BAR
#undef GP_SCHED
}
}

struct Frame {
    float* out; unsigned char* ws; unsigned* ctl; LAS unsigned char* lds;
    int G, bid, tid, lane, wave;
    __device__ __forceinline__ const float* in(int i) const { return karg_in(i); }
};
enum { I_X = 0, I_C, I_CTX, I_CCTX, I_WADA, I_BADA, I_GMIX, I_WIN, I_CONV, I_BIF, I_HGAIN, I_WPOOL, I_PSCALE, I_WPA, I_WPB, I_WOUT, I_GFFN,
       I_WFG, I_WFU, I_WFD, I_WROUTER, I_WEG, I_WEU, I_WED, I_GFINAL };
constexpr int MOD_SH1 = 0, MOD_SC1 = 1024, MOD_GT1 = 2048, MOD_SH2 = 3072, MOD_SC2 = 4096, MOD_GT2 = 5120;

template <class Base, int MODE> struct WithDep : Base { static constexpr int DEP = MODE; int depw; unsigned need; };
template <bool CH> struct SchedDenseT {
    static constexpr bool GATHER = false; static constexpr int DEP = 0;
    const char* A; const char* B; int lda, ldb, nM, nN, G, c;
    __device__ __forceinline__ bool next(int i, gp::Unit& u) const { u.ex = 0; u.cnt = 256; return CH ? gp::chunk_next(i, G, c, nM, nN, u.pm, u.pn) : gp::static_next(i, G, c, nM, nN, u.pm, u.pn); }
    __device__ __forceinline__ const char* aptr(const gp::Unit& u) const { return A + (size_t)u.pm * 256 * lda; }
    __device__ __forceinline__ const char* bptr(const gp::Unit& u) const { return B + (size_t)u.pn * 256 * ldb; }
    __device__ __forceinline__ int arow(const gp::Unit&, int) const { return 0; }
};
typedef SchedDenseT<false> SchedDense;
constexpr int LDS_MOE_TAB = 131072;
__device__ __forceinline__ int moe_build_table(const Frame& F) {
    LAS int* tab = (LAS int*)(F.lds + LDS_MOE_TAB);
    int acc = 0, myex = -1, myr0 = 0, mycnt = 0;
#pragma unroll
    for (int e = 0; e < 8; ++e) { const int c = (int)__hip_atomic_load(F.ctl + CW_ECNT + 64 * e, __ATOMIC_RELAXED, __HIP_MEMORY_SCOPE_AGENT); const int nt = (c + 255) >> 8;
        if (F.tid >= acc && F.tid < acc + nt) { myex = e; myr0 = (F.tid - acc) * 256; mycnt = c - myr0; mycnt = mycnt > 256 ? 256 : mycnt; }
        acc += nt; }
    if (myex >= 0) { tab[2 * F.tid] = myex; tab[2 * F.tid + 1] = (myr0 << 9) | mycnt; }
    __syncthreads();
    return acc;
}
struct SchedMoe1 {
    static constexpr bool GATHER = true; static constexpr int DEP = 0;
    const char* A; const char* B; const int* list; LAS const int* tab; int lda, ldb, G, c, g0, ntile;
    __device__ __forceinline__ bool next(int i, gp::Unit& u) const {
        if (ntile <= 0) return false;
        if (!((DEPMASK & 4u) ? gp::chunk_next(i, G, c, ntile, DFE / 128, u.pm, u.pn) : gp::static_next(i, G, c, ntile, DFE / 128, u.pm, u.pn))) return false;
        u.ex = __builtin_amdgcn_readfirstlane(tab[2 * (g0 + u.pm)]); u.cnt = __builtin_amdgcn_readfirstlane(tab[2 * (g0 + u.pm) + 1]);
        return true;
    }
    __device__ __forceinline__ const char* aptr(const gp::Unit&) const { return A; }
    __device__ __forceinline__ const char* bptr(const gp::Unit& u) const { return B + ((size_t)u.ex * (2 * DFE) + (size_t)u.pn * 256) * ldb; }
    __device__ __forceinline__ int arow(const gp::Unit& u, int r) const {
        const int cnt = u.cnt & 511, r0 = u.cnt >> 9;
        return r < cnt ? (list[(size_t)u.ex * NL + r0 + r] >> 1) : 0;
    }
};
struct SchedMoe2 {
    static constexpr bool GATHER = false; static constexpr int DEP = 0;
    const char* A; const char* B; LAS const int* tab; int lda, ldb, G, c, g0, ntile;
    __device__ __forceinline__ bool next(int i, gp::Unit& u) const {
        if (ntile <= 0) return false;
        if (!((DEPMASK & 4u) ? gp::chunk_next(i, G, c, ntile, DM / 256, u.pm, u.pn) : gp::static_next(i, G, c, ntile, DM / 256, u.pm, u.pn))) return false;
        u.ex = __builtin_amdgcn_readfirstlane(tab[2 * (g0 + u.pm)]); u.cnt = __builtin_amdgcn_readfirstlane(tab[2 * (g0 + u.pm) + 1]);
        return true;
    }
    __device__ __forceinline__ const char* aptr(const gp::Unit& u) const { return A + (size_t)u.pm * 256 * lda; }
    __device__ __forceinline__ const char* bptr(const gp::Unit& u) const { return B + ((size_t)u.ex * DM + (size_t)u.pn * 256) * ldb; }
    __device__ __forceinline__ int arow(const gp::Unit&, int) const { return 0; }
};

#define EPI_ARGS const f32x4 (&acc)[2][2][4][2], const gp::Unit& u, int wr, int wc, int fr, int fq
#define EPI_ROWS(ai, m) ((ai) * 128 + wr * 64 + (m) * 16 + fr)
__device__ __forceinline__ u32x4 pack8(const f32x4& a, const f32x4& b) { u32x4 w; w.x = cvt_pk_bf16(a[0], a[1]); w.y = cvt_pk_bf16(a[2], a[3]); w.z = cvt_pk_bf16(b[0], b[1]); w.w = cvt_pk_bf16(b[2], b[3]); return w; }
__device__ __forceinline__ void unpack8(const u32x4& w, f32x4& a, f32x4& b) { a = (f32x4){bf_lo(w.x), bf_hi(w.x), bf_lo(w.y), bf_hi(w.y)}; b = (f32x4){bf_lo(w.z), bf_hi(w.z), bf_lo(w.w), bf_hi(w.w)}; }

struct EpiQKV {
    static constexpr bool PERM = true; static constexpr int MID_T = 0;
    bf16_t* O; bf16_t* halo;
    __device__ __forceinline__ void operator()(EPI_ARGS) const {
        const int c8 = u.pn * 256 + wc * 32 + 8 * fq;
#pragma unroll
        for (int ai = 0; ai < 2; ++ai)
#pragma unroll
            for (int m = 0; m < 4; ++m) { const int row = u.pm * 256 + EPI_ROWS(ai, m);
#pragma unroll
                for (int bj = 0; bj < 2; ++bj) { const u32x4 w = pack8(acc[ai][bj][m][0], acc[ai][bj][m][1]);
                    *(u32x4*)(O + (size_t)row * NQKV + c8 + bj * 128) = w;
                    const int rr = row & 63;
                    if (u.pn < 8 && (rr == 0 || rr == 63)) *(u32x4*)(halo + ((size_t)(row >> 6) * 2 + (rr ? 1 : 0)) * 2048 + c8 + bj * 128) = w; } }
    }
};
__device__ __forceinline__ unsigned pack4_u8(float a, float b, float c, float d) {
    unsigned w = 0;
    w = __builtin_amdgcn_cvt_pk_u8_f32(fmaxf(__builtin_rintf(a * 255.f), 1.f), 0, w); w = __builtin_amdgcn_cvt_pk_u8_f32(fmaxf(__builtin_rintf(b * 255.f), 1.f), 1, w);
    w = __builtin_amdgcn_cvt_pk_u8_f32(fmaxf(__builtin_rintf(c * 255.f), 1.f), 2, w); w = __builtin_amdgcn_cvt_pk_u8_f32(fmaxf(__builtin_rintf(d * 255.f), 1.f), 3, w); return w; }
__device__ __forceinline__ f32x4 unpack4_u8(unsigned w) { return (f32x4){(float)(w & 0xffu), (float)((w >> 8) & 0xffu), (float)((w >> 16) & 0xffu), (float)(w >> 24)} * (1.0f / 255.0f); }
struct EpiZB {
    static constexpr bool PERM = true; static constexpr int MID_T = 0;
    unsigned char* ZS; bf16_t* ZP;
    __device__ __forceinline__ void operator()(EPI_ARGS) const {
        const int c8 = wc * 32 + 8 * fq; const bool sg = u.pn < 12;
#pragma unroll
        for (int ai = 0; ai < 2; ++ai)
#pragma unroll
            for (int m = 0; m < 4; ++m) { const int row = u.pm * 256 + EPI_ROWS(ai, m);
#pragma unroll
                for (int bj = 0; bj < 2; ++bj) { const f32x4 a = acc[ai][bj][m][0], b = acc[ai][bj][m][1];
                    if (sg) { u32x2 w; w.x = pack4_u8(sigm(a[0]), sigm(a[1]), sigm(a[2]), sigm(a[3])); w.y = pack4_u8(sigm(b[0]), sigm(b[1]), sigm(b[2]), sigm(b[3]));
                        *(u32x2*)(ZS + (size_t)row * 3072 + u.pn * 256 + c8 + bj * 128) = w; }
                    else *(u32x4*)(ZP + (size_t)row * 512 + (u.pn - 12) * 256 + c8 + bj * 128) = pack8(a, b); }
                asm volatile("" ::: "memory"); }
    }
};
struct EpiMerge {
    static constexpr bool PERM = true; static constexpr int MID_T = 16;
    bf16_t* O; const unsigned char* Z;
    __device__ __forceinline__ void mid(f32x4 (&acc)[2][2][4][2], const gp::Unit& u, int wr, int wc, int fr, int fq) const {
        const int c8 = u.pn * 256 + wc * 32 + 8 * fq;
#pragma unroll
        for (int ai = 0; ai < 2; ++ai) {
            u32x2 ga[2][4], gb[2][4];
#pragma unroll
            for (int bj = 0; bj < 2; ++bj)
#pragma unroll
                for (int m = 0; m < 4; ++m) { const unsigned char* zp = Z + (size_t)(u.pm * 256 + EPI_ROWS(ai, m)) * 3072 + c8 + bj * 128; ga[bj][m] = *(const u32x2*)(zp + 1024); gb[bj][m] = *(const u32x2*)(zp + 2048); }
#pragma unroll
            for (int bj = 0; bj < 2; ++bj)
#pragma unroll
                for (int m = 0; m < 4; ++m) { const f32x4 a0 = unpack4_u8(ga[bj][m].x), a1 = unpack4_u8(ga[bj][m].y), b0 = unpack4_u8(gb[bj][m].x), b1 = unpack4_u8(gb[bj][m].y);
#pragma unroll
                    for (int j = 0; j < 4; ++j) { acc[ai][bj][m][0][j] *= a0[j] * __builtin_amdgcn_rcpf(b0[j]); acc[ai][bj][m][1][j] *= a1[j] * __builtin_amdgcn_rcpf(b1[j]); } }
            asm volatile("" ::: "memory"); }
    }
    __device__ __forceinline__ void operator()(EPI_ARGS) const {
        const int c8 = u.pn * 256 + wc * 32 + 8 * fq;
#pragma unroll
        for (int ai = 0; ai < 2; ++ai) {
            u32x2 gb[4][2];
#pragma unroll
            for (int m = 0; m < 4; ++m)
#pragma unroll
                for (int bj = 0; bj < 2; ++bj) gb[m][bj] = *(const u32x2*)(Z + (size_t)(u.pm * 256 + EPI_ROWS(ai, m)) * 3072 + 2048 + c8 + bj * 128);
#pragma unroll
            for (int m = 0; m < 4; ++m) { const int row = u.pm * 256 + EPI_ROWS(ai, m);
#pragma unroll
                for (int bj = 0; bj < 2; ++bj) *(u32x4*)(O + (size_t)row * DM + c8 + bj * 128) = pack8(acc[ai][bj][m][0] * unpack4_u8(gb[m][bj].x), acc[ai][bj][m][1] * unpack4_u8(gb[m][bj].y)); }
            asm volatile("" ::: "memory"); }
    }
};
template <bool SRC32> struct EpiResid {
    static constexpr bool PERM = true; static constexpr int MID_T = 0;
    const void* srcL; bf16_t* dstL; const void* srcC; bf16_t* dstC; const float* modl; int gtoff; float sin;
    __device__ __forceinline__ void operator()(EPI_ARGS) const {
        const bool isc = u.pm >= NL / 256; const int mrow = isc ? 8 : (u.pm >> 4);
        const void* src = isc ? srcC : srcL; bf16_t* dst = isc ? dstC : dstL; const int rbase = isc ? u.pm * 256 - NL : u.pm * 256;
        constexpr int lds_ = SRC32 ? DM : HLD, ldd_ = HLD;
        const float* gt = modl + (size_t)mrow * 6144 + gtoff;
        const int c8 = u.pn * 256 + wc * 32 + 8 * fq;
        f32x4 gv[2][2];
#pragma unroll
        for (int bj = 0; bj < 2; ++bj)
#pragma unroll
            for (int n = 0; n < 2; ++n) gv[bj][n] = *(const f32x4*)(gt + c8 + bj * 128 + n * 4) * sin;
#pragma unroll
        for (int ai = 0; ai < 2; ++ai) {
            if constexpr (SRC32) {
                f32x4 s[4][2][2];
#pragma unroll
                for (int m = 0; m < 4; ++m) { const size_t off = (size_t)(rbase + EPI_ROWS(ai, m)) * lds_ + c8;
#pragma unroll
                    for (int bj = 0; bj < 2; ++bj)
#pragma unroll
                        for (int n = 0; n < 2; ++n) s[m][bj][n] = *(const f32x4*)((const float*)src + off + bj * 128 + n * 4); }
#pragma unroll
                for (int m = 0; m < 4; ++m) { const size_t off = (size_t)(rbase + EPI_ROWS(ai, m)) * ldd_ + c8;
#pragma unroll
                    for (int bj = 0; bj < 2; ++bj) *(u32x4*)(dst + off + bj * 128) = pack8(s[m][bj][0] + gv[bj][0] * acc[ai][bj][m][0], s[m][bj][1] + gv[bj][1] * acc[ai][bj][m][1]); }
            } else {
                u32x4 s[4][2];
#pragma unroll
                for (int m = 0; m < 4; ++m) { const size_t off = (size_t)(rbase + EPI_ROWS(ai, m)) * lds_ + c8;
#pragma unroll
                    for (int bj = 0; bj < 2; ++bj) s[m][bj] = *(const u32x4*)((const bf16_t*)src + off + bj * 128); }
#pragma unroll
                for (int m = 0; m < 4; ++m) { const size_t off = (size_t)(rbase + EPI_ROWS(ai, m)) * ldd_ + c8;
#pragma unroll
                    for (int bj = 0; bj < 2; ++bj) { f32x4 s0, s1; unpack8(s[m][bj], s0, s1);
                        *(u32x4*)(dst + off + bj * 128) = pack8(s0 + gv[bj][0] * acc[ai][bj][m][0], s1 + gv[bj][1] * acc[ai][bj][m][1]); } }
            }
            asm volatile("" ::: "memory"); }
    }
};
template <int FP8OUT> struct EpiSwiglu {
    static constexpr bool PERM = true; static constexpr int MID_T = 0;
    unsigned char* O; int ldo; float sin;
    __device__ __forceinline__ void operator()(EPI_ARGS) const {
        const int c8 = u.pn * 128 + wc * 32 + 8 * fq;
#pragma unroll
        for (int ai = 0; ai < 2; ++ai)
#pragma unroll
            for (int m = 0; m < 4; ++m) { const int row = u.pm * 256 + EPI_ROWS(ai, m);
                f32x4 a, b;
#pragma unroll
                for (int j = 0; j < 4; ++j) { a[j] = silu(acc[ai][0][m][0][j] * sin) * (acc[ai][1][m][0][j] * sin); b[j] = silu(acc[ai][0][m][1][j] * sin) * (acc[ai][1][m][1][j] * sin); }
                if (FP8OUT) { u32x2 w; w.x = pack4_fp8(a[0], a[1], a[2], a[3]); w.y = pack4_fp8(b[0], b[1], b[2], b[3]); *(u32x2*)(O + (size_t)row * ldo + c8) = w; }
                else *(u32x4*)(O + (size_t)row * ldo + c8 * 2) = pack8(a, b);
                asm volatile("" ::: "memory"); }
    }
};
struct EpiMoe2 {
    static constexpr bool PERM = true; static constexpr int MID_T = 0;
    bf16_t* Y; const int* list; const float* prob; float sin;
    __device__ __forceinline__ void operator()(EPI_ARGS) const {
        const int cnt = u.cnt & 511, r0 = u.cnt >> 9;
        const int c8 = u.pn * 256 + wc * 32 + 8 * fq;
        int en[2][4]; float pr[2][4];
#pragma unroll
        for (int ai = 0; ai < 2; ++ai)
#pragma unroll
            for (int m = 0; m < 4; ++m) { const int r = EPI_ROWS(ai, m); en[ai][m] = r < cnt ? list[(size_t)u.ex * NL + r0 + r] : -1; }
#pragma unroll
        for (int ai = 0; ai < 2; ++ai)
#pragma unroll
            for (int m = 0; m < 4; ++m) pr[ai][m] = en[ai][m] >= 0 ? prob[en[ai][m]] * sin : 0.f;
#pragma unroll
        for (int ai = 0; ai < 2; ++ai)
#pragma unroll
            for (int m = 0; m < 4; ++m) {
                if (en[ai][m] >= 0) { const float p = pr[ai][m];
                    bf16_t* op = Y + ((size_t)(en[ai][m] & 1) * NL + (size_t)(en[ai][m] >> 1)) * DM + c8;
#pragma unroll
                    for (int bj = 0; bj < 2; ++bj) *(u32x4*)(op + bj * 128) = pack8(acc[ai][bj][m][0] * p, acc[ai][bj][m][1] * p); }
                asm volatile("" ::: "memory"); }
    }
};

template <int FP8>
__device__ __forceinline__ void conv_mat_t(const Frame& F, const float* src, int ld, int Krows, int c0, int ncols, void* dstv, int dld, int dr0, int mode, int rot, LAS float* tl, int kper = 1 << 20, size_t sub_stride = 0) {
    const int ntn = ncols / 64, ntk = Krows / 128, tot = ntn * ntk, t = F.tid;
    const int lr = t >> 4, lc4 = (t & 15) * 4;
    const int sn = t >> 3, skc = (t & 7) * 16;
    f32x4 v[4];
    int j = (F.bid + rot) % F.G;
    if (j < tot) { const int tn = j % ntn, tk = j / ntn;
#pragma unroll
        for (int i = 0; i < 4; ++i) v[i] = *(const f32x4*)(src + (size_t)(tk * 128 + lr + 32 * i) * ld + c0 + tn * 64 + lc4); }
    for (; j < tot; j += F.G) {
        const int tn = j % ntn, tk = j / ntn, cc = tn * 64;
#pragma unroll
        for (int i = 0; i < 4; ++i) { LAS float* p = tl + (lr + 32 * i) * 65 + lc4; p[0] = v[i][0]; p[1] = v[i][1]; p[2] = v[i][2]; p[3] = v[i][3]; }
        __syncthreads();
        const int jn = j + F.G;
        if (jn < tot) { const int tn2 = jn % ntn, tk2 = jn / ntn;
#pragma unroll
            for (int i = 0; i < 4; ++i) v[i] = *(const f32x4*)(src + (size_t)(tk2 * 128 + lr + 32 * i) * ld + c0 + tn2 * 64 + lc4); }
        float o[16];
#pragma unroll
        for (int q = 0; q < 16; ++q) o[q] = tl[(skc + q) * 65 + sn];
        const int dr = mode ? ((cc >> 7) * 256 + (cc & 127) + dr0) : (dr0 + cc);
        if (FP8) { u32x4 w;
#pragma unroll
            for (int q = 0; q < 16; ++q) o[q] *= WSCALE;
            w.x = pack4_fp8(o[0], o[1], o[2], o[3]); w.y = pack4_fp8(o[4], o[5], o[6], o[7]); w.z = pack4_fp8(o[8], o[9], o[10], o[11]); w.w = pack4_fp8(o[12], o[13], o[14], o[15]);
            *(u32x4*)((unsigned char*)dstv + (size_t)(tk / kper) * sub_stride + (size_t)(dr + sn) * dld + (tk % kper) * 128 + skc) = w; }
        else { u32x4 w0, w1;
            w0.x = cvt_pk_bf16(o[0], o[1]); w0.y = cvt_pk_bf16(o[2], o[3]); w0.z = cvt_pk_bf16(o[4], o[5]); w0.w = cvt_pk_bf16(o[6], o[7]);
            w1.x = cvt_pk_bf16(o[8], o[9]); w1.y = cvt_pk_bf16(o[10], o[11]); w1.z = cvt_pk_bf16(o[12], o[13]); w1.w = cvt_pk_bf16(o[14], o[15]);
            bf16_t* dp = (bf16_t*)dstv + (size_t)(tk / kper) * sub_stride + (size_t)(dr + sn) * dld + (tk % kper) * 128 + skc;
            *(u32x4*)dp = w0; *(u32x4*)(dp + 8) = w1; }
        __syncthreads();
    }
}

__device__ __forceinline__ void conv_mat(const Frame& F, const float* src, int ld, int Krows, int c0, int ncols, bf16_t* dst, int dld, int dr0, int mode, int rot, LAS float* tl) {
    conv_mat_t<0>(F, src, ld, Krows, c0, ncols, dst, dld, dr0, mode, rot, tl); }
__device__ __forceinline__ void prologue_phase(const Frame& F) {
    LAS float* tl = (LAS float*)F.lds;
    for (int l = 0; l < 2; ++l) {
        const float* win = F.in(I_WIN) + (size_t)l * DM * IN_COLS;
        bf16_t* wqkv = (bf16_t*)(F.ws + WS_WQKV) + (size_t)l * NQKV * DM;
        bf16_t* wb = (bf16_t*)(F.ws + WS_WB) + (size_t)l * NZB * DM;
        conv_mat(F, win, IN_COLS, DM, 0, NQKV, wqkv, DM, 0, 0, 0, tl);
        conv_mat(F, win, IN_COLS, DM, O_OFF, 1024, wb, DM, 0, 0, 64, tl);
        conv_mat(F, win, IN_COLS, DM, GA_OFF, 1024, wb, DM, 1024, 0, 128, tl);
        conv_mat(F, win, IN_COLS, DM, GB_OFF, 1024, wb, DM, 2048, 0, 192, tl);
        conv_mat(F, win, IN_COLS, DM, POOL_OFF, 512, wb, DM, 3072, 0, 0, tl);
        conv_mat(F, F.in(I_WPA) + (size_t)l * DM * DM, DM, DM, 0, DM, (bf16_t*)(F.ws + WS_WCAT) + (size_t)l * DM * KCAT, KCAT, 0, 0, 128, tl);
        conv_mat(F, F.in(I_WOUT) + (size_t)l * DM * DM, DM, DM, 0, DM, (bf16_t*)(F.ws + WS_WOUT) + (size_t)l * DM * DM, DM, 0, 0, 0, tl);
    }
    conv_mat_t<FP8_DENSE>(F, F.in(I_WFG), DFF, DM, 0, DFF, F.ws + WS_WFGU, DM, 0, 1, 0, tl);
    conv_mat_t<FP8_DENSE>(F, F.in(I_WFU), DFF, DM, 0, DFF, F.ws + WS_WFGU, DM, 128, 1, 64, tl);
    conv_mat_t<(FP8_DENSE || FP8_FFN2)>(F, F.in(I_WFD), DM, DFF, 0, DM, F.ws + WS_WFD, DFF, 0, 0, 128, tl);
    const float* wpool = F.in(I_WPOOL); const float* pscale = F.in(I_PSCALE); const float* wpb = F.in(I_WPB);
    for (int idx = F.bid * NTHREADS + F.tid; idx < 2 * 512 * 1024; idx += F.G * NTHREADS) {
        const int l = idx >> 19, rem = idx & ((1 << 19) - 1), gc = rem >> 10, n = rem & 1023, g = gc >> 7;
        const float* wp = wpool + ((size_t)l * 512 + gc) * 128; const float* ps = pscale + l * 512 + g * 128;
        const float* pb = wpb + ((size_t)l * 512 + g * 128) * DM + n;
        float s = 0.f;
        for (int e0 = 0; e0 < 128; e0 += 8) { float x[8], y[8], z[8];
#pragma unroll
            for (int j = 0; j < 8; ++j) { x[j] = wp[e0 + j]; y[j] = ps[e0 + j]; z[j] = pb[(size_t)(e0 + j) * DM]; }
#pragma unroll
            for (int j = 0; j < 8; ++j) s += x[j] * y[j] * z[j]; }
        ((bf16_t*)(F.ws + WS_WCAT))[((size_t)l * DM + n) * KCAT + 1024 + gc] = f2bf(s);
    }
    {
        LAS float* sl = (LAS float*)(F.lds + 40960);
        LAS float* red = (LAS float*)(F.lds + 40960 + 36864);
        const float* cvec = F.in(I_C); const float* ccv = F.in(I_CCTX); const float* bada = F.in(I_BADA);
        for (int idx = F.tid; idx < 9 * 1024; idx += NTHREADS) { const int r = idx >> 10, k = idx & 1023; const float v = r < 8 ? cvec[r * 1024 + k] : ccv[k]; sl[idx] = silu(v); }
        __syncthreads();
        float* mod = (float*)(F.ws + WS_MOD);
        for (int job = F.bid; job < 2 * 96; job += F.G) {
            const int l = job / 96, n0 = (job % 96) * 64, cidx = F.tid & 63, kg = F.tid >> 6;
            const float* w = F.in(I_WADA) + (size_t)l * DM * 6144 + n0 + cidx;
            float a[9];
#pragma unroll
            for (int r = 0; r < 9; ++r) a[r] = 0.f;
            for (int k0 = kg * 128; k0 < kg * 128 + 128; k0 += 8) { float wv[8];
#pragma unroll
                for (int j = 0; j < 8; ++j) wv[j] = w[(size_t)(k0 + j) * 6144];
#pragma unroll
                for (int j = 0; j < 8; ++j)
#pragma unroll
                    for (int r = 0; r < 9; ++r) a[r] += sl[r * 1024 + k0 + j] * wv[j]; }
#pragma unroll
            for (int r = 0; r < 9; ++r) red[(kg * 64 + cidx) * 9 + r] = a[r];
            __syncthreads();
            for (int idx = F.tid; idx < 576; idx += NTHREADS) { const int ci = idx & 63, r = idx >> 6; float s = 0.f;
#pragma unroll
                for (int g = 0; g < 8; ++g) s += red[(g * 64 + ci) * 9 + r];
                mod[((size_t)l * 9 + r) * 6144 + n0 + ci] = s + bada[l * 6144 + n0 + ci]; }
            __syncthreads();
        }
    }
}

__device__ __forceinline__ void expert_convert(const Frame& F, LAS float* tl) {
    constexpr int ES = FP8_MOE ? 1 : 2;
    conv_mat_t<FP8_MOE>(F, F.in(I_WEG), DFE, NEXP * DM, 0, DFE, F.ws + WS_WEGU, DM, 0, 1, 0, tl, DM / 128, (size_t)2 * DFE * DM);
    conv_mat_t<FP8_MOE>(F, F.in(I_WEU), DFE, NEXP * DM, 0, DFE, F.ws + WS_WEGU, DM, 128, 1, 128, tl, DM / 128, (size_t)2 * DFE * DM);
    conv_mat_t<FP8_MOE>(F, F.in(I_WED), DM, NEXP * DFE, 0, DM, F.ws + WS_WED, DFE, 0, 0, 0, tl, DFE / 128, (size_t)DM * DFE);
}

template <bool SRC32> struct RowRaw;
template <> struct RowRaw<true> { f32x4 v[4];
    __device__ __forceinline__ void load(const void* p, int lane) {
#pragma unroll
        for (int i = 0; i < 4; ++i) v[i] = *(const f32x4*)((const float*)p + i * 256 + lane * 4); }
    __device__ __forceinline__ f32x4 get(int i) const { return v[i]; } };
template <> struct RowRaw<false> { u32x2 v[4];
    __device__ __forceinline__ void load(const void* p, int lane) {
#pragma unroll
        for (int i = 0; i < 4; ++i) v[i] = *(const u32x2*)((const bf16_t*)p + i * 256 + lane * 4); }
    __device__ __forceinline__ f32x4 get(int i) const { return (f32x4){bf_lo(v[i].x), bf_hi(v[i].x), bf_lo(v[i].y), bf_hi(v[i].y)}; } };
template <bool SRC32>
__device__ __forceinline__ void norm_phase(const Frame& F, int l, int which) {
    const bool n1 = which == 0;
    const int M = (which == 2) ? NL : (n1 ? MT : (l == 0 ? MT : NL));
    const char* srcL = SRC32 ? (const char*)F.in(I_X) : (const char*)F.out; const char* srcC = SRC32 ? (const char*)F.in(I_CTX) : (const char*)(F.ws + WS_HC16);
    constexpr size_t RB = SRC32 ? DM * 4 : HLD * 2, RBC = SRC32 ? DM * 4 : HLD * 2;
    const float* g = (n1 ? F.in(I_GMIX) : F.in(I_GFFN)) + l * DM;
    const float* modl = (const float*)(F.ws + WS_MOD) + (size_t)l * 9 * 6144;
    const int shoff = n1 ? MOD_SH1 : MOD_SH2, scoff = n1 ? MOD_SC1 : MOD_SC2;
    bf16_t* U = (bf16_t*)(F.ws + WS_R0);
    const bool u8 = (which == 2 && FP8_MOE) || (which == 1 && FP8_DENSE);
    LAS float* W = (LAS float*)F.lds;
    LAS float* rlog = (LAS float*)(F.lds + 65536);
    LAS int* lcnt = (LAS int*)(F.lds + 65536 + 8192);
    const int ncol = n1 ? 16 : 8;
    const float* bif = F.in(I_BIF) + l * 16;
    if (which != 1) {
        const float* wsrc = n1 ? (F.in(I_WIN) + (size_t)l * DM * IN_COLS + IF_OFF) : (F.in(I_WROUTER));
        const int ld = n1 ? IN_COLS : NEXP;
        for (int idx = F.tid; idx < ncol * 1024; idx += NTHREADS) { const int k = idx / ncol, c = idx % ncol; W[c * 1024 + k] = wsrc[(size_t)k * ld + c]; }
        if (F.tid < 16) lcnt[F.tid] = 0;
        __syncthreads();
    }
    const int rpb = (M + F.G - 1) / F.G, rb0 = F.bid * rpb, rb1 = (rb0 + rpb) < M ? (rb0 + rpb) : M;
    RowRaw<SRC32> nv;
    { const int row = rb0 + F.wave;
      if (row < rb1) nv.load(row >= NL ? srcC + (size_t)(row - NL) * RBC : srcL + (size_t)row * RB, F.lane); }
    f32x4 fac[4], sft[4]; int mcur = -1;
    for (int row = rb0 + F.wave; row < rb1; row += 8) {
        const bool isc = row >= NL;
        const int mrow = isc ? 8 : (row >> 12);
        if (mrow != mcur) { mcur = mrow; const float* mr = modl + (size_t)mrow * 6144;
#pragma unroll
            for (int i = 0; i < 4; ++i) { const int k = i * 256 + F.lane * 4; fac[i] = *(const f32x4*)(g + k) * (*(const f32x4*)(mr + scoff + k) + 1.0f); sft[i] = *(const f32x4*)(mr + shoff + k); } }
        f32x4 v[4]; float ss = 0.f;
#pragma unroll
        for (int i = 0; i < 4; ++i) { v[i] = nv.get(i); ss += v[i][0] * v[i][0] + v[i][1] * v[i][1] + v[i][2] * v[i][2] + v[i][3] * v[i][3]; }
        { const int rn = row + 8;
          if (rn < rb1) nv.load(rn >= NL ? srcC + (size_t)(rn - NL) * RBC : srcL + (size_t)rn * RB, F.lane); }
        ss = wave_sum(ss, F.lane);
        const float r = rsqrtf(ss * (1.0f / DM) + EPS);
#pragma unroll
        for (int i = 0; i < 4; ++i) { const int k = i * 256 + F.lane * 4;
            v[i] = (v[i] * r) * fac[i] + sft[i];
            if (u8) *(unsigned*)((unsigned char*)U + (size_t)row * DM + k) = pack4_fp8(v[i][0], v[i][1], v[i][2], v[i][3]);
            else { u32x2 w; w.x = cvt_pk_bf16(v[i][0], v[i][1]); w.y = cvt_pk_bf16(v[i][2], v[i][3]); *(u32x2*)(U + (size_t)row * DM + k) = w; } }
        if (which == 0) {
            float p[16];
#pragma unroll
            for (int c = 0; c < 16; ++c) { f32x2 s2 = {0.f, 0.f};
#pragma unroll
                for (int i = 0; i < 4; ++i) { const f32x4 w4 = *(const LAS f32x4*)(W + c * 1024 + i * 256 + F.lane * 4);
                    s2 += (f32x2){v[i][0], v[i][1]} * (f32x2){w4[0], w4[1]}; s2 += (f32x2){v[i][2], v[i][3]} * (f32x2){w4[2], w4[3]}; }
                p[c] = s2[0] + s2[1]; }
            { const bool hi = F.lane & 32;
#pragma unroll
              for (int i = 0; i < 8; ++i) { const float keep = hi ? p[i + 8] : p[i], send = hi ? p[i] : p[i + 8]; p[i] = keep + lx_xor(send, 32, F.lane); } }
            { const bool hi = F.lane & 16;
#pragma unroll
              for (int i = 0; i < 4; ++i) { const float keep = hi ? p[i + 4] : p[i], send = hi ? p[i] : p[i + 4]; p[i] = keep + lx_xor(send, 16, F.lane); } }
            { const bool hi = F.lane & 8;
#pragma unroll
              for (int i = 0; i < 2; ++i) { const float keep = hi ? p[i + 2] : p[i], send = hi ? p[i] : p[i + 2]; p[i] = keep + lx_xor(send, 8, F.lane); } }
            { const bool hi = F.lane & 4; const float keep = hi ? p[1] : p[0], send = hi ? p[0] : p[1]; p[0] = keep + lx_xor(send, 4, F.lane); }
            p[0] += lx_xor(p[0], 2, F.lane); p[0] += lx_xor(p[0], 1, F.lane);
            if ((F.lane & 3) == 0) { const int c = ((F.lane >> 5) & 1) * 8 + ((F.lane >> 4) & 1) * 4 + ((F.lane >> 3) & 1) * 2 + ((F.lane >> 2) & 1);
                ((float*)(F.ws + WS_GATES))[(size_t)row * 16 + c] = p[0] + bif[c]; }
        } else if (which == 2) {
            float p[8];
#pragma unroll
            for (int c = 0; c < 8; ++c) { f32x2 s2 = {0.f, 0.f};
#pragma unroll
                for (int i = 0; i < 4; ++i) { const f32x4 w4 = *(const LAS f32x4*)(W + c * 1024 + i * 256 + F.lane * 4);
                    s2 += (f32x2){v[i][0], v[i][1]} * (f32x2){w4[0], w4[1]}; s2 += (f32x2){v[i][2], v[i][3]} * (f32x2){w4[2], w4[3]}; }
                p[c] = s2[0] + s2[1]; }
            { const bool hi = F.lane & 32;
#pragma unroll
              for (int i = 0; i < 4; ++i) { const float keep = hi ? p[i + 4] : p[i], send = hi ? p[i] : p[i + 4]; p[i] = keep + lx_xor(send, 32, F.lane); } }
            { const bool hi = F.lane & 16;
#pragma unroll
              for (int i = 0; i < 2; ++i) { const float keep = hi ? p[i + 2] : p[i], send = hi ? p[i] : p[i + 2]; p[i] = keep + lx_xor(send, 16, F.lane); } }
            { const bool hi = F.lane & 8; const float keep = hi ? p[1] : p[0], send = hi ? p[0] : p[1]; p[0] = keep + lx_xor(send, 8, F.lane); }
            p[0] += lx_xor(p[0], 4, F.lane); p[0] += lx_xor(p[0], 2, F.lane); p[0] += lx_xor(p[0], 1, F.lane);
            if ((F.lane & 7) == 0) { const int c = ((F.lane >> 5) & 1) * 4 + ((F.lane >> 4) & 1) * 2 + ((F.lane >> 3) & 1); rlog[(row - rb0) * 8 + c] = p[0]; }
        }
    }
    if (which == 2) {
        __syncthreads();
        const int nr = rb1 - rb0; int e0 = 0, e1 = 0, k0 = 0, k1 = 0; float p0 = 0.f, p1 = 0.f;
        const bool act = F.tid < nr;
        if (act) {
            float lg[8];
#pragma unroll
            for (int e = 0; e < 8; ++e) lg[e] = rlog[F.tid * 8 + e];
            float v0 = lg[0]; e0 = 0;
#pragma unroll
            for (int e = 1; e < 8; ++e) if (lg[e] > v0) { v0 = lg[e]; e0 = e; }
            float v1 = -3.0e38f; e1 = -1;
#pragma unroll
            for (int e = 0; e < 8; ++e) if (e != e0 && (e1 < 0 || lg[e] > v1)) { v1 = lg[e]; e1 = e; }
            p0 = 1.0f / (1.0f + __expf(v1 - v0)); p1 = 1.0f - p0;
            k0 = atomicAdd((int*)(lcnt + e0), 1); k1 = atomicAdd((int*)(lcnt + e1), 1);
        }
        __syncthreads();
        if (F.tid < 8) lcnt[8 + F.tid] = (int)__hip_atomic_fetch_add(F.ctl + CW_ECNT + 64 * F.tid, (unsigned)lcnt[F.tid], __ATOMIC_RELAXED, __HIP_MEMORY_SCOPE_AGENT);
        __syncthreads();
        if (act) { const int tok = rb0 + F.tid; int* list = (int*)(F.ws + WS_RLIST); float* prob = (float*)(F.ws + WS_RPROB);
            list[(size_t)e0 * NL + lcnt[8 + e0] + k0] = tok * 2; list[(size_t)e1 * NL + lcnt[8 + e1] + k1] = tok * 2 + 1;
            prob[tok * 2] = p0; prob[tok * 2 + 1] = p1; }
        __syncthreads();
    }
}

__device__ __forceinline__ void final_phase(const Frame& F) {
    const float* modl = (const float*)(F.ws + WS_MOD) + (size_t)1 * 9 * 6144;
    const bf16_t* Y0 = (const bf16_t*)(F.ws + WS_Y); const bf16_t* Y1 = Y0 + (size_t)NL * DM; const float* gfin = F.in(I_GFINAL);
    const bf16_t* H = (const bf16_t*)F.out;
    u32x2 nh[4]; u32x2 na[4], nb[4];
    f32x4 gfv[4], gtv[4]; int bcur = -1;
#pragma unroll
    for (int i = 0; i < 4; ++i) gfv[i] = *(const f32x4*)(gfin + i * 256 + F.lane * 4);
    const int stride = F.G * 8;
    { const int row = F.bid * 8 + F.wave;
      if (row < NL) {
#pragma unroll
          for (int i = 0; i < 4; ++i) { const int k = i * 256 + F.lane * 4; nh[i] = *(const u32x2*)(H + (size_t)row * HLD + k);
              na[i] = *(const u32x2*)(Y0 + (size_t)row * DM + k); nb[i] = *(const u32x2*)(Y1 + (size_t)row * DM + k); } } }
    for (int row = F.bid * 8 + F.wave; row < NL; row += stride) {
        float* hr = F.out + (size_t)row * DM;
        if ((row >> 12) != bcur) { bcur = row >> 12; const float* gt = modl + (size_t)bcur * 6144 + MOD_GT2;
#pragma unroll
            for (int i = 0; i < 4; ++i) gtv[i] = *(const f32x4*)(gt + i * 256 + F.lane * 4); }
        f32x4 v[4]; u32x2 ya[4], yb[4];
#pragma unroll
        for (int i = 0; i < 4; ++i) { v[i] = (f32x4){bf_lo(nh[i].x), bf_hi(nh[i].x), bf_lo(nh[i].y), bf_hi(nh[i].y)}; ya[i] = na[i]; yb[i] = nb[i]; }
        { const int rn = row + stride;
          if (rn < NL) {
#pragma unroll
              for (int i = 0; i < 4; ++i) { const int k = i * 256 + F.lane * 4; nh[i] = *(const u32x2*)(H + (size_t)rn * HLD + k);
                  na[i] = *(const u32x2*)(Y0 + (size_t)rn * DM + k); nb[i] = *(const u32x2*)(Y1 + (size_t)rn * DM + k); } } }
        float ss = 0.f;
#pragma unroll
        for (int i = 0; i < 4; ++i) { const int k = i * 256 + F.lane * 4; const u32x2 a = ya[i], b = yb[i];
            const f32x4 y = (f32x4){bf_lo(a.x) + bf_lo(b.x), bf_hi(a.x) + bf_hi(b.x), bf_lo(a.y) + bf_lo(b.y), bf_hi(a.y) + bf_hi(b.y)};
            v[i] += gtv[i] * y;
            ss += v[i][0] * v[i][0] + v[i][1] * v[i][1] + v[i][2] * v[i][2] + v[i][3] * v[i][3]; }
        ss = wave_sum(ss, F.lane);
        const float r = rsqrtf(ss * (1.0f / DM) + EPS);
#pragma unroll
        for (int i = 0; i < 4; ++i) { const int k = i * 256 + F.lane * 4; *(f32x4*)(hr + k) = (v[i] * r) * gfv[i]; }
    }
}

__device__ __forceinline__ float logsigmoid(float x) { return fminf(x, 0.f) - log1pf(__expf(-fabsf(x))); }
__device__ __forceinline__ float scan_add(float v, int lane) {
#pragma unroll
    for (int o = 1; o < 64; o <<= 1) { const float t = lx_up(v, o, lane); if (lane >= o) v += t; }
    return v;
}
__device__ __forceinline__ float scan_max(float v, int lane) {
#pragma unroll
    for (int o = 1; o < 64; o <<= 1) { const float t = lx_up(v, o, lane); if (lane >= o) v = fmaxf(v, t); }
    return v;
}
__device__ __forceinline__ void prep_phase(const Frame& F, int l) {
    bf16_t* QKV = (bf16_t*)(F.ws + WS_R1); const bf16_t* halo = (const bf16_t*)(F.ws + WS_HALO);
    bf16_t* KT = (bf16_t*)(F.ws + WS_KT); bf16_t* VT = (bf16_t*)(F.ws + WS_VT);
    const float* cw = F.in(I_CONV) + (size_t)l * 3 * 2048;
    LAS bf16_t* T = (LAS bf16_t*)F.lds;
    constexpr int TP = 258;
    const int cg = F.tid & 31, rg = F.tid >> 5;
    { const float* gates = (const float*)(F.ws + WS_GATES); f32x4* gsc = (f32x4*)(F.ws + WS_GSC);
      for (int task = F.bid * 8 + F.wave; task < NCHUNK * 8; task += F.G * 8) {
          const int ci = task >> 3, dh = task & 7, dir = dh >> 2, h = dh & 3, rr = dir ? 63 - F.lane : F.lane;
          const float ig = gates[(size_t)(ci * 64 + rr) * 16 + dir * 8 + h], fp = gates[(size_t)(ci * 64 + rr) * 16 + dir * 8 + 4 + h];
          const float bcum = scan_add(logsigmoid(fp), F.lane), a_ = ig - bcum, pmax = scan_max(a_, F.lane);
          gsc[(size_t)task * 64 + rr] = (f32x4){a_, bcum, pmax, 0.f}; } }
#if MLSTM_TR
    {
        u32x4 nraw[6];
#define PREP_LOAD(un_) do { const int _ci = (un_) >> 3, _hc = (un_) & 7, _row0 = _ci * 64, _col0 = _hc * 256 + cg * 8; bool _first, _lastc; \
        if (_ci < NCHUNK_L) { _first = (_ci & 63) == 0; _lastc = (_ci & 63) == 63; } else { const int _cc = _ci - NCHUNK_L; _first = (_cc & 3) == 0; _lastc = (_cc & 3) == 3; } \
        _Pragma("unroll") for (int i = 0; i < 6; ++i) { const int r = rg * 4 - 1 + i; \
            if (r < 0) nraw[i] = _first ? (u32x4){0u, 0u, 0u, 0u} : *(const u32x4*)(halo + ((size_t)(_ci - 1) * 2 + 1) * 2048 + _col0); \
            else if (r > 63) nraw[i] = _lastc ? (u32x4){0u, 0u, 0u, 0u} : *(const u32x4*)(halo + ((size_t)(_ci + 1) * 2 + 0) * 2048 + _col0); \
            else nraw[i] = *(const u32x4*)(QKV + (size_t)(_row0 + r) * NQKV + _col0); } } while (0)
        f32x4 w[3][2]; int hcw = -1;
        int qh = (NCHUNK * 8 + F.G - 1) / F.G, nlight = 1, lrank = -1;
        if (SPLIT_PREP && F.G == 256) {
            if (l == 0) { qh = 15; nlight = 48; lrank = (F.bid >= 96 && F.bid < 128) ? F.bid - 96 : (F.bid >= 240 ? 32 + F.bid - 240 : -1); }
            else { qh = 10; nlight = 160; lrank = F.bid >= 96 ? F.bid - 96 : -1; } }
#define PREP_UN(s_) ((s_) < qh ? F.bid + F.G * (s_) : (lrank >= 0 ? F.G * qh + lrank + nlight * ((s_) - qh) : NCHUNK * 8))
        if (PREP_UN(0) < NCHUNK * 8) PREP_LOAD(PREP_UN(0));
        for (int sq = 0; PREP_UN(sq) < NCHUNK * 8; ++sq) {
            const int un = PREP_UN(sq), un_next = PREP_UN(sq + 1);
            const int ci = un >> 3, hc = un & 7, row0 = ci * 64, col0 = hc * 256 + cg * 8;
            u32x4 raw[6];
#pragma unroll
            for (int i = 0; i < 6; ++i) raw[i] = nraw[i];
            if (hc != hcw) { hcw = hc;
#pragma unroll
                for (int j = 0; j < 3; ++j) { w[j][0] = *(const f32x4*)(cw + j * 2048 + col0); w[j][1] = *(const f32x4*)(cw + j * 2048 + col0 + 4); } }
            if (un_next < NCHUNK * 8) PREP_LOAD(un_next);
            const float scl = hc >= 4 ? 0.0625f : 1.0f;
            f32x4 x[6][2]; u32x4 ow[4];
#pragma unroll
            for (int i = 0; i < 6; ++i) unpack8(raw[i], x[i][0], x[i][1]);
#pragma unroll
            for (int i = 0; i < 4; ++i) { f32x4 o[2];
#pragma unroll
                for (int hh = 0; hh < 2; ++hh) { o[hh] = x[i][hh] * w[0][hh] + x[i + 1][hh] * w[1][hh] + x[i + 2][hh] * w[2][hh];
#pragma unroll
                    for (int j = 0; j < 4; ++j) o[hh][j] = silu(o[hh][j]) * scl; }
                ow[i] = pack8(o[0], o[1]); }
            __syncthreads();
#pragma unroll
            for (int i = 0; i < 4; ++i) *(u32x4*)(QKV + (size_t)(row0 + rg * 4 + i) * NQKV + col0) = ow[i];
        }
#undef PREP_LOAD
#undef PREP_UN
        return;
    }
#endif
    constexpr int NHC = 12;
    for (int un = F.bid; un < NCHUNK * NHC; un += F.G) {
        const int ci = un / NHC, hc = un % NHC, row0 = ci * 64, col0 = hc * 256 + cg * 8;
        bool first, lastc;
        if (ci < NCHUNK_L) { first = (ci & 63) == 0; lastc = (ci & 63) == 63; } else { const int cc = ci - NCHUNK_L; first = (cc & 3) == 0; lastc = (cc & 3) == 3; }
        u32x4 ow[4];
        if (hc < 8) {
            u32x4 raw[6];
#pragma unroll
            for (int i = 0; i < 6; ++i) { const int r = rg * 4 - 1 + i;
                if (r < 0) raw[i] = first ? (u32x4){0u, 0u, 0u, 0u} : *(const u32x4*)(halo + ((size_t)(ci - 1) * 2 + 1) * 2048 + col0);
                else if (r > 63) raw[i] = lastc ? (u32x4){0u, 0u, 0u, 0u} : *(const u32x4*)(halo + ((size_t)(ci + 1) * 2 + 0) * 2048 + col0);
                else raw[i] = *(const u32x4*)(QKV + (size_t)(row0 + r) * NQKV + col0); }
            f32x4 w[3][2];
#pragma unroll
            for (int j = 0; j < 3; ++j) { w[j][0] = *(const f32x4*)(cw + j * 2048 + col0); w[j][1] = *(const f32x4*)(cw + j * 2048 + col0 + 4); }
            const float scl = hc >= 4 ? 0.0625f : 1.0f;
            f32x4 x[6][2];
#pragma unroll
            for (int i = 0; i < 6; ++i) unpack8(raw[i], x[i][0], x[i][1]);
#pragma unroll
            for (int i = 0; i < 4; ++i) { f32x4 o[2];
#pragma unroll
                for (int hh = 0; hh < 2; ++hh) { o[hh] = x[i][hh] * w[0][hh] + x[i + 1][hh] * w[1][hh] + x[i + 2][hh] * w[2][hh];
#pragma unroll
                    for (int j = 0; j < 4; ++j) o[hh][j] = silu(o[hh][j]) * scl; }
                ow[i] = pack8(o[0], o[1]); }
            __syncthreads();
#pragma unroll
            for (int i = 0; i < 4; ++i) *(u32x4*)(QKV + (size_t)(row0 + rg * 4 + i) * NQKV + col0) = ow[i];
        } else {
#pragma unroll
            for (int i = 0; i < 4; ++i) ow[i] = *(const u32x4*)(QKV + (size_t)(row0 + rg * 4 + i) * NQKV + col0);
        }
        if (hc >= 4 && !MLSTM_TR) {
#pragma unroll
            for (int i = 0; i < 4; ++i) { LAS unsigned* tp = (LAS unsigned*)(T + (rg * 4 + i) * TP + cg * 8);
                tp[0] = ow[i].x; tp[1] = ow[i].y; tp[2] = ow[i].z; tp[3] = ow[i].w; }
            __syncthreads();
            bf16_t* dst = (hc < 8 ? KT : VT) + ((size_t)ci * 4 + (hc & 3)) * (256 * 64);
#pragma unroll
            for (int o = 0; o < 4; ++o) { const int idx = F.tid + o * NTHREADS, d = idx >> 3, sc = idx & 7; unsigned short v[8];
#pragma unroll
                for (int j = 0; j < 8; ++j) v[j] = T[(sc * 8 + j) * TP + d];
                u32x4 w; w.x = v[0] | ((unsigned)v[1] << 16); w.y = v[2] | ((unsigned)v[3] << 16); w.z = v[4] | ((unsigned)v[5] << 16); w.w = v[6] | ((unsigned)v[7] << 16);
                *(u32x4*)(dst + (size_t)d * 64 + sc * 8) = w; }
            __syncthreads();
        }
    }
}

__device__ __forceinline__ void mlstm_phase_ref(const Frame& F, int l) {
    const bf16_t* QKV = (const bf16_t*)(F.ws + WS_R1); const float* gates = (const float*)(F.ws + WS_GATES);
    LAS bf16_t* Qs = (LAS bf16_t*)F.lds;
    LAS bf16_t* Ks = (LAS bf16_t*)(F.lds + 32768);
    LAS float* Cs = (LAS float*)(F.lds + 65536);
    LAS bf16_t* Vs = (LAS bf16_t*)(F.lds + 131072);
    LAS bf16_t* Ps = (LAS bf16_t*)(F.lds + 139264);
    LAS float* sc = (LAS float*)(F.lds + 147456);
    LAS float* s_a = sc, *s_mj = sc + 64, *s_wi = sc + 128, *s_en = sc + 192, *s_wk = sc + 256, *s_den = sc + 320, *s_n = sc + 384;
    const int tid = F.tid, lane = F.lane;
    for (int un = F.bid; un < 256; un += F.G) {
        const int xcd = un & 7, q = un >> 3, seq = xcd * 8 + (q >> 2), es = q & 3;
        const int b = seq >> 3, h = (seq >> 1) & 3, dir = seq & 1;
        bf16_t* HO = (bf16_t*)(F.ws + (dir ? WS_HB : WS_HF));
        for (int i = tid; i < 256 * 64; i += NTHREADS) Cs[i] = 0.f;
        if (tid < 256) s_n[tid] = 0.f;
        float m_st = 0.f;
        __syncthreads();
        for (int step = 0; step < 68; ++step) {
            const bool isctx = step < 4; const int cidx = isctx ? step : step - 4, nch = isctx ? 4 : 64;
            const int cact = dir ? (nch - 1 - cidx) : cidx;
            const int row0 = isctx ? (NL + b * CTXL + cact * 64) : (b * SEQ + cact * 64);
#pragma unroll
            for (int o = 0; o < 4; ++o) { const int idx = tid + o * NTHREADS, r = idx >> 5, c8 = (idx & 31) * 8;
                const u32x4 qv = *(const u32x4*)(QKV + (size_t)(row0 + r) * NQKV + h * 256 + c8);
                const u32x4 kv = *(const u32x4*)(QKV + (size_t)(row0 + r) * NQKV + 1024 + h * 256 + c8);
                *(LAS u32x4*)(Qs + r * 256 + c8) = qv; *(LAS u32x4*)(Ks + r * 256 + c8) = kv; }
            { const int r = tid >> 3, c8 = (tid & 7) * 8;
              *(LAS u32x4*)(Vs + r * 64 + c8) = *(const u32x4*)(QKV + (size_t)(row0 + r) * NQKV + 2048 + h * 256 + es * 64 + c8); }
            float wc;
            { const int r = dir ? 63 - lane : lane;
              const float ig = gates[(size_t)(row0 + r) * 16 + dir * 8 + h], fp = gates[(size_t)(row0 + r) * 16 + dir * 8 + 4 + h];
              const float fc = logsigmoid(fp);
              const float bcum = scan_add(fc, lane);
              const float blast = lx_idx(bcum, 63);
              const float a = ig - bcum;
              const float pmax = scan_max(a, lane);
              const float mj = fmaxf(m_st, pmax);
              const float gend = blast + a;
              const float mnew = fmaxf(blast + m_st, wave_max(gend, lane));
              const float wk = __expf(gend - mnew);
              wc = __expf(blast + m_st - mnew);
              if (F.wave == 0) { s_a[r] = a; s_mj[r] = mj; s_wi[r] = __expf(m_st - mj); s_en[r] = __expf(-(bcum + mj)); s_wk[r] = wk; }
              m_st = mnew; }
            __syncthreads();
            { const int j = tid >> 3, sg = tid & 7; float acc[8];
#pragma unroll
              for (int i = 0; i < 8; ++i) acc[i] = 0.f;
#pragma unroll 2
              for (int kk = 0; kk < 32; ++kk) { const u32x4 qv = *(const LAS u32x4*)(Qs + j * 256 + kk * 8);
                  const float q0 = bf_lo(qv.x), q1 = bf_hi(qv.x), q2 = bf_lo(qv.y), q3 = bf_hi(qv.y), q4 = bf_lo(qv.z), q5 = bf_hi(qv.z), q6 = bf_lo(qv.w), q7 = bf_hi(qv.w);
#pragma unroll
                  for (int i = 0; i < 8; ++i) { const u32x4 kv = *(const LAS u32x4*)(Ks + (sg * 8 + i) * 256 + kk * 8);
                      acc[i] += q0 * bf_lo(kv.x) + q1 * bf_hi(kv.x) + q2 * bf_lo(kv.y) + q3 * bf_hi(kv.y) + q4 * bf_lo(kv.z) + q5 * bf_hi(kv.z) + q6 * bf_lo(kv.w) + q7 * bf_hi(kv.w); } }
              const float mjj = s_mj[j]; float rs = 0.f; float pv[8];
#pragma unroll
              for (int i = 0; i < 8; ++i) { const int s = sg * 8 + i; const bool ok = dir ? (s >= j) : (s <= j);
                  pv[i] = ok ? acc[i] * __expf(s_a[s] - mjj) : 0.f; rs += pv[i]; }
              u32x4 pw; pw.x = cvt_pk_bf16(pv[0], pv[1]); pw.y = cvt_pk_bf16(pv[2], pv[3]); pw.z = cvt_pk_bf16(pv[4], pv[5]); pw.w = cvt_pk_bf16(pv[6], pv[7]);
              *(LAS u32x4*)(Ps + j * 64 + sg * 8) = pw;
              rs += lx_xor(rs, 1, F.lane); rs += lx_xor(rs, 2, F.lane); rs += lx_xor(rs, 4, F.lane);
              if (sg == 0) s_den[j] = rs; }
            __syncthreads();
            { const int e = tid & 63, jg = tid >> 6; float acc[8], qn[8];
#pragma unroll
              for (int i = 0; i < 8; ++i) { acc[i] = 0.f;
                  const u32x2 qq = *(const LAS u32x2*)(Qs + (jg * 8 + i) * 256 + e * 4); const f32x4 nn = *(const LAS f32x4*)(s_n + e * 4);
                  qn[i] = wave_sum(bf_lo(qq.x) * nn[0] + bf_hi(qq.x) * nn[1] + bf_lo(qq.y) * nn[2] + bf_hi(qq.y) * nn[3], lane); }
#pragma unroll 4
              for (int d = 0; d < 256; d += 2) { const float c0 = Cs[d * 64 + e], c1 = Cs[(d + 1) * 64 + e];
#pragma unroll
                  for (int i = 0; i < 8; ++i) { const unsigned qq = *(const LAS unsigned*)(Qs + (jg * 8 + i) * 256 + d); acc[i] += bf_lo(qq) * c0 + bf_hi(qq) * c1; } }
#pragma unroll
              for (int i = 0; i < 8; ++i) acc[i] *= s_wi[jg * 8 + i];
#pragma unroll 4
              for (int s = 0; s < 64; s += 2) { const float v0 = bf2f(Vs[s * 64 + e]), v1 = bf2f(Vs[(s + 1) * 64 + e]);
#pragma unroll
                  for (int i = 0; i < 8; ++i) { const unsigned pp = *(const LAS unsigned*)(Ps + (jg * 8 + i) * 64 + s); acc[i] += bf_lo(pp) * v0 + bf_hi(pp) * v1; } }
              if (!isctx || l == 0) {
#pragma unroll
                  for (int i = 0; i < 8; ++i) { const int j = jg * 8 + i; const float den = s_wi[j] * qn[i] + s_den[j];
                      HO[(size_t)(row0 + j) * DM + h * 256 + es * 64 + e] = f2bf(acc[i] / fmaxf(fabsf(den), s_en[j])); } } }
            __syncthreads();
            { const int e = tid & 63, dg = tid >> 6;
#pragma unroll 1
              for (int sh = 0; sh < 64; sh += 32) { float vv[32]; const float cf = sh == 0 ? wc : 1.0f;
#pragma unroll
                  for (int s = 0; s < 32; ++s) vv[s] = s_wk[sh + s] * bf2f(Vs[(sh + s) * 64 + e]);
#pragma unroll 1
                  for (int i = 0; i < 32; i += 2) { const int d = dg * 32 + i; float a0 = cf * Cs[d * 64 + e], a1 = cf * Cs[(d + 1) * 64 + e];
#pragma unroll
                      for (int s = 0; s < 32; ++s) { const unsigned kk = *(const LAS unsigned*)(Ks + (sh + s) * 256 + d); a0 += bf_lo(kk) * vv[s]; a1 += bf_hi(kk) * vv[s]; }
                      Cs[d * 64 + e] = a0; Cs[(d + 1) * 64 + e] = a1; } }
              if (tid < 256) { float nn = wc * s_n[tid];
                  for (int s = 0; s < 64; ++s) nn += s_wk[s] * bf2f(Ks[s * 256 + tid]);
                  s_n[tid] = nn; } }
            __syncthreads();
        }
    }
}

#define LDS_BARRIER() do { asm volatile("s_waitcnt lgkmcnt(0)" ::: "memory"); __builtin_amdgcn_s_barrier(); asm volatile("" ::: "memory"); } while (0)
__device__ __forceinline__ void mlstm_phase_mfma(const Frame& F, int l) {
    constexpr int QP = 528, TP = 144;
    constexpr int O_Q = 0, O_K = 33792, O_KT = 67584, O_CT = 104448, O_VT = O_CT + 65 * QP, O_P = O_VT + 65 * TP, O_SC = O_P + 64 * TP;
    constexpr int SC_PAR = 1280;
    constexpr int O_DEN = O_SC + 2 * SC_PAR, O_MISC = O_DEN + 256, O_RAW = O_MISC + 64;
    static_assert(O_RAW + 2048 <= LDS_BYTES - 16, "mlstm LDS map");
    const bf16_t* QKV = (const bf16_t*)(F.ws + WS_R1); const f32x4* gsc = (const f32x4*)(F.ws + WS_GSC);
    const bf16_t* KTg = (const bf16_t*)(F.ws + WS_KT); const bf16_t* VTg = (const bf16_t*)(F.ws + WS_VT);
    LAS unsigned char* lds = F.lds;
    const int tid = F.tid, lane = F.lane, w = F.wave, r16 = lane & 15, g = lane >> 4;
    const int jh = w & 1, mg = w >> 1; const bool isS = mg < 2; const int nmt = mg == 3 ? 3 : 2;
    for (int un = F.bid; un < 256; un += F.G) {
        const int xcd = un & 7, q = un >> 3, seq = xcd * 8 + (q >> 2), es = q & 3;
        const int b = seq >> 3, h = (seq >> 1) & 3, dir = seq & 1;
        bf16_t* HO = (bf16_t*)(F.ws + (dir ? WS_HB : WS_HF));
        __syncthreads();
        for (int i = tid; i < 65 * QP / 4; i += NTHREADS) ((LAS unsigned*)(lds + O_CT))[i] = 0u;
        if (tid < 32) ((LAS unsigned*)(lds + O_VT + 64 * TP))[tid] = 0x3F803F80u;
        f32x4 accC[2][5];
#pragma unroll
        for (int a = 0; a < 2; ++a)
#pragma unroll
            for (int e = 0; e < 5; ++e) accC[a][e] = (f32x4){0.f, 0.f, 0.f, 0.f};
        float m_st = 0.f;
        u32x4 rq[4], rk[4], rt[4], rv; f32x4 gs4 = {0.f, 0.f, 0.f, 0.f}; int row0n = 0;
#define ML_LOAD(step_) do { const int _st = (step_); const bool _ic = _st < 4; const int _ci = _ic ? _st : _st - 4, _n = _ic ? 4 : 64, _ca = dir ? (_n - 1 - _ci) : _ci; \
        row0n = _ic ? (NL + b * CTXL + _ca * 64) : (b * SEQ + _ca * 64); const size_t _tile = (size_t)(row0n >> 6) * 4 + h; \
        _Pragma("unroll") for (int o = 0; o < 4; ++o) { const int idx = tid + o * NTHREADS, r = idx >> 5, c8 = (idx & 31) * 8; \
            rq[o] = *(const u32x4*)(QKV + (size_t)(row0n + r) * NQKV + h * 256 + c8); rk[o] = *(const u32x4*)(QKV + (size_t)(row0n + r) * NQKV + 1024 + h * 256 + c8); \
            rt[o] = *(const u32x4*)(KTg + _tile * 16384 + (size_t)idx * 8); } \
        rv = *(const u32x4*)(VTg + _tile * 16384 + (size_t)es * 4096 + (size_t)tid * 8); } while (0)
#define ML_SCAL(par_) do { LAS float* sp = (LAS float*)(lds + O_SC + (par_) * SC_PAR); const int lastr = dir ? 0 : 63; \
        const f32x4 g4 = *(const LAS f32x4*)(lds + O_RAW + (par_) * 1024 + lane * 16); const float a_ = g4[0], bcum = g4[1], pmax = g4[2]; \
        const float blast = __int_as_float(__builtin_amdgcn_readlane(__float_as_int(bcum), lastr)), gmax = blast + __int_as_float(__builtin_amdgcn_readlane(__float_as_int(pmax), lastr)); \
        const float mj = fmaxf(m_st, pmax), mnew = fmaxf(blast + m_st, gmax); \
        sp[lane] = a_; sp[64 + lane] = mj; sp[128 + lane] = __expf(m_st - mj); sp[192 + lane] = __expf(-(bcum + mj)); sp[256 + lane] = __expf(blast + a_ - mnew); \
        if (lane == 0) ((LAS float*)(lds + O_MISC))[(par_)] = __expf(blast + m_st - mnew); m_st = mnew; } while (0)
#define ML_STORE() do { _Pragma("unroll") for (int jt = 0; jt < 2; ++jt) \
        *(u32x4*)(HO + (size_t)(prow0 + jh * 32 + jt * 16 + r16) * DM + h * 256 + es * 64 + (mg - 2) * 32 + 8 * g) = (u32x4){pow_[jt][0].x, pow_[jt][0].y, pow_[jt][1].x, pow_[jt][1].y}; } while (0)
        u32x2 pow_[2][2]; bool pend = false; int prow0 = 0;
#define ML_ROW0(step_) (((step_) < 4) ? (NL + b * CTXL + (dir ? (3 - (step_)) : (step_)) * 64) : (b * SEQ + (dir ? (63 - ((step_) - 4)) : ((step_) - 4)) * 64))
        gs4 = gsc[((size_t)(ML_ROW0(0) >> 6) * 8 + dir * 4 + h) * 64 + lane];
        if (w == 0) *(LAS f32x4*)(lds + O_RAW + lane * 16) = gs4;
        gs4 = gsc[((size_t)(ML_ROW0(1) >> 6) * 8 + dir * 4 + h) * 64 + lane];
        ML_LOAD(0);
        if (w == 0) ML_SCAL(0);
        LDS_BARRIER();
        for (int step = 0; step < 68; ++step) {
            const int p = step & 1; const int row0 = row0n; const bool wr_out = (step >= 4) || (l == 0);
            const LAS float* sp = (const LAS float*)(lds + O_SC + p * SC_PAR);
            const f32x4 wkA = *(const LAS f32x4*)(sp + 256 + (tid & 7) * 8), wkB = *(const LAS f32x4*)(sp + 256 + (tid & 7) * 8 + 4);
#pragma unroll
            for (int o = 0; o < 4; ++o) { const int idx = tid + o * NTHREADS, r = idx >> 5, c8 = (idx & 31) * 8;
                *(LAS u32x4*)(lds + O_Q + r * QP + c8 * 2) = rq[o]; *(LAS u32x4*)(lds + O_K + r * QP + c8 * 2) = rk[o];
                { const u32x4 rw = rt[o]; u32x4 sw;
                  sw.x = cvt_pk_bf16(bf_lo(rw.x) * wkA[0], bf_hi(rw.x) * wkA[1]); sw.y = cvt_pk_bf16(bf_lo(rw.y) * wkA[2], bf_hi(rw.y) * wkA[3]);
                  sw.z = cvt_pk_bf16(bf_lo(rw.z) * wkB[0], bf_hi(rw.z) * wkB[1]); sw.w = cvt_pk_bf16(bf_lo(rw.w) * wkB[2], bf_hi(rw.w) * wkB[3]);
                  *(LAS u32x4*)(lds + O_KT + (idx >> 3) * TP + (idx & 7) * 16) = sw; } }
            { const int ev = tid >> 3, evr = (ev & 32) | ((ev & 4) << 2) | ((ev & 24) >> 1) | (ev & 3);
              *(LAS u32x4*)(lds + O_VT + evr * TP + (tid & 7) * 16) = rv; }
            if (w == 0) *(LAS f32x4*)(lds + O_RAW + (p ^ 1) * 1024 + lane * 16) = gs4;
            { const int sn = step + 2 < 68 ? step + 2 : 67; gs4 = gsc[((size_t)(ML_ROW0(sn) >> 6) * 8 + dir * 4 + h) * 64 + lane]; }
            LDS_BARRIER();
            if (pend) { ML_STORE(); pend = false; }
            if (step + 1 < 68) ML_LOAD(step + 1);
            f32x4 acc[3][2];
#pragma unroll
            for (int t = 0; t < 3; ++t) { acc[t][0] = (f32x4){0.f, 0.f, 0.f, 0.f}; acc[t][1] = acc[t][0]; }
            { const int abase = (isS ? O_K + mg * 32 * QP : O_CT + (mg - 2) * 32 * QP) + r16 * QP + g * 16;
              const int qbase = O_Q + (jh * 32 + r16) * QP + g * 16;
#pragma unroll
              for (int ks = 0; ks < 8; ++ks) {
                  const bf16x8 b0 = *(const LAS bf16x8*)(lds + qbase + ks * 64), b1 = *(const LAS bf16x8*)(lds + qbase + 16 * QP + ks * 64);
                  const bf16x8 a0 = *(const LAS bf16x8*)(lds + abase + ks * 64), a1 = *(const LAS bf16x8*)(lds + abase + 16 * QP + ks * 64);
                  acc[0][0] = __builtin_amdgcn_mfma_f32_16x16x32_bf16(a0, b0, acc[0][0], 0, 0, 0); acc[0][1] = __builtin_amdgcn_mfma_f32_16x16x32_bf16(a0, b1, acc[0][1], 0, 0, 0);
                  acc[1][0] = __builtin_amdgcn_mfma_f32_16x16x32_bf16(a1, b0, acc[1][0], 0, 0, 0); acc[1][1] = __builtin_amdgcn_mfma_f32_16x16x32_bf16(a1, b1, acc[1][1], 0, 0, 0);
                  if (nmt == 3) { const bf16x8 a2 = *(const LAS bf16x8*)(lds + abase + 32 * QP + ks * 64);
                      acc[2][0] = __builtin_amdgcn_mfma_f32_16x16x32_bf16(a2, b0, acc[2][0], 0, 0, 0); acc[2][1] = __builtin_amdgcn_mfma_f32_16x16x32_bf16(a2, b1, acc[2][1], 0, 0, 0); } } }
            if (isS) {
#pragma unroll
                for (int t = 0; t < 2; ++t) { const int s0 = mg * 32 + t * 16 + 4 * g; const f32x4 as = *(const LAS f32x4*)(sp + s0);
#pragma unroll
                    for (int jt = 0; jt < 2; ++jt) { const int j = jh * 32 + jt * 16 + r16; const float mjj = sp[64 + j]; float pv[4];
#pragma unroll
                        for (int i = 0; i < 4; ++i) { const int s = s0 + i; const bool ok = dir ? (s >= j) : (s <= j); pv[i] = ok ? acc[t][jt][i] * __expf(as[i] - mjj) : 0.f; }
                        u32x2 pw; pw.x = cvt_pk_bf16(pv[0], pv[1]); pw.y = cvt_pk_bf16(pv[2], pv[3]);
                        *(LAS u32x2*)(lds + O_P + j * TP + s0 * 2) = pw; } }
            }
            LDS_BARRIER();
            if (!isS) {
#pragma unroll
                for (int jt = 0; jt < 2; ++jt) { const float wi = sp[128 + jh * 32 + jt * 16 + r16];
#pragma unroll
                    for (int t = 0; t < 3; ++t) acc[t][jt] *= wi; }
                const int vbase = O_VT + ((mg - 2) * 32 + r16) * TP + g * 16, pbase = O_P + (jh * 32 + r16) * TP + g * 16;
#pragma unroll
                for (int ks = 0; ks < 2; ++ks) {
                    const bf16x8 b0 = *(const LAS bf16x8*)(lds + pbase + ks * 64), b1 = *(const LAS bf16x8*)(lds + pbase + 16 * TP + ks * 64);
                    const bf16x8 a0 = *(const LAS bf16x8*)(lds + vbase + ks * 64), a1 = *(const LAS bf16x8*)(lds + vbase + 16 * TP + ks * 64);
                    acc[0][0] = __builtin_amdgcn_mfma_f32_16x16x32_bf16(a0, b0, acc[0][0], 0, 0, 0); acc[0][1] = __builtin_amdgcn_mfma_f32_16x16x32_bf16(a0, b1, acc[0][1], 0, 0, 0);
                    acc[1][0] = __builtin_amdgcn_mfma_f32_16x16x32_bf16(a1, b0, acc[1][0], 0, 0, 0); acc[1][1] = __builtin_amdgcn_mfma_f32_16x16x32_bf16(a1, b1, acc[1][1], 0, 0, 0);
                    if (nmt == 3) { const bf16x8 a2 = *(const LAS bf16x8*)(lds + vbase + 32 * TP + ks * 64);
                        acc[2][0] = __builtin_amdgcn_mfma_f32_16x16x32_bf16(a2, b0, acc[2][0], 0, 0, 0); acc[2][1] = __builtin_amdgcn_mfma_f32_16x16x32_bf16(a2, b1, acc[2][1], 0, 0, 0); } }
                if (mg == 3 && g == 0) { LAS float* dn = (LAS float*)(lds + O_DEN); dn[jh * 32 + r16] = acc[2][0][0]; dn[jh * 32 + 16 + r16] = acc[2][1][0]; }
            } else if (w == 0 && step + 1 < 68) { ML_SCAL(p ^ 1); }
            { const float wc = ((const LAS float*)(lds + O_MISC))[p];
#pragma unroll
              for (int a = 0; a < 2; ++a)
#pragma unroll
                  for (int e = 0; e < 5; ++e) accC[a][e] *= wc;
#pragma unroll
              for (int ks = 0; ks < 2; ++ks) {
                  bf16x8 bv[5];
#pragma unroll
                  for (int e = 0; e < 5; ++e) bv[e] = *(const LAS bf16x8*)(lds + O_VT + (e * 16 + r16) * TP + ks * 64 + g * 16);
#pragma unroll
                  for (int a = 0; a < 2; ++a) { const bf16x8 ka = *(const LAS bf16x8*)(lds + O_KT + ((w * 2 + a) * 16 + r16) * TP + ks * 64 + g * 16);
#pragma unroll
                      for (int e = 0; e < 5; ++e) accC[a][e] = __builtin_amdgcn_mfma_f32_16x16x32_bf16(ka, bv[e], accC[a][e], 0, 0, 0); } } }
            LDS_BARRIER();
#pragma unroll
            for (int a = 0; a < 2; ++a)
#pragma unroll
                for (int e = 0; e < 5; ++e) { const int er = e * 16 + r16;
                    if (er <= 64) { u32x2 cw; cw.x = cvt_pk_bf16(accC[a][e][0], accC[a][e][1]); cw.y = cvt_pk_bf16(accC[a][e][2], accC[a][e][3]);
                        *(LAS u32x2*)(lds + O_CT + er * QP + ((w * 2 + a) * 16 + 4 * g) * 2) = cw; } }
            pend = !isS && wr_out; prow0 = row0;
            if (pend) {
#pragma unroll
                for (int jt = 0; jt < 2; ++jt) { const int j = jh * 32 + jt * 16 + r16;
                    const float den = ((const LAS float*)(lds + O_DEN))[j]; const float inv = __builtin_amdgcn_rcpf(fmaxf(fabsf(den), sp[192 + j]));
#pragma unroll
                    for (int t = 0; t < 2; ++t) { pow_[jt][t].x = cvt_pk_bf16(acc[t][jt][0] * inv, acc[t][jt][1] * inv); pow_[jt][t].y = cvt_pk_bf16(acc[t][jt][2] * inv, acc[t][jt][3] * inv); } }
            }
        }
        if (pend) { ML_STORE(); pend = false; }
#undef ML_LOAD
#undef ML_ROW0
#undef ML_SCAL
#undef ML_STORE
    }
}

typedef short s16x4 __attribute__((ext_vector_type(4)));
__device__ __forceinline__ bf16x8 tr_frag(LAS unsigned char* img, int pitch, int ks, int c, int lane) {
    const int g = lane >> 4, q = (lane & 15) >> 2, p = lane & 3;
    LAS unsigned char* a0 = img + (32 * ks + 8 * g + q) * pitch + (16 * c + 4 * p) * 2;
    const s16x4 lo = __builtin_amdgcn_ds_read_tr16_b64_v4i16((LAS s16x4*)a0), hi = __builtin_amdgcn_ds_read_tr16_b64_v4i16((LAS s16x4*)(a0 + 4 * pitch));
    return __builtin_shufflevector(lo, hi, 0, 1, 2, 3, 4, 5, 6, 7);
}
__device__ __forceinline__ void mlstm_phase_tr(const Frame& F, int l) {
    constexpr int QP = 544, KP = 544, VP = 208, TP = 160;
    constexpr int O_Q = 0, O_K = O_Q + 64 * QP, O_VR = O_K + 64 * KP, O_VS = O_VR + 64 * VP, O_CT = O_VS + 64 * VP, O_P = O_CT + 65 * QP, O_SC = O_P + 64 * TP;
    constexpr int SC_PAR = 1280;
    constexpr int O_DEN = O_SC + 2 * SC_PAR, O_MISC = O_DEN + 256, O_RAW = O_MISC + 64;
    static_assert(O_RAW + 2048 <= LDS_BYTES - 16, "mlstm LDS map");
    const bf16_t* QKV = (const bf16_t*)(F.ws + WS_R1); const f32x4* gsc = (const f32x4*)(F.ws + WS_GSC);
    LAS unsigned char* lds = F.lds;
    const int tid = F.tid, lane = F.lane, w = F.wave, r16 = lane & 15, g = lane >> 4;
    const int jh = w & 1, mg = w >> 1; const bool isS = mg < 2; const int nmt = mg == 3 ? 3 : 2;
    for (int un = F.bid; un < 256; un += F.G) {
        const int xcd = un & 7, q = un >> 3, seq = xcd * 8 + (q >> 2), es = q & 3;
        const int b = seq >> 3, h = (seq >> 1) & 3, dir = seq & 1;
        bf16_t* HO = (bf16_t*)(F.ws + (dir ? WS_HB : WS_HF));
        __syncthreads();
        for (int i = tid; i < 65 * QP / 4; i += NTHREADS) ((LAS unsigned*)(lds + O_CT))[i] = 0u;
        if (tid < 64) {
            LAS unsigned short* vr = (LAS unsigned short*)(lds + O_VR + tid * VP + 128); LAS unsigned short* vs = (LAS unsigned short*)(lds + O_VS + tid * VP + 128);
            unsigned one16 = 0x3F80u, zero16 = 0u; asm volatile("" : "+v"(one16), "+v"(zero16));
#pragma unroll
            for (int c = 0; c < 16; ++c) { vr[c] = c == 0 ? (unsigned short)one16 : (unsigned short)zero16; vs[c] = (unsigned short)zero16; } }
        f32x4 accC[2][5];
#pragma unroll
        for (int a = 0; a < 2; ++a)
#pragma unroll
            for (int e = 0; e < 5; ++e) accC[a][e] = (f32x4){0.f, 0.f, 0.f, 0.f};
        float m_st = 0.f;
        u32x4 rq[4], rk[4], rv; f32x4 gs4 = {0.f, 0.f, 0.f, 0.f}; int row0n = 0;
#define ML_LOAD(step_) do { const int _st = (step_); const bool _ic = _st < 4; const int _ci = _ic ? _st : _st - 4, _n = _ic ? 4 : 64, _ca = dir ? (_n - 1 - _ci) : _ci; \
        row0n = _ic ? (NL + b * CTXL + _ca * 64) : (b * SEQ + _ca * 64); \
        _Pragma("unroll") for (int o = 0; o < 4; ++o) { const int idx = tid + o * NTHREADS, r = idx >> 5, c8 = (idx & 31) * 8; \
            rq[o] = *(const u32x4*)(QKV + (size_t)(row0n + r) * NQKV + h * 256 + c8); rk[o] = *(const u32x4*)(QKV + (size_t)(row0n + r) * NQKV + 1024 + h * 256 + c8); } \
        rv = *(const u32x4*)(QKV + (size_t)(row0n + (tid >> 3)) * NQKV + 2048 + h * 256 + es * 64 + (tid & 7) * 8); } while (0)
#define ML_SCAL(par_) do { LAS float* sp = (LAS float*)(lds + O_SC + (par_) * SC_PAR); const int lastr = dir ? 0 : 63; \
        const f32x4 g4 = *(const LAS f32x4*)(lds + O_RAW + (par_) * 1024 + lane * 16); const float a_ = g4[0], bcum = g4[1], pmax = g4[2]; \
        const float blast = __int_as_float(__builtin_amdgcn_readlane(__float_as_int(bcum), lastr)), gmax = blast + __int_as_float(__builtin_amdgcn_readlane(__float_as_int(pmax), lastr)); \
        const float mj = fmaxf(m_st, pmax), mnew = fmaxf(blast + m_st, gmax); \
        sp[lane] = a_; sp[64 + lane] = mj; sp[128 + lane] = __expf(m_st - mj); sp[192 + lane] = __expf(-(bcum + mj)); sp[256 + lane] = __expf(blast + a_ - mnew); \
        if (lane == 0) ((LAS float*)(lds + O_MISC))[(par_)] = __expf(blast + m_st - mnew); m_st = mnew; } while (0)
#define ML_STORE() do { _Pragma("unroll") for (int jt = 0; jt < 2; ++jt) \
        *(u32x4*)(HO + (size_t)(prow0 + jh * 32 + jt * 16 + r16) * DM + h * 256 + es * 64 + (mg - 2) * 32 + 8 * g) = (u32x4){pow_[jt][0].x, pow_[jt][0].y, pow_[jt][1].x, pow_[jt][1].y}; } while (0)
        u32x2 pow_[2][2]; bool pend = false; int prow0 = 0;
#define ML_ROW0(step_) (((step_) < 4) ? (NL + b * CTXL + (dir ? (3 - (step_)) : (step_)) * 64) : (b * SEQ + (dir ? (63 - ((step_) - 4)) : ((step_) - 4)) * 64))
        gs4 = gsc[((size_t)(ML_ROW0(0) >> 6) * 8 + dir * 4 + h) * 64 + lane];
        if (w == 0) *(LAS f32x4*)(lds + O_RAW + lane * 16) = gs4;
        gs4 = gsc[((size_t)(ML_ROW0(1) >> 6) * 8 + dir * 4 + h) * 64 + lane];
        ML_LOAD(0);
        if (w == 0) ML_SCAL(0);
        LDS_BARRIER();
        for (int step = 0; step < 68; ++step) {
            const int p = step & 1; const int row0 = row0n; const bool wr_out = (step >= 4) || (l == 0);
            const LAS float* sp = (const LAS float*)(lds + O_SC + p * SC_PAR);
#pragma unroll
            for (int o = 0; o < 4; ++o) { const int idx = tid + o * NTHREADS, r = idx >> 5, c8 = (idx & 31) * 8;
                *(LAS u32x4*)(lds + O_Q + r * QP + c8 * 2) = rq[o]; *(LAS u32x4*)(lds + O_K + r * KP + c8 * 2) = rk[o]; }
            {
              const int vs_ = tid >> 3, c8 = (tid & 7) * 8, cl = (c8 & 32) + ((c8 >> 3) & 3) * 4; const float wks = sp[256 + vs_];
              u32x2 lo, hi; lo.x = rv.x; lo.y = rv.y; hi.x = rv.z; hi.y = rv.w;
              *(LAS u32x2*)(lds + O_VR + vs_ * VP + cl * 2) = lo; *(LAS u32x2*)(lds + O_VR + vs_ * VP + (cl + 16) * 2) = hi;
              u32x2 slo, shi; slo.x = cvt_pk_bf16(bf_lo(rv.x) * wks, bf_hi(rv.x) * wks); slo.y = cvt_pk_bf16(bf_lo(rv.y) * wks, bf_hi(rv.y) * wks);
              shi.x = cvt_pk_bf16(bf_lo(rv.z) * wks, bf_hi(rv.z) * wks); shi.y = cvt_pk_bf16(bf_lo(rv.w) * wks, bf_hi(rv.w) * wks);
              *(LAS u32x2*)(lds + O_VS + vs_ * VP + cl * 2) = slo; *(LAS u32x2*)(lds + O_VS + vs_ * VP + (cl + 16) * 2) = shi;
              if ((tid & 7) == 0) *(LAS unsigned short*)(lds + O_VS + vs_ * VP + 128) = f2bf(wks); }
            if (w == 0) *(LAS f32x4*)(lds + O_RAW + (p ^ 1) * 1024 + lane * 16) = gs4;
            { const int sn = step + 2 < 68 ? step + 2 : 67; gs4 = gsc[((size_t)(ML_ROW0(sn) >> 6) * 8 + dir * 4 + h) * 64 + lane]; }
            LDS_BARRIER();
            if (pend) { ML_STORE(); pend = false; }
            if (step + 1 < 68) ML_LOAD(step + 1);
            f32x4 acc[3][2];
#pragma unroll
            for (int t = 0; t < 3; ++t) { acc[t][0] = (f32x4){0.f, 0.f, 0.f, 0.f}; acc[t][1] = acc[t][0]; }
            if (wr_out) { const int apitch = isS ? KP : QP;            const int abase = (isS ? O_K + mg * 32 * KP : O_CT + (mg - 2) * 32 * QP) + r16 * apitch + g * 16;
              const int qbase = O_Q + (jh * 32 + r16) * QP + g * 16;
#pragma unroll
              for (int ks = 0; ks < 8; ++ks) {
                  const bf16x8 b0 = *(const LAS bf16x8*)(lds + qbase + ks * 64), b1 = *(const LAS bf16x8*)(lds + qbase + 16 * QP + ks * 64);
                  const bf16x8 a0 = *(const LAS bf16x8*)(lds + abase + ks * 64), a1 = *(const LAS bf16x8*)(lds + abase + 16 * apitch + ks * 64);
                  acc[0][0] = __builtin_amdgcn_mfma_f32_16x16x32_bf16(a0, b0, acc[0][0], 0, 0, 0); acc[0][1] = __builtin_amdgcn_mfma_f32_16x16x32_bf16(a0, b1, acc[0][1], 0, 0, 0);
                  acc[1][0] = __builtin_amdgcn_mfma_f32_16x16x32_bf16(a1, b0, acc[1][0], 0, 0, 0); acc[1][1] = __builtin_amdgcn_mfma_f32_16x16x32_bf16(a1, b1, acc[1][1], 0, 0, 0);
                  if (nmt == 3) { const bf16x8 a2 = *(const LAS bf16x8*)(lds + abase + 32 * apitch + ks * 64);
                      acc[2][0] = __builtin_amdgcn_mfma_f32_16x16x32_bf16(a2, b0, acc[2][0], 0, 0, 0); acc[2][1] = __builtin_amdgcn_mfma_f32_16x16x32_bf16(a2, b1, acc[2][1], 0, 0, 0); } } }
            if (isS && wr_out) {
#pragma unroll
                for (int t = 0; t < 2; ++t) { const int s0 = mg * 32 + t * 16 + 4 * g; const f32x4 as = *(const LAS f32x4*)(sp + s0);
#pragma unroll
                    for (int jt = 0; jt < 2; ++jt) { const int j = jh * 32 + jt * 16 + r16; const float mjj = sp[64 + j]; float pv[4];
#pragma unroll
                        for (int i = 0; i < 4; ++i) { const int s = s0 + i; const bool ok = dir ? (s >= j) : (s <= j); pv[i] = ok ? acc[t][jt][i] * __expf(as[i] - mjj) : 0.f; }
                        u32x2 pw; pw.x = cvt_pk_bf16(pv[0], pv[1]); pw.y = cvt_pk_bf16(pv[2], pv[3]);
                        *(LAS u32x2*)(lds + O_P + j * TP + s0 * 2) = pw; } }
            }
            LDS_BARRIER();
            if (!isS) { if (wr_out) {
#pragma unroll
                for (int jt = 0; jt < 2; ++jt) { const float wi = sp[128 + jh * 32 + jt * 16 + r16];
#pragma unroll
                    for (int t = 0; t < 3; ++t) acc[t][jt] *= wi; }
                const int et0 = (mg - 2) * 2, pbase = O_P + (jh * 32 + r16) * TP + g * 16;
#pragma unroll
                for (int ks = 0; ks < 2; ++ks) {
                    const bf16x8 b0 = *(const LAS bf16x8*)(lds + pbase + ks * 64), b1 = *(const LAS bf16x8*)(lds + pbase + 16 * TP + ks * 64);
                    const bf16x8 a0 = tr_frag(lds + O_VR, VP, ks, et0, lane), a1 = tr_frag(lds + O_VR, VP, ks, et0 + 1, lane);
                    acc[0][0] = __builtin_amdgcn_mfma_f32_16x16x32_bf16(a0, b0, acc[0][0], 0, 0, 0); acc[0][1] = __builtin_amdgcn_mfma_f32_16x16x32_bf16(a0, b1, acc[0][1], 0, 0, 0);
                    acc[1][0] = __builtin_amdgcn_mfma_f32_16x16x32_bf16(a1, b0, acc[1][0], 0, 0, 0); acc[1][1] = __builtin_amdgcn_mfma_f32_16x16x32_bf16(a1, b1, acc[1][1], 0, 0, 0);
                    if (nmt == 3) { const bf16x8 a2 = tr_frag(lds + O_VR, VP, ks, et0 + 2, lane);
                        acc[2][0] = __builtin_amdgcn_mfma_f32_16x16x32_bf16(a2, b0, acc[2][0], 0, 0, 0); acc[2][1] = __builtin_amdgcn_mfma_f32_16x16x32_bf16(a2, b1, acc[2][1], 0, 0, 0); } }
                if (mg == 3 && g == 0) { LAS float* dn = (LAS float*)(lds + O_DEN); dn[jh * 32 + r16] = acc[2][0][0]; dn[jh * 32 + 16 + r16] = acc[2][1][0]; } }
            } else if (w == 0 && step + 1 < 68) { ML_SCAL(p ^ 1); }
            { const float wc = ((const LAS float*)(lds + O_MISC))[p];
#pragma unroll
              for (int a = 0; a < 2; ++a)
#pragma unroll
                  for (int e = 0; e < 5; ++e) accC[a][e] *= wc;
#pragma unroll
              for (int ks = 0; ks < 2; ++ks) {
                  bf16x8 bv[5];
#pragma unroll
                  for (int e = 0; e < 5; ++e) bv[e] = tr_frag(lds + O_VS, VP, ks, e, lane);
#pragma unroll
                  for (int a = 0; a < 2; ++a) { const bf16x8 ka = tr_frag(lds + O_K, KP, ks, w * 2 + a, lane);
#pragma unroll
                      for (int e = 0; e < 5; ++e) accC[a][e] = __builtin_amdgcn_mfma_f32_16x16x32_bf16(ka, bv[e], accC[a][e], 0, 0, 0); } } }
            LDS_BARRIER();
#pragma unroll
            for (int a = 0; a < 2; ++a)
#pragma unroll
                for (int e = 0; e < 5; ++e) { const int er = e * 16 + r16;
                    if (er <= 64) { u32x2 cw; cw.x = cvt_pk_bf16(accC[a][e][0], accC[a][e][1]); cw.y = cvt_pk_bf16(accC[a][e][2], accC[a][e][3]);
                        *(LAS u32x2*)(lds + O_CT + er * QP + ((w * 2 + a) * 16 + 4 * g) * 2) = cw; } }
            pend = !isS && wr_out; prow0 = row0;
            if (pend) {
#pragma unroll
                for (int jt = 0; jt < 2; ++jt) { const int j = jh * 32 + jt * 16 + r16;
                    const float den = ((const LAS float*)(lds + O_DEN))[j]; const float inv = __builtin_amdgcn_rcpf(fmaxf(fabsf(den), sp[192 + j]));
#pragma unroll
                    for (int t = 0; t < 2; ++t) { pow_[jt][t].x = cvt_pk_bf16(acc[t][jt][0] * inv, acc[t][jt][1] * inv); pow_[jt][t].y = cvt_pk_bf16(acc[t][jt][2] * inv, acc[t][jt][3] * inv); } }
            }
        }
        if (pend) { ML_STORE(); pend = false; }
#undef ML_LOAD
#undef ML_ROW0
#undef ML_SCAL
#undef ML_STORE
    }
}

__device__ __forceinline__ void post_phase(const Frame& F, int l) {
    const int M = l == 0 ? MT : NL;
    bf16_t* AC = (bf16_t*)(F.ws + WS_ACAT); const bf16_t* HF = (const bf16_t*)(F.ws + WS_HF); const bf16_t* HB = (const bf16_t*)(F.ws + WS_HB); const unsigned char* ZS = (const unsigned char*)(F.ws + WS_ZS); const bf16_t* ZP = (const bf16_t*)(F.ws + WS_ZP);
    const float* hg = F.in(I_HGAIN) + l * DM;
    u32x2 pa[4], pb[4]; unsigned po[4];
    f32x4 hgv[4];
#pragma unroll
    for (int hh = 0; hh < 4; ++hh) hgv[hh] = *(const f32x4*)(hg + hh * 256 + F.lane * 4);
    { const int row = F.bid * 8 + F.wave;
      if (row < M) {
#pragma unroll
          for (int hh = 0; hh < 4; ++hh) { const int k = hh * 256 + F.lane * 4;
              pa[hh] = *(const u32x2*)(HF + (size_t)row * DM + k); pb[hh] = *(const u32x2*)(HB + (size_t)row * DM + k); po[hh] = *(const unsigned*)(ZS + (size_t)row * 3072 + k); } } }
    for (int row = F.bid * 8 + F.wave; row < M; row += F.G * 8) {
        u32x2 ca[4], cb[4]; unsigned co[4];
#pragma unroll
        for (int hh = 0; hh < 4; ++hh) { ca[hh] = pa[hh]; cb[hh] = pb[hh]; co[hh] = po[hh]; }
        { const int rn = row + F.G * 8;
          if (rn < M) {
#pragma unroll
              for (int hh = 0; hh < 4; ++hh) { const int k = hh * 256 + F.lane * 4;
                  pa[hh] = *(const u32x2*)(HF + (size_t)rn * DM + k); pb[hh] = *(const u32x2*)(HB + (size_t)rn * DM + k); po[hh] = *(const unsigned*)(ZS + (size_t)rn * 3072 + k); } } }
#pragma unroll
        for (int hh = 0; hh < 4; ++hh) { const int k = hh * 256 + F.lane * 4;
            const u32x2 a = ca[hh], b = cb[hh]; const unsigned o = co[hh];
            f32x4 x = (f32x4){bf_lo(a.x) + bf_lo(b.x), bf_hi(a.x) + bf_hi(b.x), bf_lo(a.y) + bf_lo(b.y), bf_hi(a.y) + bf_hi(b.y)};
            const float mu = wave_sum(x[0] + x[1] + x[2] + x[3], F.lane) * (1.0f / 256.0f);
            x -= mu;
            const float var = wave_sum(x[0] * x[0] + x[1] * x[1] + x[2] * x[2] + x[3] * x[3], F.lane) * (1.0f / 256.0f);
            const float rs = rsqrtf(var + EPS);
            const f32x4 g4 = hgv[hh], so = unpack4_u8(o);
            x = so * ((x * rs) * g4);
            u32x2 w; w.x = cvt_pk_bf16(x[0], x[1]); w.y = cvt_pk_bf16(x[2], x[3]);
            *(u32x2*)(AC + (size_t)row * KCAT + k) = w; }
    }
    bf16_t* PO = AC + 1024;
    LAS float* Vs = (LAS float*)F.lds;
    constexpr int VP = 132;
    const int nun = 8 * 64 * 4 + (l == 0 ? 8 * 4 * 4 : 0);
    const int c = F.tid >> 3, q = F.tid & 7;
    for (int un = F.bid; un < nun; un += F.G) {
        float xc[16]; int lo, hi, nrow; size_t orow;
        if (un < 2048) {
            const int b = un >> 8, gr = (un >> 2) & 63, g = (un + (un >> 8)) & 3, hw = 1 << g;
            const int rlo = (gr - hw) > 0 ? (gr - hw) : 0, rhi = (gr + hw) < 64 ? (gr + hw) : 64;
            float vs[16];
#pragma unroll
            for (int i = 0; i < 16; ++i) vs[i] = 0.f;
#define POOL_ROWS(NB) \
            for (int r4 = rlo; r4 < rhi; r4 += NB) {        \
                u32x4 w0[NB], w1[NB]; \
                _Pragma("unroll") \
                for (int k = 0; k < NB; ++k) { const int r = (r4 + k) < rhi ? (r4 + k) : (rhi - 1); const bf16_t* p = ZP + (size_t)(b * SEQ + r * 64 + c) * 512 + g * 128 + q * 16; \
                    w0[k] = *(const u32x4*)p; w1[k] = *(const u32x4*)(p + 8); } \
                _Pragma("unroll") \
                for (int k = 0; k < NB; ++k) { if (r4 + k < rhi) { f32x4 f0, f1, f2, f3; unpack8(w0[k], f0, f1); unpack8(w1[k], f2, f3); \
                    _Pragma("unroll") \
                    for (int i = 0; i < 4; ++i) { vs[i] += f0[i]; vs[4 + i] += f1[i]; vs[8 + i] += f2[i]; vs[12 + i] += f3[i]; } \
                    if (r4 + k == gr) { \
                        _Pragma("unroll") \
                        for (int i = 0; i < 4; ++i) { xc[i] = f0[i]; xc[4 + i] = f1[i]; xc[8 + i] = f2[i]; xc[12 + i] = f3[i]; } } } } }
            if (g >= 2) { POOL_ROWS(8) } else { POOL_ROWS(4) }
#undef POOL_ROWS
#pragma unroll
            for (int i = 0; i < 4; ++i) *(LAS f32x4*)(Vs + (c + 8) * VP + q * 16 + i * 4) = (f32x4){vs[i * 4], vs[i * 4 + 1], vs[i * 4 + 2], vs[i * 4 + 3]};
            nrow = rhi - rlo; lo = (c - hw) > 0 ? (c - hw) : 0; hi = (c + hw) < 64 ? (c + hw) : 64; lo += 8; hi += 8;
            orow = (size_t)(b * SEQ + gr * 64 + c);
        } else {
            const int u2 = un - 2048, b = u2 >> 4, tb = (u2 >> 2) & 3, g = u2 & 3, hw = 1 << g, t0 = tb * 64;
            for (int pp = c; pp < 80; pp += 64) { const int t = t0 - 8 + pp; f32x4 f0 = {0.f, 0.f, 0.f, 0.f}, f1 = f0, f2 = f0, f3 = f0;
                if (t >= 0 && t < CTXL) { const bf16_t* p = ZP + (size_t)(NL + b * CTXL + t) * 512 + g * 128 + q * 16;
                    unpack8(*(const u32x4*)p, f0, f1); unpack8(*(const u32x4*)(p + 8), f2, f3); }
                *(LAS f32x4*)(Vs + pp * VP + q * 16) = f0; *(LAS f32x4*)(Vs + pp * VP + q * 16 + 4) = f1; *(LAS f32x4*)(Vs + pp * VP + q * 16 + 8) = f2; *(LAS f32x4*)(Vs + pp * VP + q * 16 + 12) = f3;
                }
            { const int t = t0 + c; const bf16_t* p = ZP + (size_t)(NL + b * CTXL + t) * 512 + g * 128 + q * 16; f32x4 f0, f1, f2, f3;
              unpack8(*(const u32x4*)p, f0, f1); unpack8(*(const u32x4*)(p + 8), f2, f3);
#pragma unroll
              for (int i = 0; i < 4; ++i) { xc[i] = f0[i]; xc[4 + i] = f1[i]; xc[8 + i] = f2[i]; xc[12 + i] = f3[i]; }
              const int tlo = (t - hw) > 0 ? (t - hw) : 0, thi = (t + hw) < CTXL ? (t + hw) : CTXL;
              lo = tlo - t0 + 8; hi = thi - t0 + 8; nrow = 1; orow = (size_t)(NL + b * CTXL + t); }
        }
        LDS_BARRIER();
        { float sm[16];
#pragma unroll
          for (int i = 0; i < 16; ++i) sm[i] = 0.f;
          for (int pp = lo; pp < hi; ++pp) {
#pragma unroll
              for (int i = 0; i < 4; ++i) { const f32x4 f = *(const LAS f32x4*)(Vs + pp * VP + q * 16 + i * 4); sm[i * 4] += f[0]; sm[i * 4 + 1] += f[1]; sm[i * 4 + 2] += f[2]; sm[i * 4 + 3] += f[3]; } }
          const float inv = 1.0f / (float)(nrow * (hi - lo));
          const int g = un < 2048 ? ((un + (un >> 8)) & 3) : ((un - 2048) & 3);
          u32x4 w0, w1;
          w0.x = cvt_pk_bf16(sm[0] * inv - xc[0], sm[1] * inv - xc[1]); w0.y = cvt_pk_bf16(sm[2] * inv - xc[2], sm[3] * inv - xc[3]);
          w0.z = cvt_pk_bf16(sm[4] * inv - xc[4], sm[5] * inv - xc[5]); w0.w = cvt_pk_bf16(sm[6] * inv - xc[6], sm[7] * inv - xc[7]);
          w1.x = cvt_pk_bf16(sm[8] * inv - xc[8], sm[9] * inv - xc[9]); w1.y = cvt_pk_bf16(sm[10] * inv - xc[10], sm[11] * inv - xc[11]);
          w1.z = cvt_pk_bf16(sm[12] * inv - xc[12], sm[13] * inv - xc[13]); w1.w = cvt_pk_bf16(sm[14] * inv - xc[14], sm[15] * inv - xc[15]);
          bf16_t* op = PO + orow * KCAT + g * 128 + q * 16;
          *(u32x4*)op = w0; *(u32x4*)(op + 8) = w1; }
        LDS_BARRIER();
    }
}

constexpr int PH_FINAL = 49, PH_END = 50;
struct Args { const float* in[25]; float* out; unsigned char* ws; int ph_lo, ph_hi; };
extern __shared__ __attribute__((aligned(16))) unsigned char lds_raw[];

__device__ __forceinline__ int lane_id_volatile() { int l_; asm volatile("v_mbcnt_lo_u32_b32 %0, -1, 0\n\tv_mbcnt_hi_u32_b32 %0, -1, %0" : "=v"(l_)); return l_; }
__device__ __forceinline__ Frame make_frame(const int wv) {
    Frame F;
    F.out = (float*)karg_in(25); F.ws = (unsigned char*)karg_in(26); F.ctl = (unsigned*)(F.ws + WS_CTL); F.lds = (LAS unsigned char*)lds_raw;
    int tid = wv * 64 + lane_id_volatile(), bid = blockIdx.x, G = gridDim.x;
    asm volatile("" : "+v"(tid)); asm volatile("" : "+s"(bid)); asm volatile("" : "+s"(G));
    F.G = G; F.bid = bid; F.tid = tid; F.lane = tid & 63; F.wave = __builtin_amdgcn_readfirstlane(tid >> 6);
    return F;
}
#if MK_MULTI
#define PHASE_FN __device__ __forceinline__
#else
#define PHASE_FN __device__ __forceinline__
#endif
#define UNI(x) __builtin_amdgcn_readfirstlane(x)
PHASE_FN void ph_prologue(const int wv) { const Frame F = make_frame(wv); prologue_phase(F); }
PHASE_FN void ph_norm(const int wv, int l, int which) { const Frame F = make_frame(wv); l = UNI(l); which = UNI(which); if (l == 0 && which == 0) norm_phase<true>(F, l, which); else norm_phase<false>(F, l, which); }
PHASE_FN void ph_norm2x(const int wv, int l) { const Frame F = make_frame(wv); l = UNI(l); norm_phase<false>(F, l, l == 0 ? 1 : 2); if (l == 1) expert_convert(F, (LAS float*)(F.lds + 81920)); }
PHASE_FN void ph_gemm_a(const int wv, int l) { const Frame F = make_frame(wv); l = UNI(l);
    SchedDense S{(const char*)(F.ws + WS_R0), (const char*)(F.ws + WS_WQKV) + (size_t)l * NQKV * DM * 2, DM * 2, DM * 2, MT / 256, NQKV / 256, F.G, F.bid};
    EpiQKV E{(bf16_t*)(F.ws + WS_R1), (bf16_t*)(F.ws + WS_HALO)};
    gp::gemm_phase<0>(F.lds, DM * 2, S, E, F.tid); }
PHASE_FN void ph_prep(const int wv, int l) { const Frame F = make_frame(wv); prep_phase(F, UNI(l)); }
#ifndef MLSTM_REF
#define MLSTM_REF 0
#endif
PHASE_FN void ph_mlstm(const int wv, int l) { const Frame F = make_frame(wv);
#if MLSTM_REF
    mlstm_phase_ref(F, UNI(l));
#else
#if MLSTM_TR
    mlstm_phase_tr(F, UNI(l));
#else
    mlstm_phase_mfma(F, UNI(l));
#endif
#endif
}
PHASE_FN void ph_gemm_b(const int wv, int l) { const Frame F = make_frame(wv); l = UNI(l); const int M = l == 0 ? MT : NL;
    SchedDense S{(const char*)(F.ws + WS_R0), (const char*)(F.ws + WS_WB) + (size_t)l * NZB * DM * 2, DM * 2, DM * 2, M / 256, NZB / 256, F.G, (F.bid + F.G / 2) % F.G};
    EpiZB E{(unsigned char*)(F.ws + WS_ZS), (bf16_t*)(F.ws + WS_ZP)};
    gp::gemm_phase<0>(F.lds, DM * 2, S, E, F.tid); }
PHASE_FN void ph_post(const int wv, int l) { const Frame F = make_frame(wv); post_phase(F, UNI(l)); }
PHASE_FN void ph_merge1(const int wv, int l) { const Frame F = make_frame(wv); l = UNI(l); const int M = l == 0 ? MT : NL;
    WithDep<SchedDenseT<(DEPMASK & 1u) != 0>, (DEPMASK & 1u) ? 1 : 0> S{{(const char*)(F.ws + WS_ACAT), (const char*)(F.ws + WS_WCAT) + (size_t)l * DM * KCAT * 2, KCAT * 2, KCAT * 2, M / 256, DM / 256, F.G, F.bid}, CW_DEP_MERGE + l * 256, 0u};
    EpiMerge E{(bf16_t*)(F.ws + WS_R0), (const unsigned char*)(F.ws + WS_ZS)};
    gp::gemm_phase<0>(F.lds, KCAT * 2, S, E, F.tid); }
PHASE_FN void ph_merge2(const int wv, int l) { (void)wv; (void)l; }
PHASE_FN void ph_out(const int wv, int l) { const Frame F = make_frame(wv); l = UNI(l); const int M = l == 0 ? MT : NL;
    const float* modl = (const float*)(F.ws + WS_MOD) + (size_t)l * 9 * 6144;
    WithDep<SchedDenseT<(DEPMASK & 1u) != 0>, (DEPMASK & 1u) ? 2 : 0> S{{(const char*)(F.ws + WS_R0), (const char*)(F.ws + WS_WOUT) + (size_t)l * DM * DM * 2, DM * 2, DM * 2, M / 256, DM / 256, F.G, (F.bid + F.G / 2) % F.G}, CW_DEP_MERGE + l * 256, 32u};
    bf16_t* H = (bf16_t*)F.out; bf16_t* HC = (bf16_t*)(F.ws + WS_HC16);
    if (l == 0) { EpiResid<true> E{F.in(I_X), H, F.in(I_CTX), HC, modl, MOD_GT1, 1.0f}; gp::gemm_phase<0>(F.lds, DM * 2, S, E, F.tid); }
    else { EpiResid<false> E{H, H, HC, HC, modl, MOD_GT1, 1.0f}; gp::gemm_phase<0>(F.lds, DM * 2, S, E, F.tid); } }
PHASE_FN void ph_ffn1(const int wv) { const Frame F = make_frame(wv);
    constexpr int ES = FP8_DENSE ? 1 : 2;
    WithDep<SchedDenseT<(DEPMASK & 2u) != 0>, (DEPMASK & 2u) ? 1 : 0> S{{(const char*)(F.ws + WS_R0), (const char*)(F.ws + WS_WFGU), DM * ES, DM * ES, MT / 256, 2 * DFF / 256, F.G, F.bid}, CW_DEP_FFN, 0u};
    EpiSwiglu<(FP8_DENSE || FP8_FFN2)> E{(unsigned char*)(F.ws + WS_ACT), DFF * ((FP8_DENSE || FP8_FFN2) ? 1 : 2), FP8_DENSE ? WSCALE_INV : 1.0f};
    gp::gemm_phase<FP8_DENSE>(F.lds, DM * ES, S, E, F.tid); }
PHASE_FN void ph_ffn2(const int wv) { const Frame F = make_frame(wv);
    constexpr int F8 = (FP8_DENSE || FP8_FFN2) ? 1 : 0, ES = F8 ? 1 : 2;
    const float* modl = (const float*)(F.ws + WS_MOD);
    WithDep<SchedDenseT<(DEPMASK & 2u) != 0>, (DEPMASK & 2u) ? 2 : 0> S{{(const char*)(F.ws + WS_ACT), (const char*)(F.ws + WS_WFD), DFF * ES, DFF * ES, MT / 256, DM / 256, F.G, (F.bid + 80) % F.G}, CW_DEP_FFN, (unsigned)(2 * DFF / 256) * 8u};
    bf16_t* H = (bf16_t*)F.out; bf16_t* HC = (bf16_t*)(F.ws + WS_HC16);
    EpiResid<false> E{H, H, HC, HC, modl, MOD_GT2, F8 ? WSCALE_INV : 1.0f};
    gp::gemm_phase<F8>(F.lds, DFF * ES, S, E, F.tid); }
PHASE_FN void ph_moe1(const int wv, int r) { const Frame F = make_frame(wv); r = UNI(r);
    constexpr int ES = FP8_MOE ? 1 : 2;
    const int ttot = moe_build_table(F); int ntile = ttot - r * MOE_RT; ntile = ntile > MOE_RT ? MOE_RT : ntile;
    WithDep<SchedMoe1, (DEPMASK & 4u) ? 1 : 0> S{{(const char*)(F.ws + WS_R0), (const char*)(F.ws + WS_WEGU), (const int*)(F.ws + WS_RLIST), (LAS const int*)(F.lds + LDS_MOE_TAB), DM * ES, DM * ES, F.G, F.bid, r * MOE_RT, ntile}, CW_DEP_MOE, 0u};
    EpiSwiglu<FP8_MOE> E{(unsigned char*)(F.ws + WS_MACT + (size_t)(r & 1) * (MACT_BYTES / (FP8_MOE ? 2 : 1))), DFE * ES, FP8_MOE ? WSCALE_INV : 1.0f};
    gp::gemm_phase<FP8_MOE>(F.lds, DM * ES, S, E, F.tid); }
PHASE_FN void ph_moe2(const int wv, int r) { const Frame F = make_frame(wv); r = UNI(r);
    constexpr int ES = FP8_MOE ? 1 : 2;
    const int ttot = moe_build_table(F); int ntile = ttot - r * MOE_RT; ntile = ntile > MOE_RT ? MOE_RT : ntile;
    WithDep<SchedMoe2, (DEPMASK & 4u) ? 2 : 0> S{{(const char*)(F.ws + WS_MACT + (size_t)(r & 1) * (MACT_BYTES / (FP8_MOE ? 2 : 1))), (const char*)(F.ws + WS_WED), (LAS const int*)(F.lds + LDS_MOE_TAB), DFE * ES, DFE * ES, F.G, (F.bid + 168) % F.G, r * MOE_RT, ntile}, CW_DEP_MOE, (unsigned)(DFE / 128) * 8u};
    EpiMoe2 E{(bf16_t*)(F.ws + WS_Y), (const int*)(F.ws + WS_RLIST), (const float*)(F.ws + WS_RPROB), FP8_MOE ? WSCALE_INV : 1.0f};
    gp::gemm_phase<FP8_MOE>(F.lds, DFE * ES, S, E, F.tid); }
PHASE_FN void ph_final(const int wv) { const Frame F = make_frame(wv); final_phase(F); }

__device__ __forceinline__ void grid_sync(const int wv) {
    const bool thread0 = (wv == 0) && (lane_id_volatile() == 0);
    XcdBarrier b; b.bar = (unsigned*)((unsigned char*)karg_in(26) + WS_CTL) + CW_BAR; b.x = xb_xcc_id();
    b.st = (volatile LAS unsigned*)((LAS unsigned char*)lds_raw + LDS_BYTES - 16);
    xcd_barrier(b, thread0);
}
__device__ __forceinline__ void split_arrive(const int wv, int l) {
    if (wv == 0 && lane_id_volatile() == 0) { __builtin_amdgcn_fence(__ATOMIC_RELEASE, "agent"); asm volatile("s_waitcnt vmcnt(0)" ::: "memory");
        (void)xb_add((unsigned*)((unsigned char*)karg_in(26) + WS_CTL) + CW_SPLIT + l, 1u); }
}
__device__ __forceinline__ void split_wait(const int wv, int l) {
    if (wv == 0 && lane_id_volatile() == 0) { unsigned* p = (unsigned*)((unsigned char*)karg_in(26) + WS_CTL) + CW_SPLIT + l; unsigned sp = 0;
        while (xb_ld(p) < gridDim.x) { __builtin_amdgcn_s_sleep(2); if (++sp > (1u << 20)) break; } }
    __syncthreads();
}
#ifndef REPMASK
#define REPMASK 0u
#endif
#ifndef DEPMASK
#define DEPMASK 7u
#endif
#define RP(k) (((REPMASK >> (k)) & 1u) ? 2 : 1)
template <unsigned PMASK>
__global__ void __launch_bounds__(NTHREADS, 2) fwd_kernel(Args args) {
    unsigned* ctl = (unsigned*)(args.ws + WS_CTL);
    volatile LAS unsigned* bst = (volatile LAS unsigned*)((LAS unsigned char*)lds_raw + LDS_BYTES - 16);
    const int wv = __builtin_amdgcn_readfirstlane((int)(threadIdx.x >> 6));
    if (threadIdx.x < 4) bst[threadIdx.x] = 0u;
    if (threadIdx.x == 0 && (xb_xcc_id() != (blockIdx.x % gp::NXCD) || gridDim.x < gp::NXCD)) (void)xb_add(ctl + CW_NONCANON, 1u);
    __syncthreads();
    const int lo = args.ph_lo, hi = args.ph_hi;
    const bool single = (hi - lo) > 1;
    if (single) (void)xcd_barrier_post(ctl + CW_BAR, bst);
#define IN(k) (lo <= (k) && (k) < hi)
#define PK(b) ((PMASK >> (b)) & 1u)
#define SEAM(k) do { if (IN((k) + 1) && single) grid_sync(wv); } while (0)

    if (PK(0) && IN(0)) { for (int rep = 0; rep < RP(0); ++rep) { if (rep) __syncthreads(); ph_prologue(wv); } SEAM(0); }
    if (single) { if (threadIdx.x == 0) bst[2] = xb_ld(ctl + CW_NONCANON); __syncthreads(); }
#define DEP_SEAM(bit, k) do { if (!(DEPMASK & (bit)) || bst[2] != 0u) SEAM(k); } while (0)

    for (int l = 0; l < 2; ++l) {
        const int pb = 1 + 24 * l;
        if (hi <= pb || lo >= pb + 24) continue;
        if (PK(1) && IN(pb + 0)) { for (int rep = 0; rep < RP(1); ++rep) { if (rep) __syncthreads(); ph_norm(wv, l, 0); } SEAM(pb + 0); }
        if (PK(2) && IN(pb + 1)) { for (int rep = 0; rep < RP(2); ++rep) { if (rep) __syncthreads(); ph_gemm_a(wv, l); if (SPLIT_PREP) split_arrive(wv, l); ph_gemm_b(wv, l); } if (!SPLIT_PREP) SEAM(pb + 1); }
        if (PK(3) && IN(pb + 2)) { if (SPLIT_PREP) split_wait(wv, l); ph_prep(wv, l); SEAM(pb + 2); }
        if (PK(4) && IN(pb + 3)) { for (int rep = 0; rep < RP(4); ++rep) { if (rep) __syncthreads(); ph_mlstm(wv, l); } SEAM(pb + 4); }
        if (PK(6) && IN(pb + 5)) { for (int rep = 0; rep < RP(6); ++rep) { if (rep) __syncthreads(); ph_post(wv, l); } SEAM(pb + 5); }
        if (PK(7) && IN(pb + 6)) { for (int rep = 0; rep < RP(7); ++rep) { if (rep) __syncthreads(); ph_merge1(wv, l); ph_merge2(wv, l); } DEP_SEAM(1u, pb + 6);   }
        if (PK(8) && IN(pb + 7)) { ph_out(wv, l); SEAM(pb + 7); }
        if (PK(9) && IN(pb + 8)) { ph_norm2x(wv, l); SEAM(pb + 8); }
        if (l == 0) {
            if (PK(10) && IN(pb + 9)) { for (int rep = 0; rep < RP(10); ++rep) { if (rep) __syncthreads(); ph_ffn1(wv); } DEP_SEAM(2u, pb + 9);   }
            if (PK(11) && IN(pb + 10)) { ph_ffn2(wv); SEAM(pb + 10); }
        } else {
            if (PK(12) && IN(pb + 11)) { for (int rep = 0; rep < RP(12); ++rep) { if (rep) __syncthreads(); ph_moe1(wv, 0); } DEP_SEAM(4u, pb + 11);   }
            for (int r = 0; r < MOE_ROUNDS; ++r) {
                if (PK(13) && IN(pb + 12 + r)) { for (int rep = 0; rep < RP(13); ++rep) { if (rep) __syncthreads(); ph_moe2(wv, r); if (r + 1 < MOE_ROUNDS) ph_moe1(wv, r + 1); }
                    if (r + 1 < MOE_ROUNDS) SEAM(pb + 12 + r); else { if (single) grid_sync(wv); } }
            }
        }
    }
    if (PK(14) && IN(PH_FINAL)) ph_final(wv);
#undef IN
#undef PK
#undef SEAM
#undef DEP_SEAM
}

extern "C" void kernel_launch(void* const* d_in, const int* in_sizes, int n_in, void* d_out, int out_size, void* d_ws, size_t ws_size, hipStream_t stream) {
    static int grid = 0;
    if (grid == 0) {
        if (n_in != 25 || out_size != NL * DM || ws_size < WS_END2) { fprintf(stderr, "kernel_launch: unexpected shapes (n_in %d out %d ws %zu need %zu)\n", n_in, out_size, ws_size, (size_t)WS_END2); grid = -1; return; }
        int dev = 0, cus = 0, per_cu = 0;
        if (hipGetDevice(&dev) != hipSuccess || hipDeviceGetAttribute(&cus, hipDeviceAttributeMultiprocessorCount, dev) != hipSuccess) { grid = -1; return; }
        const void* ks[16] = { (const void*)fwd_kernel<1u << 0>, (const void*)fwd_kernel<1u << 1>, (const void*)fwd_kernel<1u << 2>, (const void*)fwd_kernel<1u << 3>, (const void*)fwd_kernel<1u << 4>,
            (const void*)fwd_kernel<1u << 5>, (const void*)fwd_kernel<1u << 6>, (const void*)fwd_kernel<1u << 7>, (const void*)fwd_kernel<1u << 8>, (const void*)fwd_kernel<1u << 9>, (const void*)fwd_kernel<1u << 10>,
            (const void*)fwd_kernel<1u << 11>, (const void*)fwd_kernel<1u << 12>, (const void*)fwd_kernel<1u << 13>, (const void*)fwd_kernel<1u << 14>,
#if MK_MULTI
            nullptr };
#else
            (const void*)fwd_kernel<0xFFFFFFFFu> };
#endif
        for (int i = 0; i < (MK_MULTI ? 15 : 16); ++i) { if (!MK_MULTI && i < 15) continue;
            if (hipFuncSetAttribute(ks[i], hipFuncAttributeMaxDynamicSharedMemorySize, LDS_BYTES) != hipSuccess) { fprintf(stderr, "kernel_launch: hipFuncSetAttribute failed\n"); grid = -1; return; }
            if (hipOccupancyMaxActiveBlocksPerMultiprocessor(&per_cu, ks[i], NTHREADS, LDS_BYTES) != hipSuccess || per_cu < 1) { fprintf(stderr, "kernel_launch: occupancy query says %d\n", per_cu); (void)hipGetLastError(); grid = -1; return; } }
        grid = cus;
    }
    if (grid < 0) return;
    (void)in_sizes;
    (void)hipMemsetAsync((char*)d_ws + WS_CTL, 0, CTL_BYTES, stream);
    Args a{};
    for (int i = 0; i < 25; ++i) a.in[i] = (const float*)d_in[i];
    a.out = (float*)d_out; a.ws = (unsigned char*)d_ws;
#if MK_MULTI
    for (int p = 0; p < PH_END; ++p) {
        const int rel = p == 0 ? -1 : (p - 1) % 24, l = p == 0 ? -1 : (p - 1) / 24;
        int kind;
        if (p == 0) kind = 0; else if (p == PH_FINAL) kind = 14;
        else { if (l > 1) continue; if (rel == 4) continue; if (l == 0 && rel > 10) continue; if (l == 1 && (rel == 9 || rel == 10 || rel > 11 + MOE_ROUNDS)) continue;
            kind = rel <= 10 ? rel + 1 : (rel == 11 ? 12 : 13); }
        a.ph_lo = p; a.ph_hi = p + 1;
        switch (kind) {
#define LK(K) case K: hipLaunchKernelGGL(fwd_kernel<1u << K>, dim3(grid), dim3(NTHREADS), LDS_BYTES, stream, a); break;
            LK(0) LK(1) LK(2) LK(3) LK(4) LK(5) LK(6) LK(7) LK(8) LK(9) LK(10) LK(11) LK(12) LK(13) LK(14)
#undef LK
        }
    }
#else
    a.ph_lo = 0; a.ph_hi = PH_END;
    hipLaunchKernelGGL(fwd_kernel<0xFFFFFFFFu>, dim3(grid), dim3(NTHREADS), LDS_BYTES, stream, a);
#endif
}
```

```cpp
#include <hip/hip_runtime.h>
#include <stdint.h>
#include <stdio.h>

#ifndef MK_MULTI
#define MK_MULTI 0
#endif

#define LAS __attribute__((address_space(3)))
typedef unsigned short bf16_t;
typedef short bf16x8 __attribute__((ext_vector_type(8)));
typedef float f32x4 __attribute__((ext_vector_type(4)));
typedef float f32x2 __attribute__((ext_vector_type(2)));
typedef unsigned u32x4 __attribute__((ext_vector_type(4)));
typedef unsigned u32x2 __attribute__((ext_vector_type(2)));
typedef int i32x4 __attribute__((ext_vector_type(4)));
typedef int i32x8 __attribute__((ext_vector_type(8)));

constexpr int BATCH = 8, SEQ = 4096, DM = 1024, CTXL = 256;
constexpr int NL = BATCH * SEQ;
constexpr int NCX = BATCH * CTXL;
constexpr int MT = NL + NCX;
constexpr int HEADS = 4, DH = 256, CHUNK = 64;
constexpr int IN_COLS = 6672, O_OFF = 3072, IF_OFF = 4096, POOL_OFF = 4112, GA_OFF = 4624, GB_OFF = 5648;
constexpr int DFF = 2816, NEXP = 8, DFE = 3584;
constexpr int NQKV = 3072, NZB = 3584;
constexpr int NCHUNK_L = NL / CHUNK;
constexpr int NCHUNK = MT / CHUNK;
constexpr float EPS = 1e-6f;
constexpr int NTHREADS = 512;
constexpr int LDS_BYTES = 163840;
#ifndef FP8_MOE
#define FP8_MOE 1
#endif
#if FP8_MOE
constexpr int MOE_RT = 264;
constexpr int MOE_ROUNDS = 1;
#else
constexpr int MOE_RT = 64;
constexpr int MOE_ROUNDS = 5;
#endif

#ifndef FP8_MOE
#define FP8_MOE 1
#endif
#define FP8_MOE_DEFAULT FP8_MOE
#ifndef MLSTM_TR
#define MLSTM_TR 1
#endif
constexpr size_t al256(size_t x) { return (x + 255) & ~(size_t)255; }
constexpr size_t WS_CTL = 0;
constexpr size_t CTL_BYTES = 65536;
constexpr size_t WS_MOD = WS_CTL + CTL_BYTES;
constexpr size_t WS_GATES = al256(WS_MOD + (size_t)2 * 9 * 6144 * 4);
constexpr size_t WS_HALO = al256(WS_GATES + (size_t)MT * 16 * 4);
constexpr size_t WS_HCTX = al256(WS_HALO + (size_t)NCHUNK * 2 * 2048 * 2);
constexpr size_t WS_RPROB = al256(WS_HCTX + (size_t)NCX * DM * 4);
constexpr size_t WS_RLIST = al256(WS_RPROB + (size_t)NL * 2 * 4);
constexpr size_t WS_GSC = al256(WS_RLIST + (size_t)NEXP * NL * 4);
constexpr size_t WS_WQKV = al256(WS_GSC + (size_t)NCHUNK * 8 * 64 * 16);
constexpr size_t WS_WB = al256(WS_WQKV + (size_t)2 * NQKV * DM * 2);
constexpr size_t WS_WPA = al256(WS_WB + (size_t)2 * NZB * DM * 2);
constexpr size_t WS_WPBC = al256(WS_WPA + (size_t)2 * DM * DM * 2);
constexpr size_t WS_WOUT = al256(WS_WPBC + (size_t)2 * DM * 512 * 2);
constexpr size_t WS_WFGU = al256(WS_WOUT + (size_t)2 * DM * DM * 2);
constexpr size_t WS_WFD = al256(WS_WFGU + (size_t)2 * DFF * DM * 2);
constexpr size_t WS_ARENA = al256(WS_WFD + (size_t)DM * DFF * 2);
constexpr size_t R0_BYTES = (size_t)MT * DM * 2;
constexpr size_t WS_R0 = WS_ARENA;
constexpr size_t WS_R1 = WS_R0 + R0_BYTES;
constexpr size_t WS_R2 = WS_R1 + (size_t)MT * NQKV * 2;
constexpr size_t WS_R3 = WS_R2 + 2 * R0_BYTES;
constexpr size_t WS_END = WS_R3 + 2 * R0_BYTES;
constexpr size_t WS_KT = WS_R2, WS_VT = WS_R2 + R0_BYTES;
constexpr size_t WS_HF = WS_R3, WS_HB = WS_R3 + R0_BYTES;
constexpr size_t WS_ZS = WS_R2;
constexpr size_t WS_ZP = WS_ZS + (size_t)MT * 3072;
constexpr int HLD = 2048;
constexpr size_t WS_HC16 = WS_END;
constexpr size_t WS_END2 = WS_HC16 + (size_t)NCX * HLD * 2;
constexpr size_t WS_ACAT = WS_R1;
constexpr int KCAT = 1536;
constexpr size_t WS_WCAT = WS_WPA;
static_assert(WS_WPBC == WS_WPA + (size_t)2 * DM * DM * 2 && WS_WOUT >= WS_WCAT + (size_t)2 * DM * KCAT * 2, "concatenated merge weights");
static_assert(WS_ZP + (size_t)MT * 512 * 2 <= WS_R3, "gate planes + pool projection fit the old K^T/V^T region");
constexpr size_t WS_ACT = WS_R1;
constexpr size_t WS_WEGU = WS_R1;
constexpr size_t ES_MOE = FP8_MOE ? 1 : 2;
constexpr size_t WS_WED = WS_WEGU + (size_t)NEXP * 2 * DFE * DM * ES_MOE;
constexpr size_t WS_MACT = WS_WED + (size_t)NEXP * DM * DFE * ES_MOE;
constexpr size_t WS_Y = WS_R3;
constexpr size_t MACT_BYTES = (size_t)MOE_RT * 256 * DFE * 2;
static_assert(WS_MACT + (MOE_ROUNDS > 1 ? 2 : 1) * (FP8_MOE_DEFAULT ? MACT_BYTES / 2 : MACT_BYTES) <= WS_R3, "MoE overlay (activation buffers)");
static_assert((size_t)2 * NL * DM * 2 <= 2 * R0_BYTES, "Y overlay");

constexpr int CW_BAR = 0;
constexpr int CW_ECNT = 4096;
constexpr int CW_ERR = 8192;
#ifndef DEPMASK
#define DEPMASK 7u
#endif
constexpr int CW_NONCANON = 8256;
constexpr int CW_DEP_MERGE = 10240;
constexpr int CW_DEP_FFN = 10752;
constexpr int CW_DEP_MOE = 11264;

#ifndef FP8_MOE
#define FP8_MOE 1
#endif
#ifndef FP8_FFN2
#define FP8_FFN2 1
#endif
#ifndef FP8_DENSE
#define FP8_DENSE 1
#endif
constexpr float WSCALE = 64.0f, WSCALE_INV = 1.0f / 64.0f;
__device__ __forceinline__ unsigned pack4_fp8(float a, float b, float c, float d) {
    a = __builtin_amdgcn_fmed3f(a, -448.f, 448.f); b = __builtin_amdgcn_fmed3f(b, -448.f, 448.f); c = __builtin_amdgcn_fmed3f(c, -448.f, 448.f); d = __builtin_amdgcn_fmed3f(d, -448.f, 448.f);
    int w = __builtin_amdgcn_cvt_pk_fp8_f32(a, b, 0, false); w = __builtin_amdgcn_cvt_pk_fp8_f32(c, d, w, true); return (unsigned)w; }
__device__ __forceinline__ unsigned cvt_pk_bf16(float lo, float hi) { unsigned r; asm("v_cvt_pk_bf16_f32 %0, %1, %2" : "=v"(r) : "v"(lo), "v"(hi)); return r; }
__device__ __forceinline__ float bf_lo(unsigned w) { return __uint_as_float(w << 16); }
__device__ __forceinline__ float bf_hi(unsigned w) { return __uint_as_float(w & 0xffff0000u); }
__device__ __forceinline__ float bf2f(bf16_t b) { return __uint_as_float(((unsigned)b) << 16); }
__device__ __forceinline__ bf16_t f2bf(float f) { return (bf16_t)(cvt_pk_bf16(f, 0.f) & 0xffffu); }
__device__ __forceinline__ float sigm(float x) { return __builtin_amdgcn_rcpf(1.0f + __expf(-x)); }
__device__ __forceinline__ float silu(float x) { return x * __builtin_amdgcn_rcpf(1.0f + __expf(-x)); }
__device__ __forceinline__ float lx_xor(float v, int m, int lane) { return __int_as_float(__builtin_amdgcn_ds_bpermute((lane ^ m) << 2, __float_as_int(v))); }
__device__ __forceinline__ float lx_up(float v, int o, int lane) { return __int_as_float(__builtin_amdgcn_ds_bpermute((lane - o) << 2, __float_as_int(v))); }
__device__ __forceinline__ float lx_idx(float v, int src) { return __int_as_float(__builtin_amdgcn_ds_bpermute(src << 2, __float_as_int(v))); }
#define DPP_F(v, ctrl) __int_as_float(__builtin_amdgcn_update_dpp(0, __float_as_int(v), ctrl, 0xf, 0xf, true))
#define RDL_F(v, l) __int_as_float(__builtin_amdgcn_readlane(__float_as_int(v), l))
__device__ __forceinline__ float wave_sum(float v, int) {
    v += DPP_F(v, 0xB1); v += DPP_F(v, 0x4E); v += DPP_F(v, 0x141); v += DPP_F(v, 0x140);
    return (RDL_F(v, 0) + RDL_F(v, 16)) + (RDL_F(v, 32) + RDL_F(v, 48));
}
__device__ __forceinline__ float wave_max(float v, int) {
    v = fmaxf(v, DPP_F(v, 0xB1)); v = fmaxf(v, DPP_F(v, 0x4E)); v = fmaxf(v, DPP_F(v, 0x141)); v = fmaxf(v, DPP_F(v, 0x140));
    return fmaxf(fmaxf(RDL_F(v, 0), RDL_F(v, 16)), fmaxf(RDL_F(v, 32), RDL_F(v, 48)));
}

#define XB_TMO      128
#define XB_XCNT(j)  (256  + 64 * (j))
#define XB_XSUB(j)  (1280 + 64 * (j))
#define XB_XGEN(j)  (2304 + 64 * (j))
#define XB_TOP      3328
#define XB_TOPGEN   3392
#define XCD_BAR_WORDS 3456
#define XB_SPIN_CAP (1u << 18)

__device__ __forceinline__ unsigned xb_ld(unsigned* p)              { return __hip_atomic_load(p, __ATOMIC_RELAXED, __HIP_MEMORY_SCOPE_AGENT); }
__device__ __forceinline__ unsigned xb_add(unsigned* p, unsigned v) { return __hip_atomic_fetch_add(p, v, __ATOMIC_RELAXED, __HIP_MEMORY_SCOPE_AGENT); }
__device__ __forceinline__ unsigned xb_xcc_id() { return (unsigned)__builtin_amdgcn_s_getreg((3 << 11) | 20) & 0xFu; }
__device__ __forceinline__ void dep_spin(unsigned* p, unsigned need) { unsigned sp = 0; while (xb_ld(p) < need) { __builtin_amdgcn_s_sleep(2); if (++sp > (1u << 20)) break; } }
#define XB_SPIN(cond, bar) do { unsigned _sp = 0; while (cond) { __builtin_amdgcn_s_sleep(1); \
    if ((++_sp & 255u) == 0u) { if (xb_ld(&(bar)[XB_TMO])) break; if (_sp > XB_SPIN_CAP) { atomicAdd(&(bar)[XB_TMO], 1u); break; } } } } while (0)

struct XcdBarrier { unsigned* bar; unsigned x; volatile LAS unsigned* st; };

__device__ __forceinline__ XcdBarrier xcd_barrier_post(unsigned* bar, volatile LAS unsigned* st) {
    XcdBarrier b; b.bar = bar; b.x = xb_xcc_id(); b.st = st;
    if (threadIdx.x == 0) (void)xb_add(&bar[XB_XCNT(b.x)], 1u);
    return b;
}
__device__ __forceinline__ void xcd_barrier_complete(unsigned* bar, unsigned x, unsigned& nloc, unsigned& nx) {
    const unsigned G = gridDim.x * gridDim.y * gridDim.z;
    unsigned sum, cnt, mine, sp = 0u;
    for (;;) {
        sum = 0u; cnt = 0u; mine = 0u;
#pragma unroll
        for (unsigned j = 0; j < 16; ++j) { const unsigned c = xb_ld(&bar[XB_XCNT(j)]); sum += c; cnt += (c > 0u) ? 1u : 0u; mine = (j == x) ? c : mine; }
        if (sum == G) break;
        __builtin_amdgcn_s_sleep(1);
        if ((++sp & 255u) == 0u) { if (xb_ld(&bar[XB_TMO])) break; if (sp > XB_SPIN_CAP) { atomicAdd(&bar[XB_TMO], 1u); break; } }
    }
    nloc = mine > 0u ? mine : 1u; nx = cnt > 0u ? cnt : 1u;
}
__device__ __forceinline__ void xcd_barrier(const XcdBarrier& b, const bool thread0) {
    asm volatile("s_waitcnt vmcnt(0)" ::: "memory");
    __syncthreads();
    if (thread0) {
        unsigned* bar = b.bar;
        __builtin_amdgcn_s_waitcnt(0);
        unsigned nloc = b.st[0], nx = b.st[1];
        if (nloc == 0u) { xcd_barrier_complete(bar, b.x, nloc, nx); b.st[0] = nloc; b.st[1] = nx; }
        const unsigned old = xb_add(&bar[XB_XSUB(b.x)], 1u);
        const unsigned gen = old / nloc;
        if (old + 1u == (gen + 1u) * nloc) {
            __builtin_amdgcn_fence(__ATOMIC_RELEASE, "agent");
            asm volatile("s_waitcnt vmcnt(0)" ::: "memory");
            const unsigned og = xb_add(&bar[XB_TOP], 1u);
            const unsigned tg = og / nx;
            if (og + 1u == (tg + 1u) * nx) xb_add(&bar[XB_TOPGEN], 1u);
            else XB_SPIN(xb_ld(&bar[XB_TOPGEN]) == tg, bar);
            __builtin_amdgcn_fence(__ATOMIC_ACQUIRE, "agent");
            xb_add(&bar[XB_XGEN(b.x)], 1u);
            asm volatile("s_waitcnt vmcnt(0)" ::: "memory");
        } else {
            XB_SPIN(xb_ld(&bar[XB_XGEN(b.x)]) == gen, bar);
            __builtin_amdgcn_fence(__ATOMIC_ACQUIRE, "agent");
            asm volatile("s_waitcnt vmcnt(0)" ::: "memory");
        }
    }
    __syncthreads();
}

typedef const char __attribute__((address_space(4)))* karg_t;
__device__ __forceinline__ const float* karg_in(int i) {
    karg_t ka = (karg_t)__builtin_amdgcn_kernarg_segment_ptr();
    unsigned long long v;
    asm volatile("s_load_dwordx2 %0, %1, %2\n\ts_waitcnt lgkmcnt(0)" : "=s"(v) : "s"(ka), "s"(i * 8) : "memory");
    return (const float*)(const __attribute__((address_space(1))) float*)v;
}
namespace gp {
constexpr int BM = 256, BK = 64, HALF = 128, HTB = HALF * BK * 2, STAGE_BYTES = 8 * HTB, NXCD = 8, WGM = 8;
constexpr int LDS_GV = 135168;
__device__ __forceinline__ int lds_byte(int r, int c) { const int st = (r >> 4) * 2 + (c >> 5), rr = r & 15, cc = c & 31, ob = rr * 64 + cc * 2; return st * 1024 + (ob ^ (((ob >> 9) & 1) << 5)); }
__device__ __forceinline__ void stage_rc(int b, int& R, int& C) { const int st = b / 1024, sb = b % 1024, swz = sb ^ (((sb >> 9) & 1) << 5); R = (st >> 1) * 16 + swz / 64; C = (st & 1) * 32 + (swz % 64) / 2; }
__device__ __forceinline__ int perm32(int rho) { const int n = rho >> 4, i = rho & 15; return 8 * (i >> 2) + 4 * n + (i & 3); }

struct Unit { int pm, pn, ex, cnt; };

__device__ __forceinline__ bool static_next(int i, int G, int c, int nM, int nN, int& pm, int& pn) {
    const int nwg = nM * nN;
    const long L = (long)i * G + c; if (L >= nwg) return false;
    int wgid = (int)L; { const int q = nwg / NXCD, r = nwg % NXCD, xcd = wgid % NXCD, off = wgid / NXCD; wgid = (xcd < r ? xcd * (q + 1) : r * (q + 1) + (xcd - r) * q) + off; }
    const int nig = WGM * nN, gid = wgid / nig, fm = gid * WGM, gsz = (nM - fm) < WGM ? (nM - fm) : WGM;
    pm = fm + ((wgid % nig) % gsz); pn = (wgid % nig) / gsz; return true;
}

__device__ __forceinline__ bool chunk_next(int i, int G, int c, int nM, int nN, int& pm, int& pn) {
    const int x = c % NXCD, slot = c / NXCD, nslots = (G - x + NXCD - 1) / NXCD;
    const int r0 = x * nM / NXCD, nr = (x + 1) * nM / NXCD - r0;
    const int off = i * nslots + slot; if (off >= nr * nN) return false;
    const int nig = WGM * nN, gid = off / nig, fm = gid * WGM, gsz = (nr - fm) < WGM ? (nr - fm) : WGM;
    pm = r0 + fm + ((off % nig) % gsz); pn = (off % nig) / gsz; return true;
}

template <int FP8, class Epi, class Sched>
__device__ __forceinline__ void gemm_phase(LAS unsigned char* lds, const int Kb, const Sched& S, const Epi& E, const int tid) {
    const int wid = __builtin_amdgcn_readfirstlane(tid >> 6), lane = tid & 63, wr = wid >> 2, wc = wid & 3, fr = lane & 15, fq = lane >> 4;
    const int nt = Kb / (BK * 2);
    const int lda = S.lda, ldb = S.ldb;
    unsigned voffA[2], voffB[2];
#pragma unroll
    for (int i = 0; i < 2; ++i) { int R, C; stage_rc(tid * 16 + i * 8192, R, C); const int Rb = Epi::PERM ? ((R & ~31) + perm32(R & 31)) : R;
        voffA[i] = (unsigned)(R * lda + C * 2); voffB[i] = (unsigned)(Rb * ldb + C * 2); }
#define GP_GATHER(dst, u_) do { _Pragma("unroll") for (int _i = 0; _i < 2; ++_i) { int _R, _C; stage_rc(tid * 16 + _i * 8192, _R, _C); \
        _Pragma("unroll") for (int _h = 0; _h < 2; ++_h) dst[_h][_i] = (unsigned)(S.arow(u_, _h * HALF + _R) * lda + _C * 2); } } while (0)
    const size_t kstep = (size_t)(BK * 2);
    const size_t hstepA = (size_t)HALF * lda, hstepB = (size_t)HALF * ldb;
    const unsigned ldsw = (unsigned)wid * 1024u;
    const int aoff = lds_byte(wr * 64 + fr, fq * 8), boff = lds_byte(wc * 32 + fr, fq * 8);
    unsigned gvc[2][2];
#define GP_SA(b, h) (((b) * 2 + (h)) * HTB)
#define GP_SB(b, h) ((4 + (b) * 2 + (h)) * HTB)
#define GP_STAGE_B(bufoff, gbase) do { _Pragma("unroll") for (int _i = 0; _i < 2; ++_i) { unsigned _vo = voffB[_i]; asm volatile("" : "+v"(_vo));     \
        __builtin_amdgcn_global_load_lds((const unsigned*)((const char*)(gbase) + _vo), (LAS unsigned*)(lds + (bufoff) + ldsw + _i * 8192), 16, 0, 0); } } while (0)
#define GP_STAGE_A(bufoff, p, nx, h) do { _Pragma("unroll") for (int _i = 0; _i < 2; ++_i) { \
        unsigned _vo = Sched::GATHER ? gvc[h][_i] : voffA[_i]; asm volatile("" : "+v"(_vo)); \
        __builtin_amdgcn_global_load_lds((const unsigned*)((const char*)(p) + (Sched::GATHER ? (size_t)0 : (size_t)(h) * hstepA) + _vo), (LAS unsigned*)(lds + (bufoff) + ldsw + _i * 8192), 16, 0, 0); } } while (0)
#define GP_LDA(dst, b, h) do { _Pragma("unroll") for (int m = 0; m < 4; ++m) _Pragma("unroll") for (int k = 0; k < 2; ++k) dst[m][k] = *(const LAS bf16x8*)(lds + GP_SA(b, h) + aoff + m * 2048 + k * 1024); } while (0)
#define GP_LDB(dst, b, h) do { _Pragma("unroll") for (int n = 0; n < 2; ++n) _Pragma("unroll") for (int k = 0; k < 2; ++k) dst[n][k] = *(const LAS bf16x8*)(lds + GP_SB(b, h) + boff + n * 2048 + k * 1024); } while (0)
#define GP_MMA(ai, bj, At, Bt) do { __builtin_amdgcn_s_setprio(1); _Pragma("unroll") for (int m = 0; m < 4; ++m) _Pragma("unroll") for (int n = 0; n < 2; ++n) { \
        if (FP8) { const i32x8 _b = __builtin_shufflevector(__builtin_bit_cast(i32x4, Bt[n][0]), __builtin_bit_cast(i32x4, Bt[n][1]), 0, 1, 2, 3, 4, 5, 6, 7); \
                   const i32x8 _a = __builtin_shufflevector(__builtin_bit_cast(i32x4, At[m][0]), __builtin_bit_cast(i32x4, At[m][1]), 0, 1, 2, 3, 4, 5, 6, 7); \
                   asm volatile("v_mfma_f32_16x16x128_f8f6f4 %0, %1, %2, %0" : "+v"(acc[ai][bj][m][n]) : "v"(_b), "v"(_a)); }     \
        else { _Pragma("unroll") for (int k = 0; k < 2; ++k) acc[ai][bj][m][n] = __builtin_amdgcn_mfma_f32_16x16x32_bf16(Bt[n][k], At[m][k], acc[ai][bj][m][n], 0, 0, 0); } } \
        __builtin_amdgcn_s_setprio(0); } while (0)
#define GP_WAIT_V(n) asm volatile("s_waitcnt vmcnt(" #n ")" ::: "memory")
#define GP_WAIT_L(n) asm volatile("s_waitcnt lgkmcnt(" #n ")" ::: "memory")
#define GP_BAR __builtin_amdgcn_s_barrier()
#define GP_SCHED __builtin_amdgcn_sched_barrier(0)
    Unit cur, nxt; int ui = 0;
    if (!S.next(0, cur)) return;
    f32x4 acc[2][2][4][2];
#pragma unroll
    for (int a = 0; a < 2; ++a)
#pragma unroll
        for (int b = 0; b < 2; ++b)
#pragma unroll
            for (int m = 0; m < 4; ++m)
#pragma unroll
                for (int n = 0; n < 2; ++n) acc[a][b][m][n] = (f32x4){0.f, 0.f, 0.f, 0.f};
    bf16x8 At[4][2], B0[2][2], B1[2][2];
    const char* cA = S.aptr(cur); const char* cB = S.bptr(cur);
    if (Sched::GATHER) GP_GATHER(gvc, cur);
    int sig_pm = -1;
#define GP_CTL() ((unsigned*)((unsigned char*)karg_in(26) + WS_CTL))
#define GP_SIGNAL(pm_) do { if (lane == 0) (void)xb_add(GP_CTL() + S.depw + (pm_), 1u); } while (0)
#define GP_AWAIT(pm_) do { if (wid == 0) dep_spin(GP_CTL() + S.depw + (pm_), S.need); } while (0)
    if constexpr (Sched::DEP == 2) { GP_AWAIT(cur.pm); GP_BAR; }
    GP_STAGE_B(GP_SB(0, 0), cB); GP_STAGE_A(GP_SA(0, 0), cA, false, 0); GP_STAGE_B(GP_SB(0, 1), cB + hstepB); GP_STAGE_A(GP_SA(0, 1), cA, false, 1);
    if (wr == 1) GP_BAR;
    GP_WAIT_V(4); GP_BAR;
    GP_STAGE_B(GP_SB(1, 0), cB + kstep); GP_STAGE_A(GP_SA(1, 0), cA + kstep, false, 0); GP_STAGE_B(GP_SB(1, 1), cB + hstepB + kstep);
    GP_WAIT_V(6); GP_BAR;
    for (;;) {
        const bool has_next = S.next(ui + 1, nxt);
        const char* nA = has_next ? S.aptr(nxt) : cA; const char* nB = has_next ? S.bptr(nxt) : cB;
        if (Sched::GATHER && has_next) { unsigned gn[2][2]; GP_GATHER(gn, nxt); *(LAS u32x4*)(lds + LDS_GV + tid * 16) = (u32x4){gn[0][0], gn[0][1], gn[1][0], gn[1][1]}; }
        for (int t = 0; t < nt; t += 2) {
            const bool last = (t == nt - 2);
            if constexpr (Epi::MID_T > 0) { if (t == Epi::MID_T) { int t3 = tid; asm volatile("" : "+v"(t3)); E.mid(acc, cur, wr, wc, t3 & 15, (t3 & 63) >> 4); } }
            const char* a1 = cA + (size_t)(t + 1) * kstep;
            const char* a2 = last ? nA : cA + (size_t)(t + 2) * kstep; const char* b2 = last ? nB : cB + (size_t)(t + 2) * kstep;
            const char* a3 = a2 + kstep; const char* b3 = b2 + kstep;
            if constexpr (Sched::DEP == 2) { if (last && has_next) GP_AWAIT(nxt.pm); }
            GP_LDB(B0, 0, 0); GP_SCHED; GP_LDA(At, 0, 0); GP_STAGE_A(GP_SA(1, 1), a1, false, 1);
            GP_WAIT_L(8); GP_BAR; GP_WAIT_L(0); GP_MMA(0, 0, At, B0); GP_BAR; GP_SCHED;
            if (Sched::GATHER && last && has_next) { const u32x4 gq = *(const LAS u32x4*)(lds + LDS_GV + tid * 16); gvc[0][0] = gq.x; gvc[0][1] = gq.y; gvc[1][0] = gq.z; gvc[1][1] = gq.w; }
            GP_LDB(B1, 0, 1); GP_STAGE_B(GP_SB(0, 0), b2);
            GP_BAR; GP_WAIT_L(0); GP_MMA(0, 1, At, B1); GP_BAR;
            GP_LDA(At, 0, 1); GP_STAGE_A(GP_SA(0, 0), a2, last, 0);
            GP_BAR; GP_WAIT_L(0); GP_MMA(1, 0, At, B0); GP_BAR; GP_SCHED;
            GP_STAGE_B(GP_SB(0, 1), b2 + hstepB);
            GP_WAIT_V(6); GP_BAR; GP_MMA(1, 1, At, B1); GP_BAR;
            GP_LDB(B0, 1, 0); GP_SCHED; GP_LDA(At, 1, 0); GP_STAGE_A(GP_SA(0, 1), a2, last, 1);
            GP_WAIT_L(8); GP_BAR; GP_WAIT_L(0); GP_MMA(0, 0, At, B0); GP_BAR; GP_SCHED;
            GP_LDB(B1, 1, 1); GP_STAGE_B(GP_SB(1, 0), b3);
            GP_BAR; GP_WAIT_L(0); GP_MMA(0, 1, At, B1); GP_BAR;
            GP_LDA(At, 1, 1); GP_STAGE_A(GP_SA(1, 0), a3, last, 0);
            GP_BAR; GP_WAIT_L(0); GP_MMA(1, 0, At, B0); GP_BAR; GP_SCHED;
            GP_STAGE_B(GP_SB(1, 1), b3 + hstepB);
            GP_WAIT_V(6); GP_BAR; GP_MMA(1, 1, At, B1); GP_BAR;
            if constexpr (Sched::DEP == 1) {
                if (t == 0 && sig_pm >= 0) { GP_SIGNAL(sig_pm); sig_pm = -1; } }
        }
        if (FP8) asm volatile("s_nop 15\n\ts_nop 15" ::: "memory");
        { int t2 = tid; asm volatile("" : "+v"(t2));
          E(acc, cur, wr, wc, t2 & 15, (t2 & 63) >> 4); }
        if constexpr (Sched::DEP == 1) sig_pm = cur.pm;
        if (!has_next) break;
#pragma unroll
        for (int a = 0; a < 2; ++a)
#pragma unroll
            for (int b = 0; b < 2; ++b)
#pragma unroll
                for (int m = 0; m < 4; ++m)
#pragma unroll
                    for (int n = 0; n < 2; ++n) acc[a][b][m][n] = (f32x4){0.f, 0.f, 0.f, 0.f};
        cur = nxt; cA = nA; cB = nB; ++ui;
    }
    GP_WAIT_V(0);
    if constexpr (Sched::DEP == 1) { if (sig_pm >= 0) GP_SIGNAL(sig_pm); }
    if (wr == 0) GP_BAR;
    GP_BAR;
#undef GP_SA
#undef GP_CTL
#undef GP_SIGNAL
#undef GP_AWAIT
#undef GP_GATHER
#undef GP_SB
#undef GP_STAGE_A
#undef GP_STAGE_B
#undef GP_LDA
#undef GP_LDB
#undef GP_MMA
#undef GP_WAIT_V
#undef GP_WAIT_L
#undef GP_BAR
#undef GP_SCHED
}
}

struct Frame {
    float* out; unsigned char* ws; unsigned* ctl; LAS unsigned char* lds;
    int G, bid, tid, lane, wave;
    __device__ __forceinline__ const float* in(int i) const { return karg_in(i); }
};
enum { I_X = 0, I_C, I_CTX, I_CCTX, I_WADA, I_BADA, I_GMIX, I_WIN, I_CONV, I_BIF, I_HGAIN, I_WPOOL, I_PSCALE, I_WPA, I_WPB, I_WOUT, I_GFFN,
       I_WFG, I_WFU, I_WFD, I_WROUTER, I_WEG, I_WEU, I_WED, I_GFINAL };
constexpr int MOD_SH1 = 0, MOD_SC1 = 1024, MOD_GT1 = 2048, MOD_SH2 = 3072, MOD_SC2 = 4096, MOD_GT2 = 5120;

template <class Base, int MODE> struct WithDep : Base { static constexpr int DEP = MODE; int depw; unsigned need; };
template <bool CH> struct SchedDenseT {
    static constexpr bool GATHER = false; static constexpr int DEP = 0;
    const char* A; const char* B; int lda, ldb, nM, nN, G, c;
    __device__ __forceinline__ bool next(int i, gp::Unit& u) const { u.ex = 0; u.cnt = 256; return CH ? gp::chunk_next(i, G, c, nM, nN, u.pm, u.pn) : gp::static_next(i, G, c, nM, nN, u.pm, u.pn); }
    __device__ __forceinline__ const char* aptr(const gp::Unit& u) const { return A + (size_t)u.pm * 256 * lda; }
    __device__ __forceinline__ const char* bptr(const gp::Unit& u) const { return B + (size_t)u.pn * 256 * ldb; }
    __device__ __forceinline__ int arow(const gp::Unit&, int) const { return 0; }
};
typedef SchedDenseT<false> SchedDense;
constexpr int LDS_MOE_TAB = 131072;
__device__ __forceinline__ int moe_build_table(const Frame& F) {
    LAS int* tab = (LAS int*)(F.lds + LDS_MOE_TAB);
    int acc = 0, myex = -1, myr0 = 0, mycnt = 0;
#pragma unroll
    for (int e = 0; e < 8; ++e) { const int c = (int)__hip_atomic_load(F.ctl + CW_ECNT + 64 * e, __ATOMIC_RELAXED, __HIP_MEMORY_SCOPE_AGENT); const int nt = (c + 255) >> 8;
        if (F.tid >= acc && F.tid < acc + nt) { myex = e; myr0 = (F.tid - acc) * 256; mycnt = c - myr0; mycnt = mycnt > 256 ? 256 : mycnt; }
        acc += nt; }
    if (myex >= 0) { tab[2 * F.tid] = myex; tab[2 * F.tid + 1] = (myr0 << 9) | mycnt; }
    __syncthreads();
    return acc;
}
struct SchedMoe1 {
    static constexpr bool GATHER = true; static constexpr int DEP = 0;
    const char* A; const char* B; const int* list; LAS const int* tab; int lda, ldb, G, c, g0, ntile;
    __device__ __forceinline__ bool next(int i, gp::Unit& u) const {
        if (ntile <= 0) return false;
        if (!((DEPMASK & 4u) ? gp::chunk_next(i, G, c, ntile, DFE / 128, u.pm, u.pn) : gp::static_next(i, G, c, ntile, DFE / 128, u.pm, u.pn))) return false;
        u.ex = __builtin_amdgcn_readfirstlane(tab[2 * (g0 + u.pm)]); u.cnt = __builtin_amdgcn_readfirstlane(tab[2 * (g0 + u.pm) + 1]);
        return true;
    }
    __device__ __forceinline__ const char* aptr(const gp::Unit&) const { return A; }
    __device__ __forceinline__ const char* bptr(const gp::Unit& u) const { return B + ((size_t)u.ex * (2 * DFE) + (size_t)u.pn * 256) * ldb; }
    __device__ __forceinline__ int arow(const gp::Unit& u, int r) const {
        const int cnt = u.cnt & 511, r0 = u.cnt >> 9;
        return r < cnt ? (list[(size_t)u.ex * NL + r0 + r] >> 1) : 0;
    }
};
struct SchedMoe2 {
    static constexpr bool GATHER = false; static constexpr int DEP = 0;
    const char* A; const char* B; LAS const int* tab; int lda, ldb, G, c, g0, ntile;
    __device__ __forceinline__ bool next(int i, gp::Unit& u) const {
        if (ntile <= 0) return false;
        if (!((DEPMASK & 4u) ? gp::chunk_next(i, G, c, ntile, DM / 256, u.pm, u.pn) : gp::static_next(i, G, c, ntile, DM / 256, u.pm, u.pn))) return false;
        u.ex = __builtin_amdgcn_readfirstlane(tab[2 * (g0 + u.pm)]); u.cnt = __builtin_amdgcn_readfirstlane(tab[2 * (g0 + u.pm) + 1]);
        return true;
    }
    __device__ __forceinline__ const char* aptr(const gp::Unit& u) const { return A + (size_t)u.pm * 256 * lda; }
    __device__ __forceinline__ const char* bptr(const gp::Unit& u) const { return B + ((size_t)u.ex * DM + (size_t)u.pn * 256) * ldb; }
    __device__ __forceinline__ int arow(const gp::Unit&, int) const { return 0; }
};

#define EPI_ARGS const f32x4 (&acc)[2][2][4][2], const gp::Unit& u, int wr, int wc, int fr, int fq
#define EPI_ROWS(ai, m) ((ai) * 128 + wr * 64 + (m) * 16 + fr)
__device__ __forceinline__ u32x4 pack8(const f32x4& a, const f32x4& b) { u32x4 w; w.x = cvt_pk_bf16(a[0], a[1]); w.y = cvt_pk_bf16(a[2], a[3]); w.z = cvt_pk_bf16(b[0], b[1]); w.w = cvt_pk_bf16(b[2], b[3]); return w; }
__device__ __forceinline__ void unpack8(const u32x4& w, f32x4& a, f32x4& b) { a = (f32x4){bf_lo(w.x), bf_hi(w.x), bf_lo(w.y), bf_hi(w.y)}; b = (f32x4){bf_lo(w.z), bf_hi(w.z), bf_lo(w.w), bf_hi(w.w)}; }

struct EpiQKV {
    static constexpr bool PERM = true; static constexpr int MID_T = 0;
    bf16_t* O; bf16_t* halo;
    __device__ __forceinline__ void operator()(EPI_ARGS) const {
        const int c8 = u.pn * 256 + wc * 32 + 8 * fq;
#pragma unroll
        for (int ai = 0; ai < 2; ++ai)
#pragma unroll
            for (int m = 0; m < 4; ++m) { const int row = u.pm * 256 + EPI_ROWS(ai, m);
#pragma unroll
                for (int bj = 0; bj < 2; ++bj) { const u32x4 w = pack8(acc[ai][bj][m][0], acc[ai][bj][m][1]);
                    *(u32x4*)(O + (size_t)row * NQKV + c8 + bj * 128) = w;
                    const int rr = row & 63;
                    if (u.pn < 8 && (rr == 0 || rr == 63)) *(u32x4*)(halo + ((size_t)(row >> 6) * 2 + (rr ? 1 : 0)) * 2048 + c8 + bj * 128) = w; } }
    }
};
__device__ __forceinline__ unsigned pack4_u8(float a, float b, float c, float d) {
    unsigned w = 0;
    w = __builtin_amdgcn_cvt_pk_u8_f32(fmaxf(__builtin_rintf(a * 255.f), 1.f), 0, w); w = __builtin_amdgcn_cvt_pk_u8_f32(fmaxf(__builtin_rintf(b * 255.f), 1.f), 1, w);
    w = __builtin_amdgcn_cvt_pk_u8_f32(fmaxf(__builtin_rintf(c * 255.f), 1.f), 2, w); w = __builtin_amdgcn_cvt_pk_u8_f32(fmaxf(__builtin_rintf(d * 255.f), 1.f), 3, w); return w; }
__device__ __forceinline__ f32x4 unpack4_u8(unsigned w) { return (f32x4){(float)(w & 0xffu), (float)((w >> 8) & 0xffu), (float)((w >> 16) & 0xffu), (float)(w >> 24)} * (1.0f / 255.0f); }
struct EpiZB {
    static constexpr bool PERM = true; static constexpr int MID_T = 0;
    unsigned char* ZS; bf16_t* ZP;
    __device__ __forceinline__ void operator()(EPI_ARGS) const {
        const int c8 = wc * 32 + 8 * fq; const bool sg = u.pn < 12;
#pragma unroll
        for (int ai = 0; ai < 2; ++ai)
#pragma unroll
            for (int m = 0; m < 4; ++m) { const int row = u.pm * 256 + EPI_ROWS(ai, m);
#pragma unroll
                for (int bj = 0; bj < 2; ++bj) { const f32x4 a = acc[ai][bj][m][0], b = acc[ai][bj][m][1];
                    if (sg) { u32x2 w; w.x = pack4_u8(sigm(a[0]), sigm(a[1]), sigm(a[2]), sigm(a[3])); w.y = pack4_u8(sigm(b[0]), sigm(b[1]), sigm(b[2]), sigm(b[3]));
                        *(u32x2*)(ZS + (size_t)row * 3072 + u.pn * 256 + c8 + bj * 128) = w; }
                    else *(u32x4*)(ZP + (size_t)row * 512 + (u.pn - 12) * 256 + c8 + bj * 128) = pack8(a, b); }
                asm volatile("" ::: "memory"); }
    }
};
struct EpiMerge {
    static constexpr bool PERM = true; static constexpr int MID_T = 16;
    bf16_t* O; const unsigned char* Z;
    __device__ __forceinline__ void mid(f32x4 (&acc)[2][2][4][2], const gp::Unit& u, int wr, int wc, int fr, int fq) const {
        const int c8 = u.pn * 256 + wc * 32 + 8 * fq;
#pragma unroll
        for (int ai = 0; ai < 2; ++ai) {
            u32x2 ga[2][4], gb[2][4];
#pragma unroll
            for (int bj = 0; bj < 2; ++bj)
#pragma unroll
                for (int m = 0; m < 4; ++m) { const unsigned char* zp = Z + (size_t)(u.pm * 256 + EPI_ROWS(ai, m)) * 3072 + c8 + bj * 128; ga[bj][m] = *(const u32x2*)(zp + 1024); gb[bj][m] = *(const u32x2*)(zp + 2048); }
#pragma unroll
            for (int bj = 0; bj < 2; ++bj)
#pragma unroll
                for (int m = 0; m < 4; ++m) { const f32x4 a0 = unpack4_u8(ga[bj][m].x), a1 = unpack4_u8(ga[bj][m].y), b0 = unpack4_u8(gb[bj][m].x), b1 = unpack4_u8(gb[bj][m].y);
#pragma unroll
                    for (int j = 0; j < 4; ++j) { acc[ai][bj][m][0][j] *= a0[j] * __builtin_amdgcn_rcpf(b0[j]); acc[ai][bj][m][1][j] *= a1[j] * __builtin_amdgcn_rcpf(b1[j]); } }
            asm volatile("" ::: "memory"); }
    }
    __device__ __forceinline__ void operator()(EPI_ARGS) const {
        const int c8 = u.pn * 256 + wc * 32 + 8 * fq;
#pragma unroll
        for (int ai = 0; ai < 2; ++ai) {
            u32x2 gb[4][2];
#pragma unroll
            for (int m = 0; m < 4; ++m)
#pragma unroll
                for (int bj = 0; bj < 2; ++bj) gb[m][bj] = *(const u32x2*)(Z + (size_t)(u.pm * 256 + EPI_ROWS(ai, m)) * 3072 + 2048 + c8 + bj * 128);
#pragma unroll
            for (int m = 0; m < 4; ++m) { const int row = u.pm * 256 + EPI_ROWS(ai, m);
#pragma unroll
                for (int bj = 0; bj < 2; ++bj) *(u32x4*)(O + (size_t)row * DM + c8 + bj * 128) = pack8(acc[ai][bj][m][0] * unpack4_u8(gb[m][bj].x), acc[ai][bj][m][1] * unpack4_u8(gb[m][bj].y)); }
            asm volatile("" ::: "memory"); }
    }
};
template <bool SRC32> struct EpiResid {
    static constexpr bool PERM = true; static constexpr int MID_T = 0;
    const void* srcL; bf16_t* dstL; const void* srcC; bf16_t* dstC; const float* modl; int gtoff; float sin;
    __device__ __forceinline__ void operator()(EPI_ARGS) const {
        const bool isc = u.pm >= NL / 256; const int mrow = isc ? 8 : (u.pm >> 4);
        const void* src = isc ? srcC : srcL; bf16_t* dst = isc ? dstC : dstL; const int rbase = isc ? u.pm * 256 - NL : u.pm * 256;
        constexpr int lds_ = SRC32 ? DM : HLD, ldd_ = HLD;
        const float* gt = modl + (size_t)mrow * 6144 + gtoff;
        const int c8 = u.pn * 256 + wc * 32 + 8 * fq;
        f32x4 gv[2][2];
#pragma unroll
        for (int bj = 0; bj < 2; ++bj)
#pragma unroll
            for (int n = 0; n < 2; ++n) gv[bj][n] = *(const f32x4*)(gt + c8 + bj * 128 + n * 4) * sin;
#pragma unroll
        for (int ai = 0; ai < 2; ++ai) {
            if constexpr (SRC32) {
                f32x4 s[4][2][2];
#pragma unroll
                for (int m = 0; m < 4; ++m) { const size_t off = (size_t)(rbase + EPI_ROWS(ai, m)) * lds_ + c8;
#pragma unroll
                    for (int bj = 0; bj < 2; ++bj)
#pragma unroll
                        for (int n = 0; n < 2; ++n) s[m][bj][n] = *(const f32x4*)((const float*)src + off + bj * 128 + n * 4); }
#pragma unroll
                for (int m = 0; m < 4; ++m) { const size_t off = (size_t)(rbase + EPI_ROWS(ai, m)) * ldd_ + c8;
#pragma unroll
                    for (int bj = 0; bj < 2; ++bj) *(u32x4*)(dst + off + bj * 128) = pack8(s[m][bj][0] + gv[bj][0] * acc[ai][bj][m][0], s[m][bj][1] + gv[bj][1] * acc[ai][bj][m][1]); }
            } else {
                u32x4 s[4][2];
#pragma unroll
                for (int m = 0; m < 4; ++m) { const size_t off = (size_t)(rbase + EPI_ROWS(ai, m)) * lds_ + c8;
#pragma unroll
                    for (int bj = 0; bj < 2; ++bj) s[m][bj] = *(const u32x4*)((const bf16_t*)src + off + bj * 128); }
#pragma unroll
                for (int m = 0; m < 4; ++m) { const size_t off = (size_t)(rbase + EPI_ROWS(ai, m)) * ldd_ + c8;
#pragma unroll
                    for (int bj = 0; bj < 2; ++bj) { f32x4 s0, s1; unpack8(s[m][bj], s0, s1);
                        *(u32x4*)(dst + off + bj * 128) = pack8(s0 + gv[bj][0] * acc[ai][bj][m][0], s1 + gv[bj][1] * acc[ai][bj][m][1]); } }
            }
            asm volatile("" ::: "memory"); }
    }
};
template <int FP8OUT> struct EpiSwiglu {
    static constexpr bool PERM = true; static constexpr int MID_T = 0;
    unsigned char* O; int ldo; float sin;
    __device__ __forceinline__ void operator()(EPI_ARGS) const {
        const int c8 = u.pn * 128 + wc * 32 + 8 * fq;
#pragma unroll
        for (int ai = 0; ai < 2; ++ai)
#pragma unroll
            for (int m = 0; m < 4; ++m) { const int row = u.pm * 256 + EPI_ROWS(ai, m);
                f32x4 a, b;
#pragma unroll
                for (int j = 0; j < 4; ++j) { a[j] = silu(acc[ai][0][m][0][j] * sin) * (acc[ai][1][m][0][j] * sin); b[j] = silu(acc[ai][0][m][1][j] * sin) * (acc[ai][1][m][1][j] * sin); }
                if (FP8OUT) { u32x2 w; w.x = pack4_fp8(a[0], a[1], a[2], a[3]); w.y = pack4_fp8(b[0], b[1], b[2], b[3]); *(u32x2*)(O + (size_t)row * ldo + c8) = w; }
                else *(u32x4*)(O + (size_t)row * ldo + c8 * 2) = pack8(a, b);
                asm volatile("" ::: "memory"); }
    }
};
struct EpiMoe2 {
    static constexpr bool PERM = true; static constexpr int MID_T = 0;
    bf16_t* Y; const int* list; const float* prob; float sin;
    __device__ __forceinline__ void operator()(EPI_ARGS) const {
        const int cnt = u.cnt & 511, r0 = u.cnt >> 9;
        const int c8 = u.pn * 256 + wc * 32 + 8 * fq;
        int en[2][4]; float pr[2][4];
#pragma unroll
        for (int ai = 0; ai < 2; ++ai)
#pragma unroll
            for (int m = 0; m < 4; ++m) { const int r = EPI_ROWS(ai, m); en[ai][m] = r < cnt ? list[(size_t)u.ex * NL + r0 + r] : -1; }
#pragma unroll
        for (int ai = 0; ai < 2; ++ai)
#pragma unroll
            for (int m = 0; m < 4; ++m) pr[ai][m] = en[ai][m] >= 0 ? prob[en[ai][m]] * sin : 0.f;
#pragma unroll
        for (int ai = 0; ai < 2; ++ai)
#pragma unroll
            for (int m = 0; m < 4; ++m) {
                if (en[ai][m] >= 0) { const float p = pr[ai][m];
                    bf16_t* op = Y + ((size_t)(en[ai][m] & 1) * NL + (size_t)(en[ai][m] >> 1)) * DM + c8;
#pragma unroll
                    for (int bj = 0; bj < 2; ++bj) *(u32x4*)(op + bj * 128) = pack8(acc[ai][bj][m][0] * p, acc[ai][bj][m][1] * p); }
                asm volatile("" ::: "memory"); }
    }
};

template <int FP8>
__device__ __forceinline__ void conv_mat_t(const Frame& F, const float* src, int ld, int Krows, int c0, int ncols, void* dstv, int dld, int dr0, int mode, int rot, LAS float* tl, int kper = 1 << 20, size_t sub_stride = 0) {
    const int ntn = ncols / 64, ntk = Krows / 128, tot = ntn * ntk, t = F.tid;
    const int lr = t >> 4, lc4 = (t & 15) * 4;
    const int sn = t >> 3, skc = (t & 7) * 16;
    f32x4 v[4];
    int j = (F.bid + rot) % F.G;
    if (j < tot) { const int tn = j % ntn, tk = j / ntn;
#pragma unroll
        for (int i = 0; i < 4; ++i) v[i] = *(const f32x4*)(src + (size_t)(tk * 128 + lr + 32 * i) * ld + c0 + tn * 64 + lc4); }
    for (; j < tot; j += F.G) {
        const int tn = j % ntn, tk = j / ntn, cc = tn * 64;
#pragma unroll
        for (int i = 0; i < 4; ++i) { LAS float* p = tl + (lr + 32 * i) * 65 + lc4; p[0] = v[i][0]; p[1] = v[i][1]; p[2] = v[i][2]; p[3] = v[i][3]; }
        __syncthreads();
        const int jn = j + F.G;
        if (jn < tot) { const int tn2 = jn % ntn, tk2 = jn / ntn;
#pragma unroll
            for (int i = 0; i < 4; ++i) v[i] = *(const f32x4*)(src + (size_t)(tk2 * 128 + lr + 32 * i) * ld + c0 + tn2 * 64 + lc4); }
        float o[16];
#pragma unroll
        for (int q = 0; q < 16; ++q) o[q] = tl[(skc + q) * 65 + sn];
        const int dr = mode ? ((cc >> 7) * 256 + (cc & 127) + dr0) : (dr0 + cc);
        if (FP8) { u32x4 w;
#pragma unroll
            for (int q = 0; q < 16; ++q) o[q] *= WSCALE;
            w.x = pack4_fp8(o[0], o[1], o[2], o[3]); w.y = pack4_fp8(o[4], o[5], o[6], o[7]); w.z = pack4_fp8(o[8], o[9], o[10], o[11]); w.w = pack4_fp8(o[12], o[13], o[14], o[15]);
            *(u32x4*)((unsigned char*)dstv + (size_t)(tk / kper) * sub_stride + (size_t)(dr + sn) * dld + (tk % kper) * 128 + skc) = w; }
        else { u32x4 w0, w1;
            w0.x = cvt_pk_bf16(o[0], o[1]); w0.y = cvt_pk_bf16(o[2], o[3]); w0.z = cvt_pk_bf16(o[4], o[5]); w0.w = cvt_pk_bf16(o[6], o[7]);
            w1.x = cvt_pk_bf16(o[8], o[9]); w1.y = cvt_pk_bf16(o[10], o[11]); w1.z = cvt_pk_bf16(o[12], o[13]); w1.w = cvt_pk_bf16(o[14], o[15]);
            bf16_t* dp = (bf16_t*)dstv + (size_t)(tk / kper) * sub_stride + (size_t)(dr + sn) * dld + (tk % kper) * 128 + skc;
            *(u32x4*)dp = w0; *(u32x4*)(dp + 8) = w1; }
        __syncthreads();
    }
}

__device__ __forceinline__ void conv_mat(const Frame& F, const float* src, int ld, int Krows, int c0, int ncols, bf16_t* dst, int dld, int dr0, int mode, int rot, LAS float* tl) {
    conv_mat_t<0>(F, src, ld, Krows, c0, ncols, dst, dld, dr0, mode, rot, tl); }
__device__ __forceinline__ void prologue_phase(const Frame& F) {
    LAS float* tl = (LAS float*)F.lds;
    for (int l = 0; l < 2; ++l) {
        const float* win = F.in(I_WIN) + (size_t)l * DM * IN_COLS;
        bf16_t* wqkv = (bf16_t*)(F.ws + WS_WQKV) + (size_t)l * NQKV * DM;
        bf16_t* wb = (bf16_t*)(F.ws + WS_WB) + (size_t)l * NZB * DM;
        conv_mat(F, win, IN_COLS, DM, 0, NQKV, wqkv, DM, 0, 0, 0, tl);
        conv_mat(F, win, IN_COLS, DM, O_OFF, 1024, wb, DM, 0, 0, 64, tl);
        conv_mat(F, win, IN_COLS, DM, GA_OFF, 1024, wb, DM, 1024, 0, 128, tl);
        conv_mat(F, win, IN_COLS, DM, GB_OFF, 1024, wb, DM, 2048, 0, 192, tl);
        conv_mat(F, win, IN_COLS, DM, POOL_OFF, 512, wb, DM, 3072, 0, 0, tl);
        conv_mat(F, F.in(I_WPA) + (size_t)l * DM * DM, DM, DM, 0, DM, (bf16_t*)(F.ws + WS_WCAT) + (size_t)l * DM * KCAT, KCAT, 0, 0, 128, tl);
        conv_mat(F, F.in(I_WOUT) + (size_t)l * DM * DM, DM, DM, 0, DM, (bf16_t*)(F.ws + WS_WOUT) + (size_t)l * DM * DM, DM, 0, 0, 0, tl);
    }
    conv_mat_t<FP8_DENSE>(F, F.in(I_WFG), DFF, DM, 0, DFF, F.ws + WS_WFGU, DM, 0, 1, 0, tl);
    conv_mat_t<FP8_DENSE>(F, F.in(I_WFU), DFF, DM, 0, DFF, F.ws + WS_WFGU, DM, 128, 1, 64, tl);
    conv_mat_t<(FP8_DENSE || FP8_FFN2)>(F, F.in(I_WFD), DM, DFF, 0, DM, F.ws + WS_WFD, DFF, 0, 0, 128, tl);
    const float* wpool = F.in(I_WPOOL); const float* pscale = F.in(I_PSCALE); const float* wpb = F.in(I_WPB);
    for (int idx = F.bid * NTHREADS + F.tid; idx < 2 * 512 * 1024; idx += F.G * NTHREADS) {
        const int l = idx >> 19, rem = idx & ((1 << 19) - 1), gc = rem >> 10, n = rem & 1023, g = gc >> 7;
        const float* wp = wpool + ((size_t)l * 512 + gc) * 128; const float* ps = pscale + l * 512 + g * 128;
        const float* pb = wpb + ((size_t)l * 512 + g * 128) * DM + n;
        float s = 0.f;
        for (int e0 = 0; e0 < 128; e0 += 8) { float x[8], y[8], z[8];
#pragma unroll
            for (int j = 0; j < 8; ++j) { x[j] = wp[e0 + j]; y[j] = ps[e0 + j]; z[j] = pb[(size_t)(e0 + j) * DM]; }
#pragma unroll
            for (int j = 0; j < 8; ++j) s += x[j] * y[j] * z[j]; }
        ((bf16_t*)(F.ws + WS_WCAT))[((size_t)l * DM + n) * KCAT + 1024 + gc] = f2bf(s);
    }
    {
        LAS float* sl = (LAS float*)(F.lds + 40960);
        LAS float* red = (LAS float*)(F.lds + 40960 + 36864);
        const float* cvec = F.in(I_C); const float* ccv = F.in(I_CCTX); const float* bada = F.in(I_BADA);
        for (int idx = F.tid; idx < 9 * 1024; idx += NTHREADS) { const int r = idx >> 10, k = idx & 1023; const float v = r < 8 ? cvec[r * 1024 + k] : ccv[k]; sl[idx] = silu(v); }
        __syncthreads();
        float* mod = (float*)(F.ws + WS_MOD);
        for (int job = F.bid; job < 2 * 96; job += F.G) {
            const int l = job / 96, n0 = (job % 96) * 64, cidx = F.tid & 63, kg = F.tid >> 6;
            const float* w = F.in(I_WADA) + (size_t)l * DM * 6144 + n0 + cidx;
            float a[9];
#pragma unroll
            for (int r = 0; r < 9; ++r) a[r] = 0.f;
            for (int k0 = kg * 128; k0 < kg * 128 + 128; k0 += 8) { float wv[8];
#pragma unroll
                for (int j = 0; j < 8; ++j) wv[j] = w[(size_t)(k0 + j) * 6144];
#pragma unroll
                for (int j = 0; j < 8; ++j)
#pragma unroll
                    for (int r = 0; r < 9; ++r) a[r] += sl[r * 1024 + k0 + j] * wv[j]; }
#pragma unroll
            for (int r = 0; r < 9; ++r) red[(kg * 64 + cidx) * 9 + r] = a[r];
            __syncthreads();
            for (int idx = F.tid; idx < 576; idx += NTHREADS) { const int ci = idx & 63, r = idx >> 6; float s = 0.f;
#pragma unroll
                for (int g = 0; g < 8; ++g) s += red[(g * 64 + ci) * 9 + r];
                mod[((size_t)l * 9 + r) * 6144 + n0 + ci] = s + bada[l * 6144 + n0 + ci]; }
            __syncthreads();
        }
    }
}

__device__ __forceinline__ void expert_convert(const Frame& F, LAS float* tl) {
    constexpr int ES = FP8_MOE ? 1 : 2;
    conv_mat_t<FP8_MOE>(F, F.in(I_WEG), DFE, NEXP * DM, 0, DFE, F.ws + WS_WEGU, DM, 0, 1, 0, tl, DM / 128, (size_t)2 * DFE * DM);
    conv_mat_t<FP8_MOE>(F, F.in(I_WEU), DFE, NEXP * DM, 0, DFE, F.ws + WS_WEGU, DM, 128, 1, 128, tl, DM / 128, (size_t)2 * DFE * DM);
    conv_mat_t<FP8_MOE>(F, F.in(I_WED), DM, NEXP * DFE, 0, DM, F.ws + WS_WED, DFE, 0, 0, 0, tl, DFE / 128, (size_t)DM * DFE);
}

template <bool SRC32> struct RowRaw;
template <> struct RowRaw<true> { f32x4 v[4];
    __device__ __forceinline__ void load(const void* p, int lane) {
#pragma unroll
        for (int i = 0; i < 4; ++i) v[i] = *(const f32x4*)((const float*)p + i * 256 + lane * 4); }
    __device__ __forceinline__ f32x4 get(int i) const { return v[i]; } };
template <> struct RowRaw<false> { u32x2 v[4];
    __device__ __forceinline__ void load(const void* p, int lane) {
#pragma unroll
        for (int i = 0; i < 4; ++i) v[i] = *(const u32x2*)((const bf16_t*)p + i * 256 + lane * 4); }
    __device__ __forceinline__ f32x4 get(int i) const { return (f32x4){bf_lo(v[i].x), bf_hi(v[i].x), bf_lo(v[i].y), bf_hi(v[i].y)}; } };
template <bool SRC32>
__device__ __forceinline__ void norm_phase(const Frame& F, int l, int which) {
    const bool n1 = which == 0;
    const int M = (which == 2) ? NL : (n1 ? MT : (l == 0 ? MT : NL));
    const char* srcL = SRC32 ? (const char*)F.in(I_X) : (const char*)F.out; const char* srcC = SRC32 ? (const char*)F.in(I_CTX) : (const char*)(F.ws + WS_HC16);
    constexpr size_t RB = SRC32 ? DM * 4 : HLD * 2, RBC = SRC32 ? DM * 4 : HLD * 2;
    const float* g = (n1 ? F.in(I_GMIX) : F.in(I_GFFN)) + l * DM;
    const float* modl = (const float*)(F.ws + WS_MOD) + (size_t)l * 9 * 6144;
    const int shoff = n1 ? MOD_SH1 : MOD_SH2, scoff = n1 ? MOD_SC1 : MOD_SC2;
    bf16_t* U = (bf16_t*)(F.ws + WS_R0);
    const bool u8 = (which == 2 && FP8_MOE) || (which == 1 && FP8_DENSE);
    LAS float* W = (LAS float*)F.lds;
    LAS float* rlog = (LAS float*)(F.lds + 65536);
    LAS int* lcnt = (LAS int*)(F.lds + 65536 + 8192);
    const int ncol = n1 ? 16 : 8;
    const float* bif = F.in(I_BIF) + l * 16;
    if (which != 1) {
        const float* wsrc = n1 ? (F.in(I_WIN) + (size_t)l * DM * IN_COLS + IF_OFF) : (F.in(I_WROUTER));
        const int ld = n1 ? IN_COLS : NEXP;
        for (int idx = F.tid; idx < ncol * 1024; idx += NTHREADS) { const int k = idx / ncol, c = idx % ncol; W[c * 1024 + k] = wsrc[(size_t)k * ld + c]; }
        if (F.tid < 16) lcnt[F.tid] = 0;
        __syncthreads();
    }
    const int rpb = (M + F.G - 1) / F.G, rb0 = F.bid * rpb, rb1 = (rb0 + rpb) < M ? (rb0 + rpb) : M;
    RowRaw<SRC32> nv;
    { const int row = rb0 + F.wave;
      if (row < rb1) nv.load(row >= NL ? srcC + (size_t)(row - NL) * RBC : srcL + (size_t)row * RB, F.lane); }
    f32x4 fac[4], sft[4]; int mcur = -1;
    for (int row = rb0 + F.wave; row < rb1; row += 8) {
        const bool isc = row >= NL;
        const int mrow = isc ? 8 : (row >> 12);
        if (mrow != mcur) { mcur = mrow; const float* mr = modl + (size_t)mrow * 6144;
#pragma unroll
            for (int i = 0; i < 4; ++i) { const int k = i * 256 + F.lane * 4; fac[i] = *(const f32x4*)(g + k) * (*(const f32x4*)(mr + scoff + k) + 1.0f); sft[i] = *(const f32x4*)(mr + shoff + k); } }
        f32x4 v[4]; float ss = 0.f;
#pragma unroll
        for (int i = 0; i < 4; ++i) { v[i] = nv.get(i); ss += v[i][0] * v[i][0] + v[i][1] * v[i][1] + v[i][2] * v[i][2] + v[i][3] * v[i][3]; }
        { const int rn = row + 8;
          if (rn < rb1) nv.load(rn >= NL ? srcC + (size_t)(rn - NL) * RBC : srcL + (size_t)rn * RB, F.lane); }
        ss = wave_sum(ss, F.lane);
        const float r = rsqrtf(ss * (1.0f / DM) + EPS);
#pragma unroll
        for (int i = 0; i < 4; ++i) { const int k = i * 256 + F.lane * 4;
            v[i] = (v[i] * r) * fac[i] + sft[i];
            if (u8) *(unsigned*)((unsigned char*)U + (size_t)row * DM + k) = pack4_fp8(v[i][0], v[i][1], v[i][2], v[i][3]);
            else { u32x2 w; w.x = cvt_pk_bf16(v[i][0], v[i][1]); w.y = cvt_pk_bf16(v[i][2], v[i][3]); *(u32x2*)(U + (size_t)row * DM + k) = w; } }
        if (which == 0) {
            float p[16];
#pragma unroll
            for (int c = 0; c < 16; ++c) { f32x2 s2 = {0.f, 0.f};
#pragma unroll
                for (int i = 0; i < 4; ++i) { const f32x4 w4 = *(const LAS f32x4*)(W + c * 1024 + i * 256 + F.lane * 4);
                    s2 += (f32x2){v[i][0], v[i][1]} * (f32x2){w4[0], w4[1]}; s2 += (f32x2){v[i][2], v[i][3]} * (f32x2){w4[2], w4[3]}; }
                p[c] = s2[0] + s2[1]; }
            { const bool hi = F.lane & 32;
#pragma unroll
              for (int i = 0; i < 8; ++i) { const float keep = hi ? p[i + 8] : p[i], send = hi ? p[i] : p[i + 8]; p[i] = keep + lx_xor(send, 32, F.lane); } }
            { const bool hi = F.lane & 16;
#pragma unroll
              for (int i = 0; i < 4; ++i) { const float keep = hi ? p[i + 4] : p[i], send = hi ? p[i] : p[i + 4]; p[i] = keep + lx_xor(send, 16, F.lane); } }
            { const bool hi = F.lane & 8;
#pragma unroll
              for (int i = 0; i < 2; ++i) { const float keep = hi ? p[i + 2] : p[i], send = hi ? p[i] : p[i + 2]; p[i] = keep + lx_xor(send, 8, F.lane); } }
            { const bool hi = F.lane & 4; const float keep = hi ? p[1] : p[0], send = hi ? p[0] : p[1]; p[0] = keep + lx_xor(send, 4, F.lane); }
            p[0] += lx_xor(p[0], 2, F.lane); p[0] += lx_xor(p[0], 1, F.lane);
            if ((F.lane & 3) == 0) { const int c = ((F.lane >> 5) & 1) * 8 + ((F.lane >> 4) & 1) * 4 + ((F.lane >> 3) & 1) * 2 + ((F.lane >> 2) & 1);
                ((float*)(F.ws + WS_GATES))[(size_t)row * 16 + c] = p[0] + bif[c]; }
        } else if (which == 2) {
            float p[8];
#pragma unroll
            for (int c = 0; c < 8; ++c) { f32x2 s2 = {0.f, 0.f};
#pragma unroll
                for (int i = 0; i < 4; ++i) { const f32x4 w4 = *(const LAS f32x4*)(W + c * 1024 + i * 256 + F.lane * 4);
                    s2 += (f32x2){v[i][0], v[i][1]} * (f32x2){w4[0], w4[1]}; s2 += (f32x2){v[i][2], v[i][3]} * (f32x2){w4[2], w4[3]}; }
                p[c] = s2[0] + s2[1]; }
            { const bool hi = F.lane & 32;
#pragma unroll
              for (int i = 0; i < 4; ++i) { const float keep = hi ? p[i + 4] : p[i], send = hi ? p[i] : p[i + 4]; p[i] = keep + lx_xor(send, 32, F.lane); } }
            { const bool hi = F.lane & 16;
#pragma unroll
              for (int i = 0; i < 2; ++i) { const float keep = hi ? p[i + 2] : p[i], send = hi ? p[i] : p[i + 2]; p[i] = keep + lx_xor(send, 16, F.lane); } }
            { const bool hi = F.lane & 8; const float keep = hi ? p[1] : p[0], send = hi ? p[0] : p[1]; p[0] = keep + lx_xor(send, 8, F.lane); }
            p[0] += lx_xor(p[0], 4, F.lane); p[0] += lx_xor(p[0], 2, F.lane); p[0] += lx_xor(p[0], 1, F.lane);
            if ((F.lane & 7) == 0) { const int c = ((F.lane >> 5) & 1) * 4 + ((F.lane >> 4) & 1) * 2 + ((F.lane >> 3) & 1); rlog[(row - rb0) * 8 + c] = p[0]; }
        }
    }
    if (which == 2) {
        __syncthreads();
        const int nr = rb1 - rb0; int e0 = 0, e1 = 0, k0 = 0, k1 = 0; float p0 = 0.f, p1 = 0.f;
        const bool act = F.tid < nr;
        if (act) {
            float lg[8];
#pragma unroll
            for (int e = 0; e < 8; ++e) lg[e] = rlog[F.tid * 8 + e];
            float v0 = lg[0]; e0 = 0;
#pragma unroll
            for (int e = 1; e < 8; ++e) if (lg[e] > v0) { v0 = lg[e]; e0 = e; }
            float v1 = -3.0e38f; e1 = -1;
#pragma unroll
            for (int e = 0; e < 8; ++e) if (e != e0 && (e1 < 0 || lg[e] > v1)) { v1 = lg[e]; e1 = e; }
            p0 = 1.0f / (1.0f + __expf(v1 - v0)); p1 = 1.0f - p0;
            k0 = atomicAdd((int*)(lcnt + e0), 1); k1 = atomicAdd((int*)(lcnt + e1), 1);
        }
        __syncthreads();
        if (F.tid < 8) lcnt[8 + F.tid] = (int)__hip_atomic_fetch_add(F.ctl + CW_ECNT + 64 * F.tid, (unsigned)lcnt[F.tid], __ATOMIC_RELAXED, __HIP_MEMORY_SCOPE_AGENT);
        __syncthreads();
        if (act) { const int tok = rb0 + F.tid; int* list = (int*)(F.ws + WS_RLIST); float* prob = (float*)(F.ws + WS_RPROB);
            list[(size_t)e0 * NL + lcnt[8 + e0] + k0] = tok * 2; list[(size_t)e1 * NL + lcnt[8 + e1] + k1] = tok * 2 + 1;
            prob[tok * 2] = p0; prob[tok * 2 + 1] = p1; }
        __syncthreads();
    }
}

__device__ __forceinline__ void final_phase(const Frame& F) {
    const float* modl = (const float*)(F.ws + WS_MOD) + (size_t)1 * 9 * 6144;
    const bf16_t* Y0 = (const bf16_t*)(F.ws + WS_Y); const bf16_t* Y1 = Y0 + (size_t)NL * DM; const float* gfin = F.in(I_GFINAL);
    const bf16_t* H = (const bf16_t*)F.out;
    u32x2 nh[4]; u32x2 na[4], nb[4];
    f32x4 gfv[4], gtv[4]; int bcur = -1;
#pragma unroll
    for (int i = 0; i < 4; ++i) gfv[i] = *(const f32x4*)(gfin + i * 256 + F.lane * 4);
    const int stride = F.G * 8;
    { const int row = F.bid * 8 + F.wave;
      if (row < NL) {
#pragma unroll
          for (int i = 0; i < 4; ++i) { const int k = i * 256 + F.lane * 4; nh[i] = *(const u32x2*)(H + (size_t)row * HLD + k);
              na[i] = *(const u32x2*)(Y0 + (size_t)row * DM + k); nb[i] = *(const u32x2*)(Y1 + (size_t)row * DM + k); } } }
    for (int row = F.bid * 8 + F.wave; row < NL; row += stride) {
        float* hr = F.out + (size_t)row * DM;
        if ((row >> 12) != bcur) { bcur = row >> 12; const float* gt = modl + (size_t)bcur * 6144 + MOD_GT2;
#pragma unroll
            for (int i = 0; i < 4; ++i) gtv[i] = *(const f32x4*)(gt + i * 256 + F.lane * 4); }
        f32x4 v[4]; u32x2 ya[4], yb[4];
#pragma unroll
        for (int i = 0; i < 4; ++i) { v[i] = (f32x4){bf_lo(nh[i].x), bf_hi(nh[i].x), bf_lo(nh[i].y), bf_hi(nh[i].y)}; ya[i] = na[i]; yb[i] = nb[i]; }
        { const int rn = row + stride;
          if (rn < NL) {
#pragma unroll
              for (int i = 0; i < 4; ++i) { const int k = i * 256 + F.lane * 4; nh[i] = *(const u32x2*)(H + (size_t)rn * HLD + k);
                  na[i] = *(const u32x2*)(Y0 + (size_t)rn * DM + k); nb[i] = *(const u32x2*)(Y1 + (size_t)rn * DM + k); } } }
        float ss = 0.f;
#pragma unroll
        for (int i = 0; i < 4; ++i) { const int k = i * 256 + F.lane * 4; const u32x2 a = ya[i], b = yb[i];
            const f32x4 y = (f32x4){bf_lo(a.x) + bf_lo(b.x), bf_hi(a.x) + bf_hi(b.x), bf_lo(a.y) + bf_lo(b.y), bf_hi(a.y) + bf_hi(b.y)};
            v[i] += gtv[i] * y;
            ss += v[i][0] * v[i][0] + v[i][1] * v[i][1] + v[i][2] * v[i][2] + v[i][3] * v[i][3]; }
        ss = wave_sum(ss, F.lane);
        const float r = rsqrtf(ss * (1.0f / DM) + EPS);
#pragma unroll
        for (int i = 0; i < 4; ++i) { const int k = i * 256 + F.lane * 4; *(f32x4*)(hr + k) = (v[i] * r) * gfv[i]; }
    }
}

__device__ __forceinline__ float logsigmoid(float x) { return fminf(x, 0.f) - log1pf(__expf(-fabsf(x))); }
__device__ __forceinline__ float scan_add(float v, int lane) {
#pragma unroll
    for (int o = 1; o < 64; o <<= 1) { const float t = lx_up(v, o, lane); if (lane >= o) v += t; }
    return v;
}
__device__ __forceinline__ float scan_max(float v, int lane) {
#pragma unroll
    for (int o = 1; o < 64; o <<= 1) { const float t = lx_up(v, o, lane); if (lane >= o) v = fmaxf(v, t); }
    return v;
}
__device__ __forceinline__ void prep_phase(const Frame& F, int l) {
    bf16_t* QKV = (bf16_t*)(F.ws + WS_R1); const bf16_t* halo = (const bf16_t*)(F.ws + WS_HALO);
    bf16_t* KT = (bf16_t*)(F.ws + WS_KT); bf16_t* VT = (bf16_t*)(F.ws + WS_VT);
    const float* cw = F.in(I_CONV) + (size_t)l * 3 * 2048;
    LAS bf16_t* T = (LAS bf16_t*)F.lds;
    constexpr int TP = 258;
    const int cg = F.tid & 31, rg = F.tid >> 5;
    { const float* gates = (const float*)(F.ws + WS_GATES); f32x4* gsc = (f32x4*)(F.ws + WS_GSC);
      for (int task = F.bid * 8 + F.wave; task < NCHUNK * 8; task += F.G * 8) {
          const int ci = task >> 3, dh = task & 7, dir = dh >> 2, h = dh & 3, rr = dir ? 63 - F.lane : F.lane;
          const float ig = gates[(size_t)(ci * 64 + rr) * 16 + dir * 8 + h], fp = gates[(size_t)(ci * 64 + rr) * 16 + dir * 8 + 4 + h];
          const float bcum = scan_add(logsigmoid(fp), F.lane), a_ = ig - bcum, pmax = scan_max(a_, F.lane);
          gsc[(size_t)task * 64 + rr] = (f32x4){a_, bcum, pmax, 0.f}; } }
#if MLSTM_TR
    {
        u32x4 nraw[6];
#define PREP_LOAD(un_) do { const int _ci = (un_) >> 3, _hc = (un_) & 7, _row0 = _ci * 64, _col0 = _hc * 256 + cg * 8; bool _first, _lastc; \
        if (_ci < NCHUNK_L) { _first = (_ci & 63) == 0; _lastc = (_ci & 63) == 63; } else { const int _cc = _ci - NCHUNK_L; _first = (_cc & 3) == 0; _lastc = (_cc & 3) == 3; } \
        _Pragma("unroll") for (int i = 0; i < 6; ++i) { const int r = rg * 4 - 1 + i; \
            if (r < 0) nraw[i] = _first ? (u32x4){0u, 0u, 0u, 0u} : *(const u32x4*)(halo + ((size_t)(_ci - 1) * 2 + 1) * 2048 + _col0); \
            else if (r > 63) nraw[i] = _lastc ? (u32x4){0u, 0u, 0u, 0u} : *(const u32x4*)(halo + ((size_t)(_ci + 1) * 2 + 0) * 2048 + _col0); \
            else nraw[i] = *(const u32x4*)(QKV + (size_t)(_row0 + r) * NQKV + _col0); } } while (0)
        f32x4 w[3][2]; int hcw = -1;
        if (F.bid < NCHUNK * 8) PREP_LOAD(F.bid);
        for (int un = F.bid; un < NCHUNK * 8; un += F.G) {
            const int ci = un >> 3, hc = un & 7, row0 = ci * 64, col0 = hc * 256 + cg * 8;
            u32x4 raw[6];
#pragma unroll
            for (int i = 0; i < 6; ++i) raw[i] = nraw[i];
            if (hc != hcw) { hcw = hc;
#pragma unroll
                for (int j = 0; j < 3; ++j) { w[j][0] = *(const f32x4*)(cw + j * 2048 + col0); w[j][1] = *(const f32x4*)(cw + j * 2048 + col0 + 4); } }
            if (un + F.G < NCHUNK * 8) PREP_LOAD(un + F.G);
            const float scl = hc >= 4 ? 0.0625f : 1.0f;
            f32x4 x[6][2]; u32x4 ow[4];
#pragma unroll
            for (int i = 0; i < 6; ++i) unpack8(raw[i], x[i][0], x[i][1]);
#pragma unroll
            for (int i = 0; i < 4; ++i) { f32x4 o[2];
#pragma unroll
                for (int hh = 0; hh < 2; ++hh) { o[hh] = x[i][hh] * w[0][hh] + x[i + 1][hh] * w[1][hh] + x[i + 2][hh] * w[2][hh];
#pragma unroll
                    for (int j = 0; j < 4; ++j) o[hh][j] = silu(o[hh][j]) * scl; }
                ow[i] = pack8(o[0], o[1]); }
            __syncthreads();
#pragma unroll
            for (int i = 0; i < 4; ++i) *(u32x4*)(QKV + (size_t)(row0 + rg * 4 + i) * NQKV + col0) = ow[i];
        }
#undef PREP_LOAD
        return;
    }
#endif
    constexpr int NHC = 12;
    for (int un = F.bid; un < NCHUNK * NHC; un += F.G) {
        const int ci = un / NHC, hc = un % NHC, row0 = ci * 64, col0 = hc * 256 + cg * 8;
        bool first, lastc;
        if (ci < NCHUNK_L) { first = (ci & 63) == 0; lastc = (ci & 63) == 63; } else { const int cc = ci - NCHUNK_L; first = (cc & 3) == 0; lastc = (cc & 3) == 3; }
        u32x4 ow[4];
        if (hc < 8) {
            u32x4 raw[6];
#pragma unroll
            for (int i = 0; i < 6; ++i) { const int r = rg * 4 - 1 + i;
                if (r < 0) raw[i] = first ? (u32x4){0u, 0u, 0u, 0u} : *(const u32x4*)(halo + ((size_t)(ci - 1) * 2 + 1) * 2048 + col0);
                else if (r > 63) raw[i] = lastc ? (u32x4){0u, 0u, 0u, 0u} : *(const u32x4*)(halo + ((size_t)(ci + 1) * 2 + 0) * 2048 + col0);
                else raw[i] = *(const u32x4*)(QKV + (size_t)(row0 + r) * NQKV + col0); }
            f32x4 w[3][2];
#pragma unroll
            for (int j = 0; j < 3; ++j) { w[j][0] = *(const f32x4*)(cw + j * 2048 + col0); w[j][1] = *(const f32x4*)(cw + j * 2048 + col0 + 4); }
            const float scl = hc >= 4 ? 0.0625f : 1.0f;
            f32x4 x[6][2];
#pragma unroll
            for (int i = 0; i < 6; ++i) unpack8(raw[i], x[i][0], x[i][1]);
#pragma unroll
            for (int i = 0; i < 4; ++i) { f32x4 o[2];
#pragma unroll
                for (int hh = 0; hh < 2; ++hh) { o[hh] = x[i][hh] * w[0][hh] + x[i + 1][hh] * w[1][hh] + x[i + 2][hh] * w[2][hh];
#pragma unroll
                    for (int j = 0; j < 4; ++j) o[hh][j] = silu(o[hh][j]) * scl; }
                ow[i] = pack8(o[0], o[1]); }
            __syncthreads();
#pragma unroll
            for (int i = 0; i < 4; ++i) *(u32x4*)(QKV + (size_t)(row0 + rg * 4 + i) * NQKV + col0) = ow[i];
        } else {
#pragma unroll
            for (int i = 0; i < 4; ++i) ow[i] = *(const u32x4*)(QKV + (size_t)(row0 + rg * 4 + i) * NQKV + col0);
        }
        if (hc >= 4 && !MLSTM_TR) {
#pragma unroll
            for (int i = 0; i < 4; ++i) { LAS unsigned* tp = (LAS unsigned*)(T + (rg * 4 + i) * TP + cg * 8);
                tp[0] = ow[i].x; tp[1] = ow[i].y; tp[2] = ow[i].z; tp[3] = ow[i].w; }
            __syncthreads();
            bf16_t* dst = (hc < 8 ? KT : VT) + ((size_t)ci * 4 + (hc & 3)) * (256 * 64);
#pragma unroll
            for (int o = 0; o < 4; ++o) { const int idx = F.tid + o * NTHREADS, d = idx >> 3, sc = idx & 7; unsigned short v[8];
#pragma unroll
                for (int j = 0; j < 8; ++j) v[j] = T[(sc * 8 + j) * TP + d];
                u32x4 w; w.x = v[0] | ((unsigned)v[1] << 16); w.y = v[2] | ((unsigned)v[3] << 16); w.z = v[4] | ((unsigned)v[5] << 16); w.w = v[6] | ((unsigned)v[7] << 16);
                *(u32x4*)(dst + (size_t)d * 64 + sc * 8) = w; }
            __syncthreads();
        }
    }
}

__device__ __forceinline__ void mlstm_phase_ref(const Frame& F, int l) {
    const bf16_t* QKV = (const bf16_t*)(F.ws + WS_R1); const float* gates = (const float*)(F.ws + WS_GATES);
    LAS bf16_t* Qs = (LAS bf16_t*)F.lds;
    LAS bf16_t* Ks = (LAS bf16_t*)(F.lds + 32768);
    LAS float* Cs = (LAS float*)(F.lds + 65536);
    LAS bf16_t* Vs = (LAS bf16_t*)(F.lds + 131072);
    LAS bf16_t* Ps = (LAS bf16_t*)(F.lds + 139264);
    LAS float* sc = (LAS float*)(F.lds + 147456);
    LAS float* s_a = sc, *s_mj = sc + 64, *s_wi = sc + 128, *s_en = sc + 192, *s_wk = sc + 256, *s_den = sc + 320, *s_n = sc + 384;
    const int tid = F.tid, lane = F.lane;
    for (int un = F.bid; un < 256; un += F.G) {
        const int xcd = un & 7, q = un >> 3, seq = xcd * 8 + (q >> 2), es = q & 3;
        const int b = seq >> 3, h = (seq >> 1) & 3, dir = seq & 1;
        bf16_t* HO = (bf16_t*)(F.ws + (dir ? WS_HB : WS_HF));
        for (int i = tid; i < 256 * 64; i += NTHREADS) Cs[i] = 0.f;
        if (tid < 256) s_n[tid] = 0.f;
        float m_st = 0.f;
        __syncthreads();
        for (int step = 0; step < 68; ++step) {
            const bool isctx = step < 4; const int cidx = isctx ? step : step - 4, nch = isctx ? 4 : 64;
            const int cact = dir ? (nch - 1 - cidx) : cidx;
            const int row0 = isctx ? (NL + b * CTXL + cact * 64) : (b * SEQ + cact * 64);
#pragma unroll
            for (int o = 0; o < 4; ++o) { const int idx = tid + o * NTHREADS, r = idx >> 5, c8 = (idx & 31) * 8;
                const u32x4 qv = *(const u32x4*)(QKV + (size_t)(row0 + r) * NQKV + h * 256 + c8);
                const u32x4 kv = *(const u32x4*)(QKV + (size_t)(row0 + r) * NQKV + 1024 + h * 256 + c8);
                *(LAS u32x4*)(Qs + r * 256 + c8) = qv; *(LAS u32x4*)(Ks + r * 256 + c8) = kv; }
            { const int r = tid >> 3, c8 = (tid & 7) * 8;
              *(LAS u32x4*)(Vs + r * 64 + c8) = *(const u32x4*)(QKV + (size_t)(row0 + r) * NQKV + 2048 + h * 256 + es * 64 + c8); }
            float wc;
            { const int r = dir ? 63 - lane : lane;
              const float ig = gates[(size_t)(row0 + r) * 16 + dir * 8 + h], fp = gates[(size_t)(row0 + r) * 16 + dir * 8 + 4 + h];
              const float fc = logsigmoid(fp);
              const float bcum = scan_add(fc, lane);
              const float blast = lx_idx(bcum, 63);
              const float a = ig - bcum;
              const float pmax = scan_max(a, lane);
              const float mj = fmaxf(m_st, pmax);
              const float gend = blast + a;
              const float mnew = fmaxf(blast + m_st, wave_max(gend, lane));
              const float wk = __expf(gend - mnew);
              wc = __expf(blast + m_st - mnew);
              if (F.wave == 0) { s_a[r] = a; s_mj[r] = mj; s_wi[r] = __expf(m_st - mj); s_en[r] = __expf(-(bcum + mj)); s_wk[r] = wk; }
              m_st = mnew; }
            __syncthreads();
            { const int j = tid >> 3, sg = tid & 7; float acc[8];
#pragma unroll
              for (int i = 0; i < 8; ++i) acc[i] = 0.f;
#pragma unroll 2
              for (int kk = 0; kk < 32; ++kk) { const u32x4 qv = *(const LAS u32x4*)(Qs + j * 256 + kk * 8);
                  const float q0 = bf_lo(qv.x), q1 = bf_hi(qv.x), q2 = bf_lo(qv.y), q3 = bf_hi(qv.y), q4 = bf_lo(qv.z), q5 = bf_hi(qv.z), q6 = bf_lo(qv.w), q7 = bf_hi(qv.w);
#pragma unroll
                  for (int i = 0; i < 8; ++i) { const u32x4 kv = *(const LAS u32x4*)(Ks + (sg * 8 + i) * 256 + kk * 8);
                      acc[i] += q0 * bf_lo(kv.x) + q1 * bf_hi(kv.x) + q2 * bf_lo(kv.y) + q3 * bf_hi(kv.y) + q4 * bf_lo(kv.z) + q5 * bf_hi(kv.z) + q6 * bf_lo(kv.w) + q7 * bf_hi(kv.w); } }
              const float mjj = s_mj[j]; float rs = 0.f; float pv[8];
#pragma unroll
              for (int i = 0; i < 8; ++i) { const int s = sg * 8 + i; const bool ok = dir ? (s >= j) : (s <= j);
                  pv[i] = ok ? acc[i] * __expf(s_a[s] - mjj) : 0.f; rs += pv[i]; }
              u32x4 pw; pw.x = cvt_pk_bf16(pv[0], pv[1]); pw.y = cvt_pk_bf16(pv[2], pv[3]); pw.z = cvt_pk_bf16(pv[4], pv[5]); pw.w = cvt_pk_bf16(pv[6], pv[7]);
              *(LAS u32x4*)(Ps + j * 64 + sg * 8) = pw;
              rs += lx_xor(rs, 1, F.lane); rs += lx_xor(rs, 2, F.lane); rs += lx_xor(rs, 4, F.lane);
              if (sg == 0) s_den[j] = rs; }
            __syncthreads();
            { const int e = tid & 63, jg = tid >> 6; float acc[8], qn[8];
#pragma unroll
              for (int i = 0; i < 8; ++i) { acc[i] = 0.f;
                  const u32x2 qq = *(const LAS u32x2*)(Qs + (jg * 8 + i) * 256 + e * 4); const f32x4 nn = *(const LAS f32x4*)(s_n + e * 4);
                  qn[i] = wave_sum(bf_lo(qq.x) * nn[0] + bf_hi(qq.x) * nn[1] + bf_lo(qq.y) * nn[2] + bf_hi(qq.y) * nn[3], lane); }
#pragma unroll 4
              for (int d = 0; d < 256; d += 2) { const float c0 = Cs[d * 64 + e], c1 = Cs[(d + 1) * 64 + e];
#pragma unroll
                  for (int i = 0; i < 8; ++i) { const unsigned qq = *(const LAS unsigned*)(Qs + (jg * 8 + i) * 256 + d); acc[i] += bf_lo(qq) * c0 + bf_hi(qq) * c1; } }
#pragma unroll
              for (int i = 0; i < 8; ++i) acc[i] *= s_wi[jg * 8 + i];
#pragma unroll 4
              for (int s = 0; s < 64; s += 2) { const float v0 = bf2f(Vs[s * 64 + e]), v1 = bf2f(Vs[(s + 1) * 64 + e]);
#pragma unroll
                  for (int i = 0; i < 8; ++i) { const unsigned pp = *(const LAS unsigned*)(Ps + (jg * 8 + i) * 64 + s); acc[i] += bf_lo(pp) * v0 + bf_hi(pp) * v1; } }
              if (!isctx || l == 0) {
#pragma unroll
                  for (int i = 0; i < 8; ++i) { const int j = jg * 8 + i; const float den = s_wi[j] * qn[i] + s_den[j];
                      HO[(size_t)(row0 + j) * DM + h * 256 + es * 64 + e] = f2bf(acc[i] / fmaxf(fabsf(den), s_en[j])); } } }
            __syncthreads();
            { const int e = tid & 63, dg = tid >> 6;
#pragma unroll 1
              for (int sh = 0; sh < 64; sh += 32) { float vv[32]; const float cf = sh == 0 ? wc : 1.0f;
#pragma unroll
                  for (int s = 0; s < 32; ++s) vv[s] = s_wk[sh + s] * bf2f(Vs[(sh + s) * 64 + e]);
#pragma unroll 1
                  for (int i = 0; i < 32; i += 2) { const int d = dg * 32 + i; float a0 = cf * Cs[d * 64 + e], a1 = cf * Cs[(d + 1) * 64 + e];
#pragma unroll
                      for (int s = 0; s < 32; ++s) { const unsigned kk = *(const LAS unsigned*)(Ks + (sh + s) * 256 + d); a0 += bf_lo(kk) * vv[s]; a1 += bf_hi(kk) * vv[s]; }
                      Cs[d * 64 + e] = a0; Cs[(d + 1) * 64 + e] = a1; } }
              if (tid < 256) { float nn = wc * s_n[tid];
                  for (int s = 0; s < 64; ++s) nn += s_wk[s] * bf2f(Ks[s * 256 + tid]);
                  s_n[tid] = nn; } }
            __syncthreads();
        }
    }
}

#define LDS_BARRIER() do { asm volatile("s_waitcnt lgkmcnt(0)" ::: "memory"); __builtin_amdgcn_s_barrier(); asm volatile("" ::: "memory"); } while (0)
__device__ __forceinline__ void mlstm_phase_mfma(const Frame& F, int l) {
    constexpr int QP = 528, TP = 144;
    constexpr int O_Q = 0, O_K = 33792, O_KT = 67584, O_CT = 104448, O_VT = O_CT + 65 * QP, O_P = O_VT + 65 * TP, O_SC = O_P + 64 * TP;
    constexpr int SC_PAR = 1280;
    constexpr int O_DEN = O_SC + 2 * SC_PAR, O_MISC = O_DEN + 256, O_RAW = O_MISC + 64;
    static_assert(O_RAW + 2048 <= LDS_BYTES - 16, "mlstm LDS map");
    const bf16_t* QKV = (const bf16_t*)(F.ws + WS_R1); const f32x4* gsc = (const f32x4*)(F.ws + WS_GSC);
    const bf16_t* KTg = (const bf16_t*)(F.ws + WS_KT); const bf16_t* VTg = (const bf16_t*)(F.ws + WS_VT);
    LAS unsigned char* lds = F.lds;
    const int tid = F.tid, lane = F.lane, w = F.wave, r16 = lane & 15, g = lane >> 4;
    const int jh = w & 1, mg = w >> 1; const bool isS = mg < 2; const int nmt = mg == 3 ? 3 : 2;
    for (int un = F.bid; un < 256; un += F.G) {
        const int xcd = un & 7, q = un >> 3, seq = xcd * 8 + (q >> 2), es = q & 3;
        const int b = seq >> 3, h = (seq >> 1) & 3, dir = seq & 1;
        bf16_t* HO = (bf16_t*)(F.ws + (dir ? WS_HB : WS_HF));
        __syncthreads();
        for (int i = tid; i < 65 * QP / 4; i += NTHREADS) ((LAS unsigned*)(lds + O_CT))[i] = 0u;
        if (tid < 32) ((LAS unsigned*)(lds + O_VT + 64 * TP))[tid] = 0x3F803F80u;
        f32x4 accC[2][5];
#pragma unroll
        for (int a = 0; a < 2; ++a)
#pragma unroll
            for (int e = 0; e < 5; ++e) accC[a][e] = (f32x4){0.f, 0.f, 0.f, 0.f};
        float m_st = 0.f;
        u32x4 rq[4], rk[4], rt[4], rv; f32x4 gs4 = {0.f, 0.f, 0.f, 0.f}; int row0n = 0;
#define ML_LOAD(step_) do { const int _st = (step_); const bool _ic = _st < 4; const int _ci = _ic ? _st : _st - 4, _n = _ic ? 4 : 64, _ca = dir ? (_n - 1 - _ci) : _ci; \
        row0n = _ic ? (NL + b * CTXL + _ca * 64) : (b * SEQ + _ca * 64); const size_t _tile = (size_t)(row0n >> 6) * 4 + h; \
        _Pragma("unroll") for (int o = 0; o < 4; ++o) { const int idx = tid + o * NTHREADS, r = idx >> 5, c8 = (idx & 31) * 8; \
            rq[o] = *(const u32x4*)(QKV + (size_t)(row0n + r) * NQKV + h * 256 + c8); rk[o] = *(const u32x4*)(QKV + (size_t)(row0n + r) * NQKV + 1024 + h * 256 + c8); \
            rt[o] = *(const u32x4*)(KTg + _tile * 16384 + (size_t)idx * 8); } \
        rv = *(const u32x4*)(VTg + _tile * 16384 + (size_t)es * 4096 + (size_t)tid * 8); } while (0)
#define ML_SCAL(par_) do { LAS float* sp = (LAS float*)(lds + O_SC + (par_) * SC_PAR); const int lastr = dir ? 0 : 63; \
        const f32x4 g4 = *(const LAS f32x4*)(lds + O_RAW + (par_) * 1024 + lane * 16); const float a_ = g4[0], bcum = g4[1], pmax = g4[2]; \
        const float blast = __int_as_float(__builtin_amdgcn_readlane(__float_as_int(bcum), lastr)), gmax = blast + __int_as_float(__builtin_amdgcn_readlane(__float_as_int(pmax), lastr)); \
        const float mj = fmaxf(m_st, pmax), mnew = fmaxf(blast + m_st, gmax); \
        sp[lane] = a_; sp[64 + lane] = mj; sp[128 + lane] = __expf(m_st - mj); sp[192 + lane] = __expf(-(bcum + mj)); sp[256 + lane] = __expf(blast + a_ - mnew); \
        if (lane == 0) ((LAS float*)(lds + O_MISC))[(par_)] = __expf(blast + m_st - mnew); m_st = mnew; } while (0)
#define ML_STORE() do { _Pragma("unroll") for (int jt = 0; jt < 2; ++jt) \
        *(u32x4*)(HO + (size_t)(prow0 + jh * 32 + jt * 16 + r16) * DM + h * 256 + es * 64 + (mg - 2) * 32 + 8 * g) = (u32x4){pow_[jt][0].x, pow_[jt][0].y, pow_[jt][1].x, pow_[jt][1].y}; } while (0)
        u32x2 pow_[2][2]; bool pend = false; int prow0 = 0;
#define ML_ROW0(step_) (((step_) < 4) ? (NL + b * CTXL + (dir ? (3 - (step_)) : (step_)) * 64) : (b * SEQ + (dir ? (63 - ((step_) - 4)) : ((step_) - 4)) * 64))
        gs4 = gsc[((size_t)(ML_ROW0(0) >> 6) * 8 + dir * 4 + h) * 64 + lane];
        if (w == 0) *(LAS f32x4*)(lds + O_RAW + lane * 16) = gs4;
        gs4 = gsc[((size_t)(ML_ROW0(1) >> 6) * 8 + dir * 4 + h) * 64 + lane];
        ML_LOAD(0);
        if (w == 0) ML_SCAL(0);
        LDS_BARRIER();
        for (int step = 0; step < 68; ++step) {
            const int p = step & 1; const int row0 = row0n; const bool wr_out = (step >= 4) || (l == 0);
            const LAS float* sp = (const LAS float*)(lds + O_SC + p * SC_PAR);
            const f32x4 wkA = *(const LAS f32x4*)(sp + 256 + (tid & 7) * 8), wkB = *(const LAS f32x4*)(sp + 256 + (tid & 7) * 8 + 4);
#pragma unroll
            for (int o = 0; o < 4; ++o) { const int idx = tid + o * NTHREADS, r = idx >> 5, c8 = (idx & 31) * 8;
                *(LAS u32x4*)(lds + O_Q + r * QP + c8 * 2) = rq[o]; *(LAS u32x4*)(lds + O_K + r * QP + c8 * 2) = rk[o];
                { const u32x4 rw = rt[o]; u32x4 sw;
                  sw.x = cvt_pk_bf16(bf_lo(rw.x) * wkA[0], bf_hi(rw.x) * wkA[1]); sw.y = cvt_pk_bf16(bf_lo(rw.y) * wkA[2], bf_hi(rw.y) * wkA[3]);
                  sw.z = cvt_pk_bf16(bf_lo(rw.z) * wkB[0], bf_hi(rw.z) * wkB[1]); sw.w = cvt_pk_bf16(bf_lo(rw.w) * wkB[2], bf_hi(rw.w) * wkB[3]);
                  *(LAS u32x4*)(lds + O_KT + (idx >> 3) * TP + (idx & 7) * 16) = sw; } }
            { const int ev = tid >> 3, evr = (ev & 32) | ((ev & 4) << 2) | ((ev & 24) >> 1) | (ev & 3);
              *(LAS u32x4*)(lds + O_VT + evr * TP + (tid & 7) * 16) = rv; }
            if (w == 0) *(LAS f32x4*)(lds + O_RAW + (p ^ 1) * 1024 + lane * 16) = gs4;
            { const int sn = step + 2 < 68 ? step + 2 : 67; gs4 = gsc[((size_t)(ML_ROW0(sn) >> 6) * 8 + dir * 4 + h) * 64 + lane]; }
            LDS_BARRIER();
            if (pend) { ML_STORE(); pend = false; }
            if (step + 1 < 68) ML_LOAD(step + 1);
            f32x4 acc[3][2];
#pragma unroll
            for (int t = 0; t < 3; ++t) { acc[t][0] = (f32x4){0.f, 0.f, 0.f, 0.f}; acc[t][1] = acc[t][0]; }
            { const int abase = (isS ? O_K + mg * 32 * QP : O_CT + (mg - 2) * 32 * QP) + r16 * QP + g * 16;
              const int qbase = O_Q + (jh * 32 + r16) * QP + g * 16;
#pragma unroll
              for (int ks = 0; ks < 8; ++ks) {
                  const bf16x8 b0 = *(const LAS bf16x8*)(lds + qbase + ks * 64), b1 = *(const LAS bf16x8*)(lds + qbase + 16 * QP + ks * 64);
                  const bf16x8 a0 = *(const LAS bf16x8*)(lds + abase + ks * 64), a1 = *(const LAS bf16x8*)(lds + abase + 16 * QP + ks * 64);
                  acc[0][0] = __builtin_amdgcn_mfma_f32_16x16x32_bf16(a0, b0, acc[0][0], 0, 0, 0); acc[0][1] = __builtin_amdgcn_mfma_f32_16x16x32_bf16(a0, b1, acc[0][1], 0, 0, 0);
                  acc[1][0] = __builtin_amdgcn_mfma_f32_16x16x32_bf16(a1, b0, acc[1][0], 0, 0, 0); acc[1][1] = __builtin_amdgcn_mfma_f32_16x16x32_bf16(a1, b1, acc[1][1], 0, 0, 0);
                  if (nmt == 3) { const bf16x8 a2 = *(const LAS bf16x8*)(lds + abase + 32 * QP + ks * 64);
                      acc[2][0] = __builtin_amdgcn_mfma_f32_16x16x32_bf16(a2, b0, acc[2][0], 0, 0, 0); acc[2][1] = __builtin_amdgcn_mfma_f32_16x16x32_bf16(a2, b1, acc[2][1], 0, 0, 0); } } }
            if (isS) {
#pragma unroll
                for (int t = 0; t < 2; ++t) { const int s0 = mg * 32 + t * 16 + 4 * g; const f32x4 as = *(const LAS f32x4*)(sp + s0);
#pragma unroll
                    for (int jt = 0; jt < 2; ++jt) { const int j = jh * 32 + jt * 16 + r16; const float mjj = sp[64 + j]; float pv[4];
#pragma unroll
                        for (int i = 0; i < 4; ++i) { const int s = s0 + i; const bool ok = dir ? (s >= j) : (s <= j); pv[i] = ok ? acc[t][jt][i] * __expf(as[i] - mjj) : 0.f; }
                        u32x2 pw; pw.x = cvt_pk_bf16(pv[0], pv[1]); pw.y = cvt_pk_bf16(pv[2], pv[3]);
                        *(LAS u32x2*)(lds + O_P + j * TP + s0 * 2) = pw; } }
            }
            LDS_BARRIER();
            if (!isS) {
#pragma unroll
                for (int jt = 0; jt < 2; ++jt) { const float wi = sp[128 + jh * 32 + jt * 16 + r16];
#pragma unroll
                    for (int t = 0; t < 3; ++t) acc[t][jt] *= wi; }
                const int vbase = O_VT + ((mg - 2) * 32 + r16) * TP + g * 16, pbase = O_P + (jh * 32 + r16) * TP + g * 16;
#pragma unroll
                for (int ks = 0; ks < 2; ++ks) {
                    const bf16x8 b0 = *(const LAS bf16x8*)(lds + pbase + ks * 64), b1 = *(const LAS bf16x8*)(lds + pbase + 16 * TP + ks * 64);
                    const bf16x8 a0 = *(const LAS bf16x8*)(lds + vbase + ks * 64), a1 = *(const LAS bf16x8*)(lds + vbase + 16 * TP + ks * 64);
                    acc[0][0] = __builtin_amdgcn_mfma_f32_16x16x32_bf16(a0, b0, acc[0][0], 0, 0, 0); acc[0][1] = __builtin_amdgcn_mfma_f32_16x16x32_bf16(a0, b1, acc[0][1], 0, 0, 0);
                    acc[1][0] = __builtin_amdgcn_mfma_f32_16x16x32_bf16(a1, b0, acc[1][0], 0, 0, 0); acc[1][1] = __builtin_amdgcn_mfma_f32_16x16x32_bf16(a1, b1, acc[1][1], 0, 0, 0);
                    if (nmt == 3) { const bf16x8 a2 = *(const LAS bf16x8*)(lds + vbase + 32 * TP + ks * 64);
                        acc[2][0] = __builtin_amdgcn_mfma_f32_16x16x32_bf16(a2, b0, acc[2][0], 0, 0, 0); acc[2][1] = __builtin_amdgcn_mfma_f32_16x16x32_bf16(a2, b1, acc[2][1], 0, 0, 0); } }
                if (mg == 3 && g == 0) { LAS float* dn = (LAS float*)(lds + O_DEN); dn[jh * 32 + r16] = acc[2][0][0]; dn[jh * 32 + 16 + r16] = acc[2][1][0]; }
            } else if (w == 0 && step + 1 < 68) { ML_SCAL(p ^ 1); }
            { const float wc = ((const LAS float*)(lds + O_MISC))[p];
#pragma unroll
              for (int a = 0; a < 2; ++a)
#pragma unroll
                  for (int e = 0; e < 5; ++e) accC[a][e] *= wc;
#pragma unroll
              for (int ks = 0; ks < 2; ++ks) {
                  bf16x8 bv[5];
#pragma unroll
                  for (int e = 0; e < 5; ++e) bv[e] = *(const LAS bf16x8*)(lds + O_VT + (e * 16 + r16) * TP + ks * 64 + g * 16);
#pragma unroll
                  for (int a = 0; a < 2; ++a) { const bf16x8 ka = *(const LAS bf16x8*)(lds + O_KT + ((w * 2 + a) * 16 + r16) * TP + ks * 64 + g * 16);
#pragma unroll
                      for (int e = 0; e < 5; ++e) accC[a][e] = __builtin_amdgcn_mfma_f32_16x16x32_bf16(ka, bv[e], accC[a][e], 0, 0, 0); } } }
            LDS_BARRIER();
#pragma unroll
            for (int a = 0; a < 2; ++a)
#pragma unroll
                for (int e = 0; e < 5; ++e) { const int er = e * 16 + r16;
                    if (er <= 64) { u32x2 cw; cw.x = cvt_pk_bf16(accC[a][e][0], accC[a][e][1]); cw.y = cvt_pk_bf16(accC[a][e][2], accC[a][e][3]);
                        *(LAS u32x2*)(lds + O_CT + er * QP + ((w * 2 + a) * 16 + 4 * g) * 2) = cw; } }
            pend = !isS && wr_out; prow0 = row0;
            if (pend) {
#pragma unroll
                for (int jt = 0; jt < 2; ++jt) { const int j = jh * 32 + jt * 16 + r16;
                    const float den = ((const LAS float*)(lds + O_DEN))[j]; const float inv = __builtin_amdgcn_rcpf(fmaxf(fabsf(den), sp[192 + j]));
#pragma unroll
                    for (int t = 0; t < 2; ++t) { pow_[jt][t].x = cvt_pk_bf16(acc[t][jt][0] * inv, acc[t][jt][1] * inv); pow_[jt][t].y = cvt_pk_bf16(acc[t][jt][2] * inv, acc[t][jt][3] * inv); } }
            }
        }
        if (pend) { ML_STORE(); pend = false; }
#undef ML_LOAD
#undef ML_ROW0
#undef ML_SCAL
#undef ML_STORE
    }
}

typedef short s16x4 __attribute__((ext_vector_type(4)));
__device__ __forceinline__ bf16x8 tr_frag(LAS unsigned char* img, int pitch, int ks, int c, int lane) {
    const int g = lane >> 4, q = (lane & 15) >> 2, p = lane & 3;
    LAS unsigned char* a0 = img + (32 * ks + 8 * g + q) * pitch + (16 * c + 4 * p) * 2;
    const s16x4 lo = __builtin_amdgcn_ds_read_tr16_b64_v4i16((LAS s16x4*)a0), hi = __builtin_amdgcn_ds_read_tr16_b64_v4i16((LAS s16x4*)(a0 + 4 * pitch));
    return __builtin_shufflevector(lo, hi, 0, 1, 2, 3, 4, 5, 6, 7);
}
__device__ __forceinline__ void mlstm_phase_tr(const Frame& F, int l) {
    constexpr int QP = 544, KP = 544, VP = 208, TP = 160;
    constexpr int O_Q = 0, O_K = O_Q + 64 * QP, O_VR = O_K + 64 * KP, O_VS = O_VR + 64 * VP, O_CT = O_VS + 64 * VP, O_P = O_CT + 65 * QP, O_SC = O_P + 64 * TP;
    constexpr int SC_PAR = 1280;
    constexpr int O_DEN = O_SC + 2 * SC_PAR, O_MISC = O_DEN + 256, O_RAW = O_MISC + 64;
    static_assert(O_RAW + 2048 <= LDS_BYTES - 16, "mlstm LDS map");
    const bf16_t* QKV = (const bf16_t*)(F.ws + WS_R1); const f32x4* gsc = (const f32x4*)(F.ws + WS_GSC);
    LAS unsigned char* lds = F.lds;
    const int tid = F.tid, lane = F.lane, w = F.wave, r16 = lane & 15, g = lane >> 4;
    const int jh = w & 1, mg = w >> 1; const bool isS = mg < 2; const int nmt = mg == 3 ? 3 : 2;
    for (int un = F.bid; un < 256; un += F.G) {
        const int xcd = un & 7, q = un >> 3, seq = xcd * 8 + (q >> 2), es = q & 3;
        const int b = seq >> 3, h = (seq >> 1) & 3, dir = seq & 1;
        bf16_t* HO = (bf16_t*)(F.ws + (dir ? WS_HB : WS_HF));
        __syncthreads();
        for (int i = tid; i < 65 * QP / 4; i += NTHREADS) ((LAS unsigned*)(lds + O_CT))[i] = 0u;
        if (tid < 64) {
            LAS unsigned short* vr = (LAS unsigned short*)(lds + O_VR + tid * VP + 128); LAS unsigned short* vs = (LAS unsigned short*)(lds + O_VS + tid * VP + 128);
            unsigned one16 = 0x3F80u, zero16 = 0u; asm volatile("" : "+v"(one16), "+v"(zero16));
#pragma unroll
            for (int c = 0; c < 16; ++c) { vr[c] = c == 0 ? (unsigned short)one16 : (unsigned short)zero16; vs[c] = (unsigned short)zero16; } }
        f32x4 accC[2][5];
#pragma unroll
        for (int a = 0; a < 2; ++a)
#pragma unroll
            for (int e = 0; e < 5; ++e) accC[a][e] = (f32x4){0.f, 0.f, 0.f, 0.f};
        float m_st = 0.f;
        u32x4 rq[4], rk[4], rv; f32x4 gs4 = {0.f, 0.f, 0.f, 0.f}; int row0n = 0;
#define ML_LOAD(step_) do { const int _st = (step_); const bool _ic = _st < 4; const int _ci = _ic ? _st : _st - 4, _n = _ic ? 4 : 64, _ca = dir ? (_n - 1 - _ci) : _ci; \
        row0n = _ic ? (NL + b * CTXL + _ca * 64) : (b * SEQ + _ca * 64); \
        _Pragma("unroll") for (int o = 0; o < 4; ++o) { const int idx = tid + o * NTHREADS, r = idx >> 5, c8 = (idx & 31) * 8; \
            rq[o] = *(const u32x4*)(QKV + (size_t)(row0n + r) * NQKV + h * 256 + c8); rk[o] = *(const u32x4*)(QKV + (size_t)(row0n + r) * NQKV + 1024 + h * 256 + c8); } \
        rv = *(const u32x4*)(QKV + (size_t)(row0n + (tid >> 3)) * NQKV + 2048 + h * 256 + es * 64 + (tid & 7) * 8); } while (0)
#define ML_SCAL(par_) do { LAS float* sp = (LAS float*)(lds + O_SC + (par_) * SC_PAR); const int lastr = dir ? 0 : 63; \
        const f32x4 g4 = *(const LAS f32x4*)(lds + O_RAW + (par_) * 1024 + lane * 16); const float a_ = g4[0], bcum = g4[1], pmax = g4[2]; \
        const float blast = __int_as_float(__builtin_amdgcn_readlane(__float_as_int(bcum), lastr)), gmax = blast + __int_as_float(__builtin_amdgcn_readlane(__float_as_int(pmax), lastr)); \
        const float mj = fmaxf(m_st, pmax), mnew = fmaxf(blast + m_st, gmax); \
        sp[lane] = a_; sp[64 + lane] = mj; sp[128 + lane] = __expf(m_st - mj); sp[192 + lane] = __expf(-(bcum + mj)); sp[256 + lane] = __expf(blast + a_ - mnew); \
        if (lane == 0) ((LAS float*)(lds + O_MISC))[(par_)] = __expf(blast + m_st - mnew); m_st = mnew; } while (0)
#define ML_STORE() do { _Pragma("unroll") for (int jt = 0; jt < 2; ++jt) \
        *(u32x4*)(HO + (size_t)(prow0 + jh * 32 + jt * 16 + r16) * DM + h * 256 + es * 64 + (mg - 2) * 32 + 8 * g) = (u32x4){pow_[jt][0].x, pow_[jt][0].y, pow_[jt][1].x, pow_[jt][1].y}; } while (0)
        u32x2 pow_[2][2]; bool pend = false; int prow0 = 0;
#define ML_ROW0(step_) (((step_) < 4) ? (NL + b * CTXL + (dir ? (3 - (step_)) : (step_)) * 64) : (b * SEQ + (dir ? (63 - ((step_) - 4)) : ((step_) - 4)) * 64))
        gs4 = gsc[((size_t)(ML_ROW0(0) >> 6) * 8 + dir * 4 + h) * 64 + lane];
        if (w == 0) *(LAS f32x4*)(lds + O_RAW + lane * 16) = gs4;
        gs4 = gsc[((size_t)(ML_ROW0(1) >> 6) * 8 + dir * 4 + h) * 64 + lane];
        ML_LOAD(0);
        if (w == 0) ML_SCAL(0);
        LDS_BARRIER();
        for (int step = 0; step < 68; ++step) {
            const int p = step & 1; const int row0 = row0n; const bool wr_out = (step >= 4) || (l == 0);
            const LAS float* sp = (const LAS float*)(lds + O_SC + p * SC_PAR);
#pragma unroll
            for (int o = 0; o < 4; ++o) { const int idx = tid + o * NTHREADS, r = idx >> 5, c8 = (idx & 31) * 8;
                *(LAS u32x4*)(lds + O_Q + r * QP + c8 * 2) = rq[o]; *(LAS u32x4*)(lds + O_K + r * KP + c8 * 2) = rk[o]; }
            {
              const int vs_ = tid >> 3, c8 = (tid & 7) * 8, cl = (c8 & 32) + ((c8 >> 3) & 3) * 4; const float wks = sp[256 + vs_];
              u32x2 lo, hi; lo.x = rv.x; lo.y = rv.y; hi.x = rv.z; hi.y = rv.w;
              *(LAS u32x2*)(lds + O_VR + vs_ * VP + cl * 2) = lo; *(LAS u32x2*)(lds + O_VR + vs_ * VP + (cl + 16) * 2) = hi;
              u32x2 slo, shi; slo.x = cvt_pk_bf16(bf_lo(rv.x) * wks, bf_hi(rv.x) * wks); slo.y = cvt_pk_bf16(bf_lo(rv.y) * wks, bf_hi(rv.y) * wks);
              shi.x = cvt_pk_bf16(bf_lo(rv.z) * wks, bf_hi(rv.z) * wks); shi.y = cvt_pk_bf16(bf_lo(rv.w) * wks, bf_hi(rv.w) * wks);
              *(LAS u32x2*)(lds + O_VS + vs_ * VP + cl * 2) = slo; *(LAS u32x2*)(lds + O_VS + vs_ * VP + (cl + 16) * 2) = shi;
              if ((tid & 7) == 0) *(LAS unsigned short*)(lds + O_VS + vs_ * VP + 128) = f2bf(wks); }
            if (w == 0) *(LAS f32x4*)(lds + O_RAW + (p ^ 1) * 1024 + lane * 16) = gs4;
            { const int sn = step + 2 < 68 ? step + 2 : 67; gs4 = gsc[((size_t)(ML_ROW0(sn) >> 6) * 8 + dir * 4 + h) * 64 + lane]; }
            LDS_BARRIER();
            if (pend) { ML_STORE(); pend = false; }
            if (step + 1 < 68) ML_LOAD(step + 1);
            f32x4 acc[3][2];
#pragma unroll
            for (int t = 0; t < 3; ++t) { acc[t][0] = (f32x4){0.f, 0.f, 0.f, 0.f}; acc[t][1] = acc[t][0]; }
            if (wr_out) { const int apitch = isS ? KP : QP;            const int abase = (isS ? O_K + mg * 32 * KP : O_CT + (mg - 2) * 32 * QP) + r16 * apitch + g * 16;
              const int qbase = O_Q + (jh * 32 + r16) * QP + g * 16;
#pragma unroll
              for (int ks = 0; ks < 8; ++ks) {
                  const bf16x8 b0 = *(const LAS bf16x8*)(lds + qbase + ks * 64), b1 = *(const LAS bf16x8*)(lds + qbase + 16 * QP + ks * 64);
                  const bf16x8 a0 = *(const LAS bf16x8*)(lds + abase + ks * 64), a1 = *(const LAS bf16x8*)(lds + abase + 16 * apitch + ks * 64);
                  acc[0][0] = __builtin_amdgcn_mfma_f32_16x16x32_bf16(a0, b0, acc[0][0], 0, 0, 0); acc[0][1] = __builtin_amdgcn_mfma_f32_16x16x32_bf16(a0, b1, acc[0][1], 0, 0, 0);
                  acc[1][0] = __builtin_amdgcn_mfma_f32_16x16x32_bf16(a1, b0, acc[1][0], 0, 0, 0); acc[1][1] = __builtin_amdgcn_mfma_f32_16x16x32_bf16(a1, b1, acc[1][1], 0, 0, 0);
                  if (nmt == 3) { const bf16x8 a2 = *(const LAS bf16x8*)(lds + abase + 32 * apitch + ks * 64);
                      acc[2][0] = __builtin_amdgcn_mfma_f32_16x16x32_bf16(a2, b0, acc[2][0], 0, 0, 0); acc[2][1] = __builtin_amdgcn_mfma_f32_16x16x32_bf16(a2, b1, acc[2][1], 0, 0, 0); } } }
            if (isS && wr_out) {
#pragma unroll
                for (int t = 0; t < 2; ++t) { const int s0 = mg * 32 + t * 16 + 4 * g; const f32x4 as = *(const LAS f32x4*)(sp + s0);
#pragma unroll
                    for (int jt = 0; jt < 2; ++jt) { const int j = jh * 32 + jt * 16 + r16; const float mjj = sp[64 + j]; float pv[4];
#pragma unroll
                        for (int i = 0; i < 4; ++i) { const int s = s0 + i; const bool ok = dir ? (s >= j) : (s <= j); pv[i] = ok ? acc[t][jt][i] * __expf(as[i] - mjj) : 0.f; }
                        u32x2 pw; pw.x = cvt_pk_bf16(pv[0], pv[1]); pw.y = cvt_pk_bf16(pv[2], pv[3]);
                        *(LAS u32x2*)(lds + O_P + j * TP + s0 * 2) = pw; } }
            }
            LDS_BARRIER();
            if (!isS) { if (wr_out) {
#pragma unroll
                for (int jt = 0; jt < 2; ++jt) { const float wi = sp[128 + jh * 32 + jt * 16 + r16];
#pragma unroll
                    for (int t = 0; t < 3; ++t) acc[t][jt] *= wi; }
                const int et0 = (mg - 2) * 2, pbase = O_P + (jh * 32 + r16) * TP + g * 16;
#pragma unroll
                for (int ks = 0; ks < 2; ++ks) {
                    const bf16x8 b0 = *(const LAS bf16x8*)(lds + pbase + ks * 64), b1 = *(const LAS bf16x8*)(lds + pbase + 16 * TP + ks * 64);
                    const bf16x8 a0 = tr_frag(lds + O_VR, VP, ks, et0, lane), a1 = tr_frag(lds + O_VR, VP, ks, et0 + 1, lane);
                    acc[0][0] = __builtin_amdgcn_mfma_f32_16x16x32_bf16(a0, b0, acc[0][0], 0, 0, 0); acc[0][1] = __builtin_amdgcn_mfma_f32_16x16x32_bf16(a0, b1, acc[0][1], 0, 0, 0);
                    acc[1][0] = __builtin_amdgcn_mfma_f32_16x16x32_bf16(a1, b0, acc[1][0], 0, 0, 0); acc[1][1] = __builtin_amdgcn_mfma_f32_16x16x32_bf16(a1, b1, acc[1][1], 0, 0, 0);
                    if (nmt == 3) { const bf16x8 a2 = tr_frag(lds + O_VR, VP, ks, et0 + 2, lane);
                        acc[2][0] = __builtin_amdgcn_mfma_f32_16x16x32_bf16(a2, b0, acc[2][0], 0, 0, 0); acc[2][1] = __builtin_amdgcn_mfma_f32_16x16x32_bf16(a2, b1, acc[2][1], 0, 0, 0); } }
                if (mg == 3 && g == 0) { LAS float* dn = (LAS float*)(lds + O_DEN); dn[jh * 32 + r16] = acc[2][0][0]; dn[jh * 32 + 16 + r16] = acc[2][1][0]; } }
            } else if (w == 0 && step + 1 < 68) { ML_SCAL(p ^ 1); }
            { const float wc = ((const LAS float*)(lds + O_MISC))[p];
#pragma unroll
              for (int a = 0; a < 2; ++a)
#pragma unroll
                  for (int e = 0; e < 5; ++e) accC[a][e] *= wc;
#pragma unroll
              for (int ks = 0; ks < 2; ++ks) {
                  bf16x8 bv[5];
#pragma unroll
                  for (int e = 0; e < 5; ++e) bv[e] = tr_frag(lds + O_VS, VP, ks, e, lane);
#pragma unroll
                  for (int a = 0; a < 2; ++a) { const bf16x8 ka = tr_frag(lds + O_K, KP, ks, w * 2 + a, lane);
#pragma unroll
                      for (int e = 0; e < 5; ++e) accC[a][e] = __builtin_amdgcn_mfma_f32_16x16x32_bf16(ka, bv[e], accC[a][e], 0, 0, 0); } } }
            LDS_BARRIER();
#pragma unroll
            for (int a = 0; a < 2; ++a)
#pragma unroll
                for (int e = 0; e < 5; ++e) { const int er = e * 16 + r16;
                    if (er <= 64) { u32x2 cw; cw.x = cvt_pk_bf16(accC[a][e][0], accC[a][e][1]); cw.y = cvt_pk_bf16(accC[a][e][2], accC[a][e][3]);
                        *(LAS u32x2*)(lds + O_CT + er * QP + ((w * 2 + a) * 16 + 4 * g) * 2) = cw; } }
            pend = !isS && wr_out; prow0 = row0;
            if (pend) {
#pragma unroll
                for (int jt = 0; jt < 2; ++jt) { const int j = jh * 32 + jt * 16 + r16;
                    const float den = ((const LAS float*)(lds + O_DEN))[j]; const float inv = __builtin_amdgcn_rcpf(fmaxf(fabsf(den), sp[192 + j]));
#pragma unroll
                    for (int t = 0; t < 2; ++t) { pow_[jt][t].x = cvt_pk_bf16(acc[t][jt][0] * inv, acc[t][jt][1] * inv); pow_[jt][t].y = cvt_pk_bf16(acc[t][jt][2] * inv, acc[t][jt][3] * inv); } }
            }
        }
        if (pend) { ML_STORE(); pend = false; }
#undef ML_LOAD
#undef ML_ROW0
#undef ML_SCAL
#undef ML_STORE
    }
}

__device__ __forceinline__ void post_phase(const Frame& F, int l) {
    const int M = l == 0 ? MT : NL;
    bf16_t* AC = (bf16_t*)(F.ws + WS_ACAT); const bf16_t* HF = (const bf16_t*)(F.ws + WS_HF); const bf16_t* HB = (const bf16_t*)(F.ws + WS_HB); const unsigned char* ZS = (const unsigned char*)(F.ws + WS_ZS); const bf16_t* ZP = (const bf16_t*)(F.ws + WS_ZP);
    const float* hg = F.in(I_HGAIN) + l * DM;
    u32x2 pa[4], pb[4]; unsigned po[4];
    f32x4 hgv[4];
#pragma unroll
    for (int hh = 0; hh < 4; ++hh) hgv[hh] = *(const f32x4*)(hg + hh * 256 + F.lane * 4);
    { const int row = F.bid * 8 + F.wave;
      if (row < M) {
#pragma unroll
          for (int hh = 0; hh < 4; ++hh) { const int k = hh * 256 + F.lane * 4;
              pa[hh] = *(const u32x2*)(HF + (size_t)row * DM + k); pb[hh] = *(const u32x2*)(HB + (size_t)row * DM + k); po[hh] = *(const unsigned*)(ZS + (size_t)row * 3072 + k); } } }
    for (int row = F.bid * 8 + F.wave; row < M; row += F.G * 8) {
        u32x2 ca[4], cb[4]; unsigned co[4];
#pragma unroll
        for (int hh = 0; hh < 4; ++hh) { ca[hh] = pa[hh]; cb[hh] = pb[hh]; co[hh] = po[hh]; }
        { const int rn = row + F.G * 8;
          if (rn < M) {
#pragma unroll
              for (int hh = 0; hh < 4; ++hh) { const int k = hh * 256 + F.lane * 4;
                  pa[hh] = *(const u32x2*)(HF + (size_t)rn * DM + k); pb[hh] = *(const u32x2*)(HB + (size_t)rn * DM + k); po[hh] = *(const unsigned*)(ZS + (size_t)rn * 3072 + k); } } }
#pragma unroll
        for (int hh = 0; hh < 4; ++hh) { const int k = hh * 256 + F.lane * 4;
            const u32x2 a = ca[hh], b = cb[hh]; const unsigned o = co[hh];
            f32x4 x = (f32x4){bf_lo(a.x) + bf_lo(b.x), bf_hi(a.x) + bf_hi(b.x), bf_lo(a.y) + bf_lo(b.y), bf_hi(a.y) + bf_hi(b.y)};
            const float mu = wave_sum(x[0] + x[1] + x[2] + x[3], F.lane) * (1.0f / 256.0f);
            x -= mu;
            const float var = wave_sum(x[0] * x[0] + x[1] * x[1] + x[2] * x[2] + x[3] * x[3], F.lane) * (1.0f / 256.0f);
            const float rs = rsqrtf(var + EPS);
            const f32x4 g4 = hgv[hh], so = unpack4_u8(o);
            x = so * ((x * rs) * g4);
            u32x2 w; w.x = cvt_pk_bf16(x[0], x[1]); w.y = cvt_pk_bf16(x[2], x[3]);
            *(u32x2*)(AC + (size_t)row * KCAT + k) = w; }
    }
    bf16_t* PO = AC + 1024;
    LAS float* Vs = (LAS float*)F.lds;
    constexpr int VP = 132;
    const int nun = 8 * 64 * 4 + (l == 0 ? 8 * 4 * 4 : 0);
    const int c = F.tid >> 3, q = F.tid & 7;
    for (int un = F.bid; un < nun; un += F.G) {
        float xc[16]; int lo, hi, nrow; size_t orow;
        if (un < 2048) {
            const int b = un >> 8, gr = (un >> 2) & 63, g = (un + (un >> 8)) & 3, hw = 1 << g;
            const int rlo = (gr - hw) > 0 ? (gr - hw) : 0, rhi = (gr + hw) < 64 ? (gr + hw) : 64;
            float vs[16];
#pragma unroll
            for (int i = 0; i < 16; ++i) vs[i] = 0.f;
#define POOL_ROWS(NB) \
            for (int r4 = rlo; r4 < rhi; r4 += NB) {        \
                u32x4 w0[NB], w1[NB]; \
                _Pragma("unroll") \
                for (int k = 0; k < NB; ++k) { const int r = (r4 + k) < rhi ? (r4 + k) : (rhi - 1); const bf16_t* p = ZP + (size_t)(b * SEQ + r * 64 + c) * 512 + g * 128 + q * 16; \
                    w0[k] = *(const u32x4*)p; w1[k] = *(const u32x4*)(p + 8); } \
                _Pragma("unroll") \
                for (int k = 0; k < NB; ++k) { if (r4 + k < rhi) { f32x4 f0, f1, f2, f3; unpack8(w0[k], f0, f1); unpack8(w1[k], f2, f3); \
                    _Pragma("unroll") \
                    for (int i = 0; i < 4; ++i) { vs[i] += f0[i]; vs[4 + i] += f1[i]; vs[8 + i] += f2[i]; vs[12 + i] += f3[i]; } \
                    if (r4 + k == gr) { \
                        _Pragma("unroll") \
                        for (int i = 0; i < 4; ++i) { xc[i] = f0[i]; xc[4 + i] = f1[i]; xc[8 + i] = f2[i]; xc[12 + i] = f3[i]; } } } } }
            if (g >= 2) { POOL_ROWS(8) } else { POOL_ROWS(4) }
#undef POOL_ROWS
#pragma unroll
            for (int i = 0; i < 4; ++i) *(LAS f32x4*)(Vs + (c + 8) * VP + q * 16 + i * 4) = (f32x4){vs[i * 4], vs[i * 4 + 1], vs[i * 4 + 2], vs[i * 4 + 3]};
            nrow = rhi - rlo; lo = (c - hw) > 0 ? (c - hw) : 0; hi = (c + hw) < 64 ? (c + hw) : 64; lo += 8; hi += 8;
            orow = (size_t)(b * SEQ + gr * 64 + c);
        } else {
            const int u2 = un - 2048, b = u2 >> 4, tb = (u2 >> 2) & 3, g = u2 & 3, hw = 1 << g, t0 = tb * 64;
            for (int pp = c; pp < 80; pp += 64) { const int t = t0 - 8 + pp; f32x4 f0 = {0.f, 0.f, 0.f, 0.f}, f1 = f0, f2 = f0, f3 = f0;
                if (t >= 0 && t < CTXL) { const bf16_t* p = ZP + (size_t)(NL + b * CTXL + t) * 512 + g * 128 + q * 16;
                    unpack8(*(const u32x4*)p, f0, f1); unpack8(*(const u32x4*)(p + 8), f2, f3); }
                *(LAS f32x4*)(Vs + pp * VP + q * 16) = f0; *(LAS f32x4*)(Vs + pp * VP + q * 16 + 4) = f1; *(LAS f32x4*)(Vs + pp * VP + q * 16 + 8) = f2; *(LAS f32x4*)(Vs + pp * VP + q * 16 + 12) = f3;
                }
            { const int t = t0 + c; const bf16_t* p = ZP + (size_t)(NL + b * CTXL + t) * 512 + g * 128 + q * 16; f32x4 f0, f1, f2, f3;
              unpack8(*(const u32x4*)p, f0, f1); unpack8(*(const u32x4*)(p + 8), f2, f3);
#pragma unroll
              for (int i = 0; i < 4; ++i) { xc[i] = f0[i]; xc[4 + i] = f1[i]; xc[8 + i] = f2[i]; xc[12 + i] = f3[i]; }
              const int tlo = (t - hw) > 0 ? (t - hw) : 0, thi = (t + hw) < CTXL ? (t + hw) : CTXL;
              lo = tlo - t0 + 8; hi = thi - t0 + 8; nrow = 1; orow = (size_t)(NL + b * CTXL + t); }
        }
        LDS_BARRIER();
        { float sm[16];
#pragma unroll
          for (int i = 0; i < 16; ++i) sm[i] = 0.f;
          for (int pp = lo; pp < hi; ++pp) {
#pragma unroll
              for (int i = 0; i < 4; ++i) { const f32x4 f = *(const LAS f32x4*)(Vs + pp * VP + q * 16 + i * 4); sm[i * 4] += f[0]; sm[i * 4 + 1] += f[1]; sm[i * 4 + 2] += f[2]; sm[i * 4 + 3] += f[3]; } }
          const float inv = 1.0f / (float)(nrow * (hi - lo));
          const int g = un < 2048 ? ((un + (un >> 8)) & 3) : ((un - 2048) & 3);
          u32x4 w0, w1;
          w0.x = cvt_pk_bf16(sm[0] * inv - xc[0], sm[1] * inv - xc[1]); w0.y = cvt_pk_bf16(sm[2] * inv - xc[2], sm[3] * inv - xc[3]);
          w0.z = cvt_pk_bf16(sm[4] * inv - xc[4], sm[5] * inv - xc[5]); w0.w = cvt_pk_bf16(sm[6] * inv - xc[6], sm[7] * inv - xc[7]);
          w1.x = cvt_pk_bf16(sm[8] * inv - xc[8], sm[9] * inv - xc[9]); w1.y = cvt_pk_bf16(sm[10] * inv - xc[10], sm[11] * inv - xc[11]);
          w1.z = cvt_pk_bf16(sm[12] * inv - xc[12], sm[13] * inv - xc[13]); w1.w = cvt_pk_bf16(sm[14] * inv - xc[14], sm[15] * inv - xc[15]);
          bf16_t* op = PO + orow * KCAT + g * 128 + q * 16;
          *(u32x4*)op = w0; *(u32x4*)(op + 8) = w1; }
        LDS_BARRIER();
    }
}

constexpr int PH_FINAL = 49, PH_END = 50;
struct Args { const float* in[25]; float* out; unsigned char* ws; int ph_lo, ph_hi; };
extern __shared__ __attribute__((aligned(16))) unsigned char lds_raw[];

__device__ __forceinline__ int lane_id_volatile() { int l_; asm volatile("v_mbcnt_lo_u32_b32 %0, -1, 0\n\tv_mbcnt_hi_u32_b32 %0, -1, %0" : "=v"(l_)); return l_; }
__device__ __forceinline__ Frame make_frame(const int wv) {
    Frame F;
    F.out = (float*)karg_in(25); F.ws = (unsigned char*)karg_in(26); F.ctl = (unsigned*)(F.ws + WS_CTL); F.lds = (LAS unsigned char*)lds_raw;
    int tid = wv * 64 + lane_id_volatile(), bid = blockIdx.x, G = gridDim.x;
    asm volatile("" : "+v"(tid)); asm volatile("" : "+s"(bid)); asm volatile("" : "+s"(G));
    F.G = G; F.bid = bid; F.tid = tid; F.lane = tid & 63; F.wave = __builtin_amdgcn_readfirstlane(tid >> 6);
    return F;
}
#if MK_MULTI
#define PHASE_FN __device__ __forceinline__
#else
#define PHASE_FN __device__ __forceinline__
#endif
#define UNI(x) __builtin_amdgcn_readfirstlane(x)
PHASE_FN void ph_prologue(const int wv) { const Frame F = make_frame(wv); prologue_phase(F); }
PHASE_FN void ph_norm(const int wv, int l, int which) { const Frame F = make_frame(wv); l = UNI(l); which = UNI(which); if (l == 0 && which == 0) norm_phase<true>(F, l, which); else norm_phase<false>(F, l, which); }
PHASE_FN void ph_norm2x(const int wv, int l) { const Frame F = make_frame(wv); l = UNI(l); norm_phase<false>(F, l, l == 0 ? 1 : 2); if (l == 1) expert_convert(F, (LAS float*)(F.lds + 81920)); }
#ifndef SKEW_TICKS
#define SKEW_TICKS 0
#endif
__device__ __forceinline__ void phase_skew(int bid, int G, int l) {
    bool light = false;
    if (G == 256) light = l == 0 ? ((bid >= 96 && bid < 128) || bid >= 240) : (bid >= 96);
    const unsigned long long t0 = __builtin_amdgcn_s_memrealtime(); const unsigned long long d = (unsigned long long)(((bid >> 3) & 7) * SKEW_TICKS + (light ? 1000 : 0));
    while (__builtin_amdgcn_s_memrealtime() - t0 < d) __builtin_amdgcn_s_sleep(8);
}
PHASE_FN void ph_gemm_a(const int wv, int l) { const Frame F = make_frame(wv); l = UNI(l);
    if (SKEW_TICKS > 0) phase_skew(F.bid, F.G, l);
    SchedDense S{(const char*)(F.ws + WS_R0), (const char*)(F.ws + WS_WQKV) + (size_t)l * NQKV * DM * 2, DM * 2, DM * 2, MT / 256, NQKV / 256, F.G, F.bid};
    EpiQKV E{(bf16_t*)(F.ws + WS_R1), (bf16_t*)(F.ws + WS_HALO)};
    gp::gemm_phase<0>(F.lds, DM * 2, S, E, F.tid); }
PHASE_FN void ph_prep(const int wv, int l) { const Frame F = make_frame(wv); prep_phase(F, UNI(l)); }
#ifndef MLSTM_REF
#define MLSTM_REF 0
#endif
PHASE_FN void ph_mlstm(const int wv, int l) { const Frame F = make_frame(wv);
#if MLSTM_REF
    mlstm_phase_ref(F, UNI(l));
#else
#if MLSTM_TR
    mlstm_phase_tr(F, UNI(l));
#else
    mlstm_phase_mfma(F, UNI(l));
#endif
#endif
}
PHASE_FN void ph_gemm_b(const int wv, int l) { const Frame F = make_frame(wv); l = UNI(l); const int M = l == 0 ? MT : NL;
    SchedDense S{(const char*)(F.ws + WS_R0), (const char*)(F.ws + WS_WB) + (size_t)l * NZB * DM * 2, DM * 2, DM * 2, M / 256, NZB / 256, F.G, (F.bid + F.G / 2) % F.G};
    EpiZB E{(unsigned char*)(F.ws + WS_ZS), (bf16_t*)(F.ws + WS_ZP)};
    gp::gemm_phase<0>(F.lds, DM * 2, S, E, F.tid); }
PHASE_FN void ph_post(const int wv, int l) { const Frame F = make_frame(wv); post_phase(F, UNI(l)); }
PHASE_FN void ph_merge1(const int wv, int l) { const Frame F = make_frame(wv); l = UNI(l); const int M = l == 0 ? MT : NL;
    WithDep<SchedDenseT<(DEPMASK & 1u) != 0>, (DEPMASK & 1u) ? 1 : 0> S{{(const char*)(F.ws + WS_ACAT), (const char*)(F.ws + WS_WCAT) + (size_t)l * DM * KCAT * 2, KCAT * 2, KCAT * 2, M / 256, DM / 256, F.G, F.bid}, CW_DEP_MERGE + l * 256, 0u};
    EpiMerge E{(bf16_t*)(F.ws + WS_R0), (const unsigned char*)(F.ws + WS_ZS)};
    gp::gemm_phase<0>(F.lds, KCAT * 2, S, E, F.tid); }
PHASE_FN void ph_merge2(const int wv, int l) { (void)wv; (void)l; }
PHASE_FN void ph_out(const int wv, int l) { const Frame F = make_frame(wv); l = UNI(l); const int M = l == 0 ? MT : NL;
    const float* modl = (const float*)(F.ws + WS_MOD) + (size_t)l * 9 * 6144;
    WithDep<SchedDenseT<(DEPMASK & 1u) != 0>, (DEPMASK & 1u) ? 2 : 0> S{{(const char*)(F.ws + WS_R0), (const char*)(F.ws + WS_WOUT) + (size_t)l * DM * DM * 2, DM * 2, DM * 2, M / 256, DM / 256, F.G, (F.bid + F.G / 2) % F.G}, CW_DEP_MERGE + l * 256, 32u};
    bf16_t* H = (bf16_t*)F.out; bf16_t* HC = (bf16_t*)(F.ws + WS_HC16);
    if (l == 0) { EpiResid<true> E{F.in(I_X), H, F.in(I_CTX), HC, modl, MOD_GT1, 1.0f}; gp::gemm_phase<0>(F.lds, DM * 2, S, E, F.tid); }
    else { EpiResid<false> E{H, H, HC, HC, modl, MOD_GT1, 1.0f}; gp::gemm_phase<0>(F.lds, DM * 2, S, E, F.tid); } }
PHASE_FN void ph_ffn1(const int wv) { const Frame F = make_frame(wv);
    constexpr int ES = FP8_DENSE ? 1 : 2;
    WithDep<SchedDenseT<(DEPMASK & 2u) != 0>, (DEPMASK & 2u) ? 1 : 0> S{{(const char*)(F.ws + WS_R0), (const char*)(F.ws + WS_WFGU), DM * ES, DM * ES, MT / 256, 2 * DFF / 256, F.G, F.bid}, CW_DEP_FFN, 0u};
    EpiSwiglu<(FP8_DENSE || FP8_FFN2)> E{(unsigned char*)(F.ws + WS_ACT), DFF * ((FP8_DENSE || FP8_FFN2) ? 1 : 2), FP8_DENSE ? WSCALE_INV : 1.0f};
    gp::gemm_phase<FP8_DENSE>(F.lds, DM * ES, S, E, F.tid); }
PHASE_FN void ph_ffn2(const int wv) { const Frame F = make_frame(wv);
    constexpr int F8 = (FP8_DENSE || FP8_FFN2) ? 1 : 0, ES = F8 ? 1 : 2;
    const float* modl = (const float*)(F.ws + WS_MOD);
    WithDep<SchedDenseT<(DEPMASK & 2u) != 0>, (DEPMASK & 2u) ? 2 : 0> S{{(const char*)(F.ws + WS_ACT), (const char*)(F.ws + WS_WFD), DFF * ES, DFF * ES, MT / 256, DM / 256, F.G, (F.bid + 80) % F.G}, CW_DEP_FFN, (unsigned)(2 * DFF / 256) * 8u};
    bf16_t* H = (bf16_t*)F.out; bf16_t* HC = (bf16_t*)(F.ws + WS_HC16);
    EpiResid<false> E{H, H, HC, HC, modl, MOD_GT2, F8 ? WSCALE_INV : 1.0f};
    gp::gemm_phase<F8>(F.lds, DFF * ES, S, E, F.tid); }
PHASE_FN void ph_moe1(const int wv, int r) { const Frame F = make_frame(wv); r = UNI(r);
    constexpr int ES = FP8_MOE ? 1 : 2;
    const int ttot = moe_build_table(F); int ntile = ttot - r * MOE_RT; ntile = ntile > MOE_RT ? MOE_RT : ntile;
    WithDep<SchedMoe1, (DEPMASK & 4u) ? 1 : 0> S{{(const char*)(F.ws + WS_R0), (const char*)(F.ws + WS_WEGU), (const int*)(F.ws + WS_RLIST), (LAS const int*)(F.lds + LDS_MOE_TAB), DM * ES, DM * ES, F.G, F.bid, r * MOE_RT, ntile}, CW_DEP_MOE, 0u};
    EpiSwiglu<FP8_MOE> E{(unsigned char*)(F.ws + WS_MACT + (size_t)(r & 1) * (MACT_BYTES / (FP8_MOE ? 2 : 1))), DFE * ES, FP8_MOE ? WSCALE_INV : 1.0f};
    gp::gemm_phase<FP8_MOE>(F.lds, DM * ES, S, E, F.tid); }
PHASE_FN void ph_moe2(const int wv, int r) { const Frame F = make_frame(wv); r = UNI(r);
    constexpr int ES = FP8_MOE ? 1 : 2;
    const int ttot = moe_build_table(F); int ntile = ttot - r * MOE_RT; ntile = ntile > MOE_RT ? MOE_RT : ntile;
    WithDep<SchedMoe2, (DEPMASK & 4u) ? 2 : 0> S{{(const char*)(F.ws + WS_MACT + (size_t)(r & 1) * (MACT_BYTES / (FP8_MOE ? 2 : 1))), (const char*)(F.ws + WS_WED), (LAS const int*)(F.lds + LDS_MOE_TAB), DFE * ES, DFE * ES, F.G, (F.bid + 168) % F.G, r * MOE_RT, ntile}, CW_DEP_MOE, (unsigned)(DFE / 128) * 8u};
    EpiMoe2 E{(bf16_t*)(F.ws + WS_Y), (const int*)(F.ws + WS_RLIST), (const float*)(F.ws + WS_RPROB), FP8_MOE ? WSCALE_INV : 1.0f};
    gp::gemm_phase<FP8_MOE>(F.lds, DFE * ES, S, E, F.tid); }
PHASE_FN void ph_final(const int wv) { const Frame F = make_frame(wv); final_phase(F); }

__device__ __forceinline__ void grid_sync(const int wv) {
    const bool thread0 = (wv == 0) && (lane_id_volatile() == 0);
    XcdBarrier b; b.bar = (unsigned*)((unsigned char*)karg_in(26) + WS_CTL) + CW_BAR; b.x = xb_xcc_id();
    b.st = (volatile LAS unsigned*)((LAS unsigned char*)lds_raw + LDS_BYTES - 16);
    xcd_barrier(b, thread0);
}
#ifndef REPMASK
#define REPMASK 0u
#endif
#ifndef DEPMASK
#define DEPMASK 7u
#endif
#define RP(k) (((REPMASK >> (k)) & 1u) ? 2 : 1)
template <unsigned PMASK>
__global__ void __launch_bounds__(NTHREADS, 2) fwd_kernel(Args args) {
    unsigned* ctl = (unsigned*)(args.ws + WS_CTL);
    volatile LAS unsigned* bst = (volatile LAS unsigned*)((LAS unsigned char*)lds_raw + LDS_BYTES - 16);
    const int wv = __builtin_amdgcn_readfirstlane((int)(threadIdx.x >> 6));
    if (threadIdx.x < 4) bst[threadIdx.x] = 0u;
    if (threadIdx.x == 0 && (xb_xcc_id() != (blockIdx.x % gp::NXCD) || gridDim.x < gp::NXCD)) (void)xb_add(ctl + CW_NONCANON, 1u);
    __syncthreads();
    const int lo = args.ph_lo, hi = args.ph_hi;
    const bool single = (hi - lo) > 1;
    if (single) (void)xcd_barrier_post(ctl + CW_BAR, bst);
#define IN(k) (lo <= (k) && (k) < hi)
#define PK(b) ((PMASK >> (b)) & 1u)
#define SEAM(k) do { if (IN((k) + 1) && single) grid_sync(wv); } while (0)

    if (PK(0) && IN(0)) { for (int rep = 0; rep < RP(0); ++rep) { if (rep) __syncthreads(); ph_prologue(wv); } SEAM(0); }
    if (single) { if (threadIdx.x == 0) bst[2] = xb_ld(ctl + CW_NONCANON); __syncthreads(); }
#define DEP_SEAM(bit, k) do { if (!(DEPMASK & (bit)) || bst[2] != 0u) SEAM(k); } while (0)

    for (int l = 0; l < 2; ++l) {
        const int pb = 1 + 24 * l;
        if (hi <= pb || lo >= pb + 24) continue;
        if (PK(1) && IN(pb + 0)) { for (int rep = 0; rep < RP(1); ++rep) { if (rep) __syncthreads(); ph_norm(wv, l, 0); } SEAM(pb + 0); }
        if (PK(2) && IN(pb + 1)) { for (int rep = 0; rep < RP(2); ++rep) { if (rep) __syncthreads(); ph_gemm_a(wv, l); ph_gemm_b(wv, l); } SEAM(pb + 1); }
        if (PK(3) && IN(pb + 2)) { ph_prep(wv, l); SEAM(pb + 2); }
        if (PK(4) && IN(pb + 3)) { for (int rep = 0; rep < RP(4); ++rep) { if (rep) __syncthreads(); ph_mlstm(wv, l); } SEAM(pb + 4); }
        if (PK(6) && IN(pb + 5)) { for (int rep = 0; rep < RP(6); ++rep) { if (rep) __syncthreads(); ph_post(wv, l); } SEAM(pb + 5); }
        if (PK(7) && IN(pb + 6)) { for (int rep = 0; rep < RP(7); ++rep) { if (rep) __syncthreads(); ph_merge1(wv, l); ph_merge2(wv, l); } DEP_SEAM(1u, pb + 6);   }
        if (PK(8) && IN(pb + 7)) { ph_out(wv, l); SEAM(pb + 7); }
        if (PK(9) && IN(pb + 8)) { ph_norm2x(wv, l); SEAM(pb + 8); }
        if (l == 0) {
            if (PK(10) && IN(pb + 9)) { for (int rep = 0; rep < RP(10); ++rep) { if (rep) __syncthreads(); ph_ffn1(wv); } DEP_SEAM(2u, pb + 9);   }
            if (PK(11) && IN(pb + 10)) { ph_ffn2(wv); SEAM(pb + 10); }
        } else {
            if (PK(12) && IN(pb + 11)) { for (int rep = 0; rep < RP(12); ++rep) { if (rep) __syncthreads(); ph_moe1(wv, 0); } DEP_SEAM(4u, pb + 11);   }
            for (int r = 0; r < MOE_ROUNDS; ++r) {
                if (PK(13) && IN(pb + 12 + r)) { for (int rep = 0; rep < RP(13); ++rep) { if (rep) __syncthreads(); ph_moe2(wv, r); if (r + 1 < MOE_ROUNDS) ph_moe1(wv, r + 1); }
                    if (r + 1 < MOE_ROUNDS) SEAM(pb + 12 + r); else { if (single) grid_sync(wv); } }
            }
        }
    }
    if (PK(14) && IN(PH_FINAL)) ph_final(wv);
#undef IN
#undef PK
#undef SEAM
#undef DEP_SEAM
}

extern "C" void kernel_launch(void* const* d_in, const int* in_sizes, int n_in, void* d_out, int out_size, void* d_ws, size_t ws_size, hipStream_t stream) {
    static int grid = 0;
    if (grid == 0) {
        if (n_in != 25 || out_size != NL * DM || ws_size < WS_END2) { fprintf(stderr, "kernel_launch: unexpected shapes (n_in %d out %d ws %zu need %zu)\n", n_in, out_size, ws_size, (size_t)WS_END2); grid = -1; return; }
        int dev = 0, cus = 0, per_cu = 0;
        if (hipGetDevice(&dev) != hipSuccess || hipDeviceGetAttribute(&cus, hipDeviceAttributeMultiprocessorCount, dev) != hipSuccess) { grid = -1; return; }
        const void* ks[16] = { (const void*)fwd_kernel<1u << 0>, (const void*)fwd_kernel<1u << 1>, (const void*)fwd_kernel<1u << 2>, (const void*)fwd_kernel<1u << 3>, (const void*)fwd_kernel<1u << 4>,
            (const void*)fwd_kernel<1u << 5>, (const void*)fwd_kernel<1u << 6>, (const void*)fwd_kernel<1u << 7>, (const void*)fwd_kernel<1u << 8>, (const void*)fwd_kernel<1u << 9>, (const void*)fwd_kernel<1u << 10>,
            (const void*)fwd_kernel<1u << 11>, (const void*)fwd_kernel<1u << 12>, (const void*)fwd_kernel<1u << 13>, (const void*)fwd_kernel<1u << 14>,
#if MK_MULTI
            nullptr };
#else
            (const void*)fwd_kernel<0xFFFFFFFFu> };
#endif
        for (int i = 0; i < (MK_MULTI ? 15 : 16); ++i) { if (!MK_MULTI && i < 15) continue;
            if (hipFuncSetAttribute(ks[i], hipFuncAttributeMaxDynamicSharedMemorySize, LDS_BYTES) != hipSuccess) { fprintf(stderr, "kernel_launch: hipFuncSetAttribute failed\n"); grid = -1; return; }
            if (hipOccupancyMaxActiveBlocksPerMultiprocessor(&per_cu, ks[i], NTHREADS, LDS_BYTES) != hipSuccess || per_cu < 1) { fprintf(stderr, "kernel_launch: occupancy query says %d\n", per_cu); (void)hipGetLastError(); grid = -1; return; } }
        grid = cus;
    }
    if (grid < 0) return;
    (void)in_sizes;
    (void)hipMemsetAsync((char*)d_ws + WS_CTL, 0, CTL_BYTES, stream);
    Args a{};
    for (int i = 0; i < 25; ++i) a.in[i] = (const float*)d_in[i];
    a.out = (float*)d_out; a.ws = (unsigned char*)d_ws;
#if MK_MULTI
    for (int p = 0; p < PH_END; ++p) {
        const int rel = p == 0 ? -1 : (p - 1) % 24, l = p == 0 ? -1 : (p - 1) / 24;
        int kind;
        if (p == 0) kind = 0; else if (p == PH_FINAL) kind = 14;
        else { if (l > 1) continue; if (rel == 4) continue; if (l == 0 && rel > 10) continue; if (l == 1 && (rel == 9 || rel == 10 || rel > 11 + MOE_ROUNDS)) continue;
            kind = rel <= 10 ? rel + 1 : (rel == 11 ? 12 : 13); }
        a.ph_lo = p; a.ph_hi = p + 1;
        switch (kind) {
#define LK(K) case K: hipLaunchKernelGGL(fwd_kernel<1u << K>, dim3(grid), dim3(NTHREADS), LDS_BYTES, stream, a); break;
            LK(0) LK(1) LK(2) LK(3) LK(4) LK(5) LK(6) LK(7) LK(8) LK(9) LK(10) LK(11) LK(12) LK(13) LK(14)
#undef LK
        }
    }
#else
    a.ph_lo = 0; a.ph_hi = PH_END;
    hipLaunchKernelGGL(fwd_kernel<0xFFFFFFFFu>, dim3(grid), dim3(NTHREADS), LDS_BYTES, stream, a);
#endif
}
```
